# Optimizing an MI355X kernel written in HIP

```python
import math
import jax
import jax.numpy as jnp
from jax import lax
import numpy as np

D_MODEL = 2048
BATCH = 2
SEQ = 8192
DEPTH = 4

GRID_W = 64
CTX_LEN = 256
N_MIXERS = 3
N_A = (DEPTH + 2) // 3
N_B = (DEPTH + 1) // 3
N_C = DEPTH // 3
D_FF = 4 * D_MODEL
N_MOD = 6
EPS = 1e-6
ROPE_BASE = 10000.0
Q_BLOCK = 128

CHUNK = 128
GMLP_WIDTH = D_MODEL
GMLP_GROUPS = 16
GMLP_GROUP_DIM = GMLP_WIDTH // GMLP_GROUPS

DIFF_HEADS = D_MODEL // 256
DIFF_HEAD_DIM = 128
DIFF_V_DIM = 2 * DIFF_HEAD_DIM

MLA_HEADS = D_MODEL // 128
MLA_Q_RANK = 448
MLA_KV_RANK = 512
MLA_NOPE = 128
MLA_ROPE = 64
MLA_V = 128
MLA_QK = MLA_NOPE + MLA_ROPE

kernel_name = "hybrid_gmlp_diffattn_mla_dit"


def rms_norm(x, g):
    xf = x.astype(jnp.float32)
    y = xf * lax.rsqrt(jnp.mean(xf * xf, axis=-1, keepdims=True) + EPS)
    return (y * g.astype(jnp.float32)).astype(x.dtype)


def layer_norm(x, g):
    xf = x.astype(jnp.float32)
    xc = xf - jnp.mean(xf, axis=-1, keepdims=True)
    y = xc * lax.rsqrt(jnp.mean(xc * xc, axis=-1, keepdims=True) + EPS)
    return (y * g.astype(jnp.float32)).astype(x.dtype)


def modulate(h, shift, scale):
    return h * (1 + scale) + shift


def axial_rope_tables(rows, cols, rot_dim):
    a = rot_dim // 2
    inv = ROPE_BASE ** (-jnp.arange(0, a, 2, dtype=jnp.float32) / a)

    def axis_angles(pos):
        ang = pos.astype(jnp.float32)[:, None] * inv[None, :]
        return jnp.concatenate([ang, ang], axis=-1)

    ang = jnp.concatenate([axis_angles(rows), axis_angles(cols)], axis=-1)
    return jnp.cos(ang), jnp.sin(ang)


def _rotate_half(t):
    half = t.shape[-1] // 2
    return jnp.concatenate([-t[..., half:], t[..., :half]], axis=-1)


def apply_axial_rope(x, cos, sin):
    a = x.shape[-1] // 2
    xr = jnp.concatenate([_rotate_half(x[..., :a]), _rotate_half(x[..., a:])], axis=-1)
    bshape = (1, cos.shape[0]) + (1,) * (x.ndim - 3) + (cos.shape[-1],)
    return x * cos.reshape(bshape).astype(x.dtype) + xr * sin.reshape(bshape).astype(x.dtype)


def map_query_blocks(fn, q):
    B, S = q.shape[:2]
    nb = S // Q_BLOCK
    qb = jnp.moveaxis(q.reshape((B, nb, Q_BLOCK) + q.shape[2:]), 1, 0)
    out = jnp.moveaxis(lax.map(fn, qb), 0, 1)
    return out.reshape((B, S) + out.shape[3:])


def diff_attend(q, k, v, lam):
    scale = DIFF_HEAD_DIM ** -0.5

    def one(qb):
        s = jnp.einsum('bqhjd,bkhjd->bhjqk', qb, k, preferred_element_type=jnp.float32) * scale
        p = jax.nn.softmax(s, axis=-1)
        w = p[:, :, 0] - lam * p[:, :, 1]
        return jnp.einsum('bhqk,bkhe->bqhe', w.astype(v.dtype), v)

    return map_query_blocks(one, q)


def softmax_attend(q, k, v, scale):
    def one(qb):
        s = jnp.einsum('bqhd,bkhd->bhqk', qb, k, preferred_element_type=jnp.float32) * scale
        p = jax.nn.softmax(s, axis=-1)
        return jnp.einsum('bhqk,bkhe->bqhe', p.astype(v.dtype), v)

    return map_query_blocks(one, q)


def gmlp_chunk_mixer(h, w_in, b_in, ln_g, w_s, b_s, w_out):
    B, T, _ = h.shape
    z = jax.nn.gelu(h @ w_in + b_in)
    u, v = jnp.split(z, 2, axis=-1)
    v = layer_norm(v, ln_g)
    v = v.reshape(B, T // CHUNK, CHUNK, GMLP_GROUPS, GMLP_GROUP_DIM)
    sv = jnp.einsum('gpq,bnqgc->bnpgc', w_s, v) + b_s.T[:, :, None]
    return (u * sv.reshape(B, T, GMLP_WIDTH)) @ w_out


def diff_attention_mixer(h_lat, h_ctx, cos, sin, w_qkv, lam_q1, lam_k1, lam_q2, lam_k2,
                         subln_g, w_o, lambda_init, need_ctx_out):
    H, d = DIFF_HEADS, DIFF_HEAD_DIM

    def proj(h):
        B, T = h.shape[:2]
        q, k, v = jnp.split(h @ w_qkv, [2 * H * d, 4 * H * d], axis=-1)
        return q.reshape(B, T, H, 2, d), k.reshape(B, T, H, 2, d), v.reshape(B, T, H, DIFF_V_DIM)

    def post(o):
        B, T = o.shape[:2]
        o = rms_norm(o, subln_g) * (1.0 - lambda_init)
        return o.reshape(B, T, H * DIFF_V_DIM) @ w_o

    f32 = jnp.float32
    lam = (jnp.exp(jnp.sum(lam_q1.astype(f32) * lam_k1.astype(f32)))
           - jnp.exp(jnp.sum(lam_q2.astype(f32) * lam_k2.astype(f32))) + lambda_init)
    q_l, k_l, v_l = proj(h_lat)
    q_l = apply_axial_rope(q_l, cos, sin)
    k_l = apply_axial_rope(k_l, cos, sin)
    q_c, k_c, v_c = proj(h_ctx)
    k_all = jnp.concatenate([k_l, k_c], axis=1)
    v_all = jnp.concatenate([v_l, v_c], axis=1)
    y_lat = post(diff_attend(q_l, k_all, v_all, lam))
    y_ctx = post(diff_attend(q_c, k_c, v_c, lam)) if need_ctx_out else None
    return y_lat, y_ctx


def mla_mixer(h_lat, h_ctx, cos, sin, w_dqkv, q_norm_g, w_uq, kv_norm_g, w_ukv, w_o, need_ctx_out):
    H = MLA_HEADS

    def proj(h, rotary):
        B, T = h.shape[:2]
        c_q, c_kv, k_r = jnp.split(h @ w_dqkv, [MLA_Q_RANK, MLA_Q_RANK + MLA_KV_RANK], axis=-1)
        q = (rms_norm(c_q, q_norm_g) @ w_uq).reshape(B, T, H, MLA_QK)
        kv = (rms_norm(c_kv, kv_norm_g) @ w_ukv).reshape(B, T, H, MLA_NOPE + MLA_V)
        q_n, q_r = jnp.split(q, [MLA_NOPE], axis=-1)
        k_n, v = jnp.split(kv, [MLA_NOPE], axis=-1)
        k_r = k_r[:, :, None, :]
        if rotary:
            q_r = apply_axial_rope(q_r, cos, sin)
            k_r = apply_axial_rope(k_r, cos, sin)
        q = jnp.concatenate([q_n, q_r], axis=-1)
        k = jnp.concatenate([k_n, jnp.broadcast_to(k_r, (B, T, H, MLA_ROPE))], axis=-1)
        return q, k, v

    def post(o):
        B, T = o.shape[:2]
        return o.reshape(B, T, H * MLA_V) @ w_o

    scale = MLA_QK ** -0.5
    q_l, k_l, v_l = proj(h_lat, True)
    q_c, k_c, v_c = proj(h_ctx, False)
    k_all = jnp.concatenate([k_l, k_c], axis=1)
    v_all = jnp.concatenate([v_l, v_c], axis=1)
    y_lat = post(softmax_attend(q_l, k_all, v_all, scale))
    y_ctx = post(softmax_attend(q_c, k_c, v_c, scale)) if need_ctx_out else None
    return y_lat, y_ctx


def sq_relu_mlp(h, w1, w2):
    return jnp.square(jax.nn.relu(h @ w1)) @ w2


def setup_inputs(seed: int = 0) -> dict:
    key = jax.random.key(seed)
    ks = iter(jax.random.split(key, 32))

    def nrm(shape, scale):
        return jax.random.normal(next(ks), shape, jnp.float32) * scale

    def gain(shape):
        return 1.0 + nrm(shape, 0.02)

    D = D_MODEL
    return {
        "x": nrm((BATCH, SEQ, D), 1.0),
        "c": nrm((BATCH, D), 1.0),
        "ctx": nrm((BATCH, CTX_LEN, D), 1.0),
        "c_ctx": nrm((D,), 1.0),
        "w_mod": nrm((DEPTH, D, N_MOD * D), 0.5 * D ** -0.5),
        "b_mod": nrm((DEPTH, N_MOD * D), 0.02),
        "norm1_g": gain((DEPTH, D)),
        "norm2_g": gain((DEPTH, D)),
        "w_ff1": nrm((DEPTH, D, D_FF), D ** -0.5),
        "w_ff2": nrm((DEPTH, D_FF, D), D_FF ** -0.5),
        "a_w_in": nrm((N_A, D, 2 * GMLP_WIDTH), D ** -0.5),
        "a_b_in": nrm((N_A, 2 * GMLP_WIDTH), 0.02),
        "a_ln_g": gain((N_A, GMLP_WIDTH)),
        "a_w_s": nrm((N_A, GMLP_GROUPS, CHUNK, CHUNK), CHUNK ** -0.5),
        "a_b_s": gain((N_A, GMLP_GROUPS, CHUNK)),
        "a_w_out": nrm((N_A, GMLP_WIDTH, D), GMLP_WIDTH ** -0.5),
        "b_w_qkv": nrm((N_B, D, 4 * DIFF_HEADS * DIFF_HEAD_DIM + DIFF_HEADS * DIFF_V_DIM), D ** -0.5),
        "b_lam_q1": nrm((N_B, DIFF_HEAD_DIM), 0.1),
        "b_lam_k1": nrm((N_B, DIFF_HEAD_DIM), 0.1),
        "b_lam_q2": nrm((N_B, DIFF_HEAD_DIM), 0.1),
        "b_lam_k2": nrm((N_B, DIFF_HEAD_DIM), 0.1),
        "b_subln_g": gain((N_B, DIFF_V_DIM)),
        "b_w_o": nrm((N_B, DIFF_HEADS * DIFF_V_DIM, D), (DIFF_HEADS * DIFF_V_DIM) ** -0.5),
        "c_w_dqkv": nrm((N_C, D, MLA_Q_RANK + MLA_KV_RANK + MLA_ROPE), D ** -0.5),
        "c_q_norm_g": gain((N_C, MLA_Q_RANK)),
        "c_w_uq": nrm((N_C, MLA_Q_RANK, MLA_HEADS * MLA_QK), MLA_Q_RANK ** -0.5),
        "c_kv_norm_g": gain((N_C, MLA_KV_RANK)),
        "c_w_ukv": nrm((N_C, MLA_KV_RANK, MLA_HEADS * (MLA_NOPE + MLA_V)), MLA_KV_RANK ** -0.5),
        "c_w_o": nrm((N_C, MLA_HEADS * MLA_V, D), (MLA_HEADS * MLA_V) ** -0.5),
        "final_g": gain((D,)),
    }


def reference(x, c, ctx, c_ctx, w_mod, b_mod, norm1_g, norm2_g, w_ff1, w_ff2,
              a_w_in, a_b_in, a_ln_g, a_w_s, a_b_s, a_w_out,
              b_w_qkv, b_lam_q1, b_lam_k1, b_lam_q2, b_lam_k2, b_subln_g, b_w_o,
              c_w_dqkv, c_q_norm_g, c_w_uq, c_kv_norm_g, c_w_ukv, c_w_o, final_g):
    B, S, D = x.shape
    ROWS = S // GRID_W
    rows = jnp.repeat(jnp.arange(ROWS, dtype=jnp.int32), GRID_W)
    cols = jnp.tile(jnp.arange(GRID_W, dtype=jnp.int32), ROWS)
    cos_b, sin_b = axial_rope_tables(rows, cols, DIFF_HEAD_DIM)
    cos_c, sin_c = axial_rope_tables(rows, cols, MLA_ROPE)
    s_c = jax.nn.silu(c)
    s_cc = jax.nn.silu(c_ctx)
    xc = ctx

    for l in range(DEPTH):
        kind = l % N_MIXERS
        idx = l // N_MIXERS
        ctx_later = any(j % N_MIXERS != 0 for j in range(l + 1, DEPTH))
        ctx_here = ctx_later or kind != 0

        sh1, sc1, g1, sh2, sc2, g2 = jnp.split((s_c @ w_mod[l] + b_mod[l])[:, None, :], N_MOD, axis=-1)
        hx = modulate(rms_norm(x, norm1_g[l]), sh1, sc1)
        hc = None
        if ctx_here:
            csh1, csc1, cg1, csh2, csc2, cg2 = jnp.split(s_cc @ w_mod[l] + b_mod[l], N_MOD, axis=-1)
            hc = modulate(rms_norm(xc, norm1_g[l]), csh1, csc1)

        if kind == 0:
            p = (a_w_in[idx], a_b_in[idx], a_ln_g[idx], a_w_s[idx], a_b_s[idx], a_w_out[idx])
            y_x = gmlp_chunk_mixer(hx, *p)
            y_c = gmlp_chunk_mixer(hc, *p) if ctx_later else None
        elif kind == 1:
            lambda_init = 0.8 - 0.6 * math.exp(-0.3 * l)
            y_x, y_c = diff_attention_mixer(hx, hc, cos_b, sin_b, b_w_qkv[idx], b_lam_q1[idx], b_lam_k1[idx],
                                            b_lam_q2[idx], b_lam_k2[idx], b_subln_g[idx], b_w_o[idx],
                                            lambda_init, ctx_later)
        else:
            y_x, y_c = mla_mixer(hx, hc, cos_c, sin_c, c_w_dqkv[idx], c_q_norm_g[idx], c_w_uq[idx],
                                 c_kv_norm_g[idx], c_w_ukv[idx], c_w_o[idx], ctx_later)

        x = x + g1 * y_x
        x = x + g2 * sq_relu_mlp(modulate(rms_norm(x, norm2_g[l]), sh2, sc2), w_ff1[l], w_ff2[l])
        if ctx_later:
            xc = xc + cg1 * y_c
            xc = xc + cg2 * sq_relu_mlp(modulate(rms_norm(xc, norm2_g[l]), csh2, csc2), w_ff1[l], w_ff2[l])

    return rms_norm(x, final_g)
```

```cpp
#include <hip/hip_runtime.h>
#include <cstdio>
#include <cstdint>
#include <cmath>

constexpr int D = 2048, BATCH = 2, SEQ = 8192, DEPTH = 4, GRID_W = 64, CTXL = 256;
constexpr int DFF = 8192, NMOD = 6;
constexpr int TB = SEQ + CTXL;
constexpr int NR = BATCH * TB;
constexpr float EPS = 1e-6f;
constexpr int GW = 2048, GG = 16, GC = 128, CHUNK = 128;
constexpr int DH = 8, DHD = 128, DVD = 256, NQKV = 6144;
constexpr int MH = 16, MQR = 448, MKVR = 512, MNOPE = 128, MROPE = 64, MV = 128, MQK = 192;
constexpr int MODW = NMOD * D;

enum { I_X = 0, I_C, I_CTX, I_CCTX, I_WMOD, I_BMOD, I_N1G, I_N2G, I_WFF1, I_WFF2, I_AWIN, I_ABIN, I_ALNG, I_AWS, I_ABS, I_AWOUT,
       I_BWQKV, I_BLQ1, I_BLK1, I_BLQ2, I_BLK2, I_BSUBG, I_BWO, I_CWDQKV, I_CQNG, I_CWUQ, I_CKVNG, I_CWUKV, I_CWO, I_FING, N_IN };

constexpr size_t MiB = 1u << 20;
constexpr size_t WS_CTL = 0;
constexpr size_t WS_MOD = 1 * MiB;
constexpr size_t WS_ROPE = 2 * MiB;
constexpr size_t WS_X = 4 * MiB;
constexpr size_t WS_S0 = 136 * MiB;
constexpr size_t SL_XN = WS_S0;
constexpr size_t SL_BIG = SL_XN + 132 * MiB;
constexpr size_t SL_B2 = SL_BIG + 528 * MiB;
constexpr size_t SL_B3 = SL_B2 + 264 * MiB;
constexpr size_t SL_ST = SL_B3 + 132 * MiB;
constexpr size_t WS_NEED = SL_ST + 1 * MiB;
static_assert(WS_NEED <= 1536 * MiB, "workspace");

__device__ __forceinline__ int row_group(int r) { return (r % TB) >= SEQ ? 2 : r / TB; }
__device__ __forceinline__ float wave_sum(float v) {
#pragma unroll
    for (int o = 1; o < 64; o <<= 1) v += __shfl_xor(v, o);
    return v;
}

__global__ __launch_bounds__(256) void k_copy_x(const float* __restrict__ x, const float* __restrict__ ctx, float* __restrict__ X) {
    const size_t n4 = (size_t)NR * D / 4;
    for (size_t i = (size_t)blockIdx.x * 256 + threadIdx.x; i < n4; i += (size_t)gridDim.x * 256) {
        const int r = (int)(i / (D / 4)), c4 = (int)(i % (D / 4));
        const int b = r / TB, t = r % TB;
        const float4 v = (t < SEQ) ? ((const float4*)x)[((size_t)b * SEQ + t) * (D / 4) + c4] : ((const float4*)ctx)[((size_t)b * CTXL + (t - SEQ)) * (D / 4) + c4];
        ((float4*)X)[i] = v;
    }
}
__global__ void k_rope_tables(float* __restrict__ tab) {
    const int i = blockIdx.x * blockDim.x + threadIdx.x;
    if (i < 128 * 32) { const int pos = i / 32, f = i % 32; const float inv = powf(10000.0f, -(float)(2 * f) / 64.0f); const float a = (float)pos * inv; tab[i] = cosf(a); tab[4096 + i] = sinf(a); }
    if (i < 128 * 16) { const int pos = i / 16, f = i % 16; const float inv = powf(10000.0f, -(float)(2 * f) / 32.0f); const float a = (float)pos * inv; tab[8192 + i] = cosf(a); tab[8192 + 2048 + i] = sinf(a); }
}
__device__ __forceinline__ float silu(float v) { return v / (1.0f + expf(-v)); }
__global__ __launch_bounds__(512) void k_mod(const float* __restrict__ c, const float* __restrict__ cctx, const float* __restrict__ wmod, const float* __restrict__ bmod, float* __restrict__ mod) {
    __shared__ float s[3][D];
    __shared__ float red[8][3][64];
    const int tid = threadIdx.x, wave = tid >> 6, lane = tid & 63;
    for (int i = tid; i < 3 * D; i += 512) { const int g = i / D, k = i % D; const float v = g < 2 ? c[g * D + k] : cctx[k]; s[g][k] = silu(v); }
    __syncthreads();
    const int cq = lane & 15, kr = lane >> 4;
    for (int u = blockIdx.x; u < DEPTH * (MODW / 64); u += gridDim.x) {
        const int l = u / (MODW / 64), n0 = (u % (MODW / 64)) * 64;
        const float* W = wmod + (size_t)l * D * MODW + n0 + cq * 4;
        float a[3][4] = {};
        for (int k = wave * 256 + kr; k < wave * 256 + 256; k += 4) {
            const float4 w = *(const float4*)(W + (size_t)k * MODW);
#pragma unroll
            for (int g = 0; g < 3; ++g) { const float sv = s[g][k]; a[g][0] += sv * w.x; a[g][1] += sv * w.y; a[g][2] += sv * w.z; a[g][3] += sv * w.w; }
        }
#pragma unroll
        for (int g = 0; g < 3; ++g)
#pragma unroll
            for (int j = 0; j < 4; ++j) { float v = a[g][j]; v += __shfl_xor(v, 16); v += __shfl_xor(v, 32); a[g][j] = v; }
        if (kr == 0) {
#pragma unroll
            for (int g = 0; g < 3; ++g)
#pragma unroll
                for (int j = 0; j < 4; ++j) red[wave][g][cq * 4 + j] = a[g][j];
        }
        __syncthreads();
        if (tid < 192) { const int g = tid / 64, n = tid % 64; float v = bmod[(size_t)l * MODW + n0 + n];
#pragma unroll
            for (int w = 0; w < 8; ++w) v += red[w][g][n];
            mod[((size_t)l * 3 + g) * MODW + n0 + n] = v; }
        __syncthreads();
    }
}

__global__ __launch_bounds__(512) void k_norm_mod(const float* __restrict__ X, const float* __restrict__ g, const float* __restrict__ modl  , int which  , float* __restrict__ OUT) {
    const int lane = threadIdx.x & 63, gw = blockIdx.x * 8 + (threadIdx.x >> 6), ngw = gridDim.x * 8;
    for (int r = gw; r < NR; r += ngw) {
        const float4* xr = (const float4*)(X + (size_t)r * D);
        float4 v[8]; float ss = 0.f;
#pragma unroll
        for (int j = 0; j < 8; ++j) { v[j] = xr[j * 64 + lane]; ss += v[j].x * v[j].x + v[j].y * v[j].y + v[j].z * v[j].z + v[j].w * v[j].w; }
        const float rstd = rsqrtf(wave_sum(ss) * (1.0f / D) + EPS);
        const float* mg = modl + (size_t)row_group(r) * MODW + which * 3 * D;
        float4* o = (float4*)(OUT + (size_t)r * D);
#pragma unroll
        for (int j = 0; j < 8; ++j) { const int c4 = j * 64 + lane; const float4 gg = ((const float4*)g)[c4], sh = ((const float4*)mg)[c4], sc = ((const float4*)(mg + D))[c4];
            float4 y; y.x = v[j].x * rstd * gg.x * (1.f + sc.x) + sh.x; y.y = v[j].y * rstd * gg.y * (1.f + sc.y) + sh.y; y.z = v[j].z * rstd * gg.z * (1.f + sc.z) + sh.z; y.w = v[j].w * rstd * gg.w * (1.f + sc.w) + sh.w;
            o[c4] = y; }
    }
}
__global__ __launch_bounds__(512) void k_final_norm(const float* __restrict__ X, const float* __restrict__ g, float* __restrict__ out) {
    const int lane = threadIdx.x & 63, gw = blockIdx.x * 8 + (threadIdx.x >> 6), ngw = gridDim.x * 8;
    for (int q = gw; q < BATCH * SEQ; q += ngw) {
        const int b = q / SEQ, t = q % SEQ, r = b * TB + t;
        const float4* xr = (const float4*)(X + (size_t)r * D);
        float4 v[8]; float ss = 0.f;
#pragma unroll
        for (int j = 0; j < 8; ++j) { v[j] = xr[j * 64 + lane]; ss += v[j].x * v[j].x + v[j].y * v[j].y + v[j].z * v[j].z + v[j].w * v[j].w; }
        const float rstd = rsqrtf(wave_sum(ss) * (1.0f / D) + EPS);
        float4* o = (float4*)(out + (size_t)q * D);
#pragma unroll
        for (int j = 0; j < 8; ++j) { const int c4 = j * 64 + lane; const float4 gg = ((const float4*)g)[c4];
            float4 y; y.x = v[j].x * rstd * gg.x; y.y = v[j].y * rstd * gg.y; y.z = v[j].z * rstd * gg.z; y.w = v[j].w * rstd * gg.w; o[c4] = y; }
    }
}

enum { EP_STORE = 0, EP_GELU = 1, EP_RELU2 = 2, EP_RES = 3 };
__device__ __forceinline__ float gelu_tanh(float x) { return 0.5f * x * (1.0f + tanhf(0.7978845608028654f * (x + 0.044715f * x * x * x))); }
template <int EPI>
__global__ __launch_bounds__(256) void k_sgemm(const float* __restrict__ A, int lda, const float* __restrict__ W, int ldw, int K, float* __restrict__ C, int ldc,
                                               const float* __restrict__ bias, const float* __restrict__ gate  ) {
    __shared__ float As[16][132];
    __shared__ float Bs[16][128];
    const int tid = threadIdx.x, tx = tid & 15, ty = tid >> 4;
    const int m0 = blockIdx.y * 128, n0 = blockIdx.x * 128;
    float acc[8][8];
#pragma unroll
    for (int i = 0; i < 8; ++i)
#pragma unroll
        for (int j = 0; j < 8; ++j) acc[i][j] = 0.f;
    const int ar = tid >> 2, ak = (tid & 3) * 4, bk = tid >> 5, bn = (tid & 31) * 4;
    const float* Ap0 = A + (size_t)(m0 + ar) * lda + ak; const float* Ap1 = A + (size_t)(m0 + ar + 64) * lda + ak;
    const float* Wp0 = W + (size_t)bk * ldw + n0 + bn; const float* Wp1 = W + (size_t)(bk + 8) * ldw + n0 + bn;
    for (int k0 = 0; k0 < K; k0 += 16) {
        const float4 a0 = *(const float4*)(Ap0 + k0), a1 = *(const float4*)(Ap1 + k0);
        const float4 b0 = *(const float4*)(Wp0 + (size_t)k0 * ldw), b1 = *(const float4*)(Wp1 + (size_t)k0 * ldw);
        __syncthreads();
        As[ak + 0][ar] = a0.x; As[ak + 1][ar] = a0.y; As[ak + 2][ar] = a0.z; As[ak + 3][ar] = a0.w;
        As[ak + 0][ar + 64] = a1.x; As[ak + 1][ar + 64] = a1.y; As[ak + 2][ar + 64] = a1.z; As[ak + 3][ar + 64] = a1.w;
        *(float4*)&Bs[bk][bn] = b0; *(float4*)&Bs[bk + 8][bn] = b1;
        __syncthreads();
#pragma unroll
        for (int k = 0; k < 16; ++k) {
            const float4 x0 = *(const float4*)&As[k][ty * 4], x1 = *(const float4*)&As[k][64 + ty * 4];
            const float4 y0 = *(const float4*)&Bs[k][tx * 4], y1 = *(const float4*)&Bs[k][64 + tx * 4];
            const float a[8] = {x0.x, x0.y, x0.z, x0.w, x1.x, x1.y, x1.z, x1.w}, b[8] = {y0.x, y0.y, y0.z, y0.w, y1.x, y1.y, y1.z, y1.w};
#pragma unroll
            for (int i = 0; i < 8; ++i)
#pragma unroll
                for (int j = 0; j < 8; ++j) acc[i][j] += a[i] * b[j];
        }
    }
#pragma unroll
    for (int i = 0; i < 8; ++i) {
        const int r = m0 + (i < 4 ? ty * 4 + i : 64 + ty * 4 + (i - 4));
        const float* gp = (EPI == EP_RES) ? gate + (size_t)row_group(r) * MODW : nullptr;
#pragma unroll
        for (int jh = 0; jh < 2; ++jh) {
            const int cn = n0 + jh * 64 + tx * 4;
            float4 v = {acc[i][jh * 4 + 0], acc[i][jh * 4 + 1], acc[i][jh * 4 + 2], acc[i][jh * 4 + 3]};
            if (bias) { const float4 bb = *(const float4*)(bias + cn); v.x += bb.x; v.y += bb.y; v.z += bb.z; v.w += bb.w; }
            float4* cp = (float4*)(C + (size_t)r * ldc + cn);
            if (EPI == EP_GELU) { v.x = gelu_tanh(v.x); v.y = gelu_tanh(v.y); v.z = gelu_tanh(v.z); v.w = gelu_tanh(v.w); }
            if (EPI == EP_RELU2) { v.x = v.x > 0.f ? v.x * v.x : 0.f; v.y = v.y > 0.f ? v.y * v.y : 0.f; v.z = v.z > 0.f ? v.z * v.z : 0.f; v.w = v.w > 0.f ? v.w * v.w : 0.f; }
            if (EPI == EP_RES) { const float4 gg = *(const float4*)(gp + cn); const float4 o = *cp; v.x = o.x + gg.x * v.x; v.y = o.y + gg.y * v.y; v.z = o.z + gg.z * v.z; v.w = o.w + gg.w * v.w; }
            *cp = v;
        }
    }
}

__global__ __launch_bounds__(512) void k_ln_stats(const float* __restrict__ Z, float* __restrict__ st) {
    const int lane = threadIdx.x & 63, gw = blockIdx.x * 8 + (threadIdx.x >> 6), ngw = gridDim.x * 8;
    for (int r = gw; r < NR; r += ngw) {
        const float4* vr = (const float4*)(Z + (size_t)r * 4096 + GW);
        float4 v[8]; float s = 0.f;
#pragma unroll
        for (int j = 0; j < 8; ++j) { v[j] = vr[j * 64 + lane]; s += v[j].x + v[j].y + v[j].z + v[j].w; }
        const float mean = wave_sum(s) * (1.0f / GW); float q = 0.f;
#pragma unroll
        for (int j = 0; j < 8; ++j) { const float a = v[j].x - mean, b = v[j].y - mean, c = v[j].z - mean, d = v[j].w - mean; q += a * a + b * b + c * c + d * d; }
        const float rstd = rsqrtf(wave_sum(q) * (1.0f / GW) + EPS);
        if (lane == 0) { st[2 * r] = mean; st[2 * r + 1] = rstd; }
    }
}
__global__ __launch_bounds__(256) void k_gmlp_spatial(const float* __restrict__ Z, const float* __restrict__ st, const float* __restrict__ lng, const float* __restrict__ ws, const float* __restrict__ bs, float* __restrict__ G) {
    extern __shared__ float vn[];
    const int chunk = blockIdx.x, g = blockIdx.y, tid = threadIdx.x;
    const int r0 = chunk * CHUNK;
    for (int i = tid; i < 128 * 128; i += 256) { const int q = i >> 7, c = i & 127; const int r = r0 + q;
        vn[i] = (Z[(size_t)r * 4096 + GW + g * GC + c] - st[2 * r]) * st[2 * r + 1] * lng[g * GC + c]; }
    __syncthreads();
    const int c = tid & 127, ph = tid >> 7;
    const float* wg = ws + (size_t)g * 128 * 128;
    for (int p = ph * 64; p < ph * 64 + 64; ++p) {
        float a = 0.f;
        for (int q = 0; q < 128; ++q) a += wg[p * 128 + q] * vn[q * 128 + c];
        const int r = r0 + p;
        G[(size_t)r * GW + g * GC + c] = Z[(size_t)r * 4096 + g * GC + c] * (a + bs[g * CHUNK + p]);
    }
}

__global__ __launch_bounds__(256) void k_rope_b(float* __restrict__ QKV, const float* __restrict__ tab) {
    const size_t total = (size_t)NR * 32 * 64;
    for (size_t i = (size_t)blockIdx.x * 256 + threadIdx.x; i < total; i += (size_t)gridDim.x * 256) {
        const int p = (int)(i & 63), vec = (int)((i >> 6) & 31), r = (int)(i >> 11);
        const int t = r % TB; if (t >= SEQ) continue;
        const int half = p >> 5, f = p & 31, pos = half ? (t % GRID_W) : (t / GRID_W);
        const float cs = tab[pos * 32 + f], sn = tab[4096 + pos * 32 + f];
        float* v = QKV + (size_t)r * NQKV + vec * 128 + half * 64 + f;
        const float x1 = v[0], x2 = v[32];
        v[0] = x1 * cs - x2 * sn; v[32] = x2 * cs + x1 * sn;
    }
}
__global__ __launch_bounds__(256) void k_rope_c(float* __restrict__ base, int ld, int off, int nvec, int vstride, const float* __restrict__ tab) {
    const size_t total = (size_t)NR * nvec * 32;
    for (size_t i = (size_t)blockIdx.x * 256 + threadIdx.x; i < total; i += (size_t)gridDim.x * 256) {
        const int p = (int)(i & 31); const size_t rest = i >> 5; const int vec = (int)(rest % nvec), r = (int)(rest / nvec);
        const int t = r % TB; if (t >= SEQ) continue;
        const int half = p >> 4, f = p & 15, pos = half ? (t % GRID_W) : (t / GRID_W);
        const float cs = tab[8192 + pos * 16 + f], sn = tab[8192 + 2048 + pos * 16 + f];
        float* v = base + (size_t)r * ld + off + vec * vstride + half * 32 + f;
        const float x1 = v[0], x2 = v[16];
        v[0] = x1 * cs - x2 * sn; v[16] = x2 * cs + x1 * sn;
    }
}

template <int DQK, int DV>
__global__ __launch_bounds__(256) void k_attn_naive(const float* __restrict__ Q, int ldq, int qhs, const float* __restrict__ K1, int ldk1, int k1hs, const float* __restrict__ K2, int ldk2,
                                                    const float* __restrict__ V, int ldv, int vhs, int vhdiv, float* __restrict__ O, int ldo, int ohs, int qoff, int koff, int nk, float scale) {
    extern __shared__ float sm[];
    float* Qs = sm;
    float* Ks = Qs + 64 * (DQK + 1);
    float* Vs = Ks + 32 * (DQK + 1);
    float* Ps = Vs + 32 * DV;
    const int tid = threadIdx.x, tx = tid & 15, ty = tid >> 4, hh = blockIdx.y, b = blockIdx.z;
    const int q0 = b * TB + qoff + blockIdx.x * 64, k0r = b * TB + koff;
    for (int i = tid; i < 64 * DQK; i += 256) { const int r = i / DQK, d = i % DQK; Qs[r * (DQK + 1) + d] = Q[(size_t)(q0 + r) * ldq + hh * qhs + d]; }
    float m[4], l[4], o[4][DV / 16];
#pragma unroll
    for (int i = 0; i < 4; ++i) { m[i] = -1e30f; l[i] = 0.f;
#pragma unroll
        for (int j = 0; j < DV / 16; ++j) o[i][j] = 0.f; }
    for (int kt = 0; kt < nk; kt += 32) {
        __syncthreads();
        for (int i = tid; i < 32 * DQK; i += 256) { const int kk = i / DQK, d = i % DQK; const size_t kr = (size_t)(k0r + kt + kk);
            Ks[kk * (DQK + 1) + d] = (d < 128) ? K1[kr * ldk1 + hh * k1hs + d] : K2[kr * ldk2 + (d - 128)]; }
        for (int i = tid; i < 32 * DV; i += 256) { const int kk = i / DV, e = i % DV; Vs[i] = V[(size_t)(k0r + kt + kk) * ldv + (hh / vhdiv) * vhs + e]; }
        __syncthreads();
        float s[4][2];
#pragma unroll
        for (int i = 0; i < 4; ++i) { s[i][0] = 0.f; s[i][1] = 0.f; }
        for (int d = 0; d < DQK; ++d) {
            const float ka = Ks[(tx * 2) * (DQK + 1) + d], kb = Ks[(tx * 2 + 1) * (DQK + 1) + d];
#pragma unroll
            for (int i = 0; i < 4; ++i) { const float qv = Qs[(ty * 4 + i) * (DQK + 1) + d]; s[i][0] += qv * ka; s[i][1] += qv * kb; }
        }
#pragma unroll
        for (int i = 0; i < 4; ++i) {
            s[i][0] *= scale; s[i][1] *= scale;
            float mx = fmaxf(s[i][0], s[i][1]);
            mx = fmaxf(mx, __shfl_xor(mx, 1)); mx = fmaxf(mx, __shfl_xor(mx, 2)); mx = fmaxf(mx, __shfl_xor(mx, 4)); mx = fmaxf(mx, __shfl_xor(mx, 8));
            const float mn = fmaxf(m[i], mx), alpha = expf(m[i] - mn);
            const float p0 = expf(s[i][0] - mn), p1 = expf(s[i][1] - mn);
            float rs = p0 + p1; rs += __shfl_xor(rs, 1); rs += __shfl_xor(rs, 2); rs += __shfl_xor(rs, 4); rs += __shfl_xor(rs, 8);
            l[i] = l[i] * alpha + rs; m[i] = mn;
#pragma unroll
            for (int j = 0; j < DV / 16; ++j) o[i][j] *= alpha;
            Ps[(ty * 4 + i) * 33 + tx * 2] = p0; Ps[(ty * 4 + i) * 33 + tx * 2 + 1] = p1;
        }
        __syncthreads();
        for (int kk = 0; kk < 32; ++kk) {
            float p[4];
#pragma unroll
            for (int i = 0; i < 4; ++i) p[i] = Ps[(ty * 4 + i) * 33 + kk];
#pragma unroll
            for (int j = 0; j < DV / 16; ++j) { const float vv = Vs[kk * DV + tx + 16 * j];
#pragma unroll
                for (int i = 0; i < 4; ++i) o[i][j] += p[i] * vv; }
        }
    }
#pragma unroll
    for (int i = 0; i < 4; ++i) { const float il = 1.0f / l[i];
#pragma unroll
        for (int j = 0; j < DV / 16; ++j) O[(size_t)(q0 + ty * 4 + i) * ldo + hh * ohs + tx + 16 * j] = o[i][j] * il; }
}

__global__ __launch_bounds__(512) void k_diff_combine(const float* __restrict__ O, const float* __restrict__ lq1, const float* __restrict__ lk1, const float* __restrict__ lq2, const float* __restrict__ lk2,
                                                      const float* __restrict__ subg, float lambda_init, float* __restrict__ ON) {
    const int lane = threadIdx.x & 63, gw = blockIdx.x * 8 + (threadIdx.x >> 6), ngw = gridDim.x * 8;
    float d1 = lq1[lane] * lk1[lane] + lq1[lane + 64] * lk1[lane + 64], d2 = lq2[lane] * lk2[lane] + lq2[lane + 64] * lk2[lane + 64];
    d1 = wave_sum(d1); d2 = wave_sum(d2);
    const float lam = expf(d1) - expf(d2) + lambda_init;
    for (int u = gw; u < NR * DH; u += ngw) {
        const int r = u / DH, h = u % DH;
        const float4 a = *(const float4*)(O + (size_t)r * 4096 + (2 * h) * 256 + lane * 4), b = *(const float4*)(O + (size_t)r * 4096 + (2 * h + 1) * 256 + lane * 4);
        float4 v; v.x = a.x - lam * b.x; v.y = a.y - lam * b.y; v.z = a.z - lam * b.z; v.w = a.w - lam * b.w;
        const float ss = wave_sum(v.x * v.x + v.y * v.y + v.z * v.z + v.w * v.w);
        const float k = rsqrtf(ss * (1.0f / 256) + EPS) * (1.0f - lambda_init);
        const float4 gg = *(const float4*)(subg + lane * 4);
        float4 y; y.x = v.x * k * gg.x; y.y = v.y * k * gg.y; y.z = v.z * k * gg.z; y.w = v.w * k * gg.w;
        *(float4*)(ON + (size_t)r * 2048 + h * 256 + lane * 4) = y;
    }
}
__global__ __launch_bounds__(512) void k_mla_mid(const float* __restrict__ C, const float* __restrict__ qg, const float* __restrict__ kvg, float* __restrict__ CQn, float* __restrict__ CKVn, float* __restrict__ KR) {
    const int lane = threadIdx.x & 63, gw = blockIdx.x * 8 + (threadIdx.x >> 6), ngw = gridDim.x * 8;
    for (int r = gw; r < NR; r += ngw) {
        const float* cr = C + (size_t)r * 1024;
        float q[7], kv[8]; float sq = 0.f, sk = 0.f;
#pragma unroll
        for (int j = 0; j < 7; ++j) { q[j] = cr[j * 64 + lane]; sq += q[j] * q[j]; }
#pragma unroll
        for (int j = 0; j < 8; ++j) { kv[j] = cr[448 + j * 64 + lane]; sk += kv[j] * kv[j]; }
        const float rq = rsqrtf(wave_sum(sq) * (1.0f / 448) + EPS), rk = rsqrtf(wave_sum(sk) * (1.0f / 512) + EPS);
#pragma unroll
        for (int j = 0; j < 7; ++j) CQn[(size_t)r * 448 + j * 64 + lane] = q[j] * rq * qg[j * 64 + lane];
#pragma unroll
        for (int j = 0; j < 8; ++j) CKVn[(size_t)r * 512 + j * 64 + lane] = kv[j] * rk * kvg[j * 64 + lane];
        KR[(size_t)r * 64 + lane] = cr[960 + lane];
    }
}

template <int EPI> static void sgemm(hipStream_t st, const float* A, int lda, const float* W, int ldw, int M, int N, int K, float* C, int ldc, const float* bias, const float* gate) {
    hipLaunchKernelGGL((k_sgemm<EPI>), dim3(N / 128, M / 128), dim3(256), 0, st, A, lda, W, ldw, K, C, ldc, bias, gate);
}

extern "C" void kernel_launch(void* const* d_in, const int* in_sizes, int n_in, void* d_out, int out_size, void* d_ws, size_t ws_size, hipStream_t stream) {
    if (n_in != N_IN || in_sizes[I_X] != BATCH * SEQ * D || out_size != BATCH * SEQ * D || ws_size < WS_NEED) {
        fprintf(stderr, "kernel_launch: unexpected shapes (n_in %d, x %d, out %d, ws %zu; need ws %zu)\n", n_in, n_in > 0 ? in_sizes[0] : -1, out_size, ws_size, (size_t)WS_NEED);
        return;
    }
    static bool attr = false;
    if (!attr) {
        hipFuncSetAttribute((const void*)k_attn_naive<128, 256>, hipFuncAttributeMaxDynamicSharedMemorySize, 110 * 1024);
        hipFuncSetAttribute((const void*)k_attn_naive<192, 128>, hipFuncAttributeMaxDynamicSharedMemorySize, 110 * 1024);
        hipFuncSetAttribute((const void*)k_gmlp_spatial, hipFuncAttributeMaxDynamicSharedMemorySize, 64 * 1024);
        attr = true;
    }
    const float* in[N_IN]; for (int i = 0; i < N_IN; ++i) in[i] = (const float*)d_in[i];
    unsigned char* ws = (unsigned char*)d_ws;
    float* mod = (float*)(ws + WS_MOD); float* tab = (float*)(ws + WS_ROPE); float* X = (float*)(ws + WS_X);
    float* XN = (float*)(ws + SL_XN); float* BIG = (float*)(ws + SL_BIG); float* B2 = (float*)(ws + SL_B2); float* B3 = (float*)(ws + SL_B3); float* ST = (float*)(ws + SL_ST);
    hipMemsetAsync(ws + WS_CTL, 0, 1 * MiB, stream);
    hipLaunchKernelGGL(k_copy_x, dim3(2048), dim3(256), 0, stream, in[I_X], in[I_CTX], X);
    hipLaunchKernelGGL(k_rope_tables, dim3(16), dim3(256), 0, stream, tab);
    hipLaunchKernelGGL(k_mod, dim3(768), dim3(512), 0, stream, in[I_C], in[I_CCTX], in[I_WMOD], in[I_BMOD], mod);
    for (int l = 0; l < DEPTH; ++l) {
        const int kind = l % 3, idx = l / 3;
        const float* modl = mod + (size_t)l * 3 * MODW;
        hipLaunchKernelGGL(k_norm_mod, dim3(1024), dim3(512), 0, stream, X, in[I_N1G] + (size_t)l * D, modl, 0, XN);
        if (kind == 0) {
            float* Z = BIG; float* G = B3;
            sgemm<EP_GELU>(stream, XN, D, in[I_AWIN] + (size_t)idx * D * 4096, 4096, NR, 4096, D, Z, 4096, in[I_ABIN] + (size_t)idx * 4096, nullptr);
            hipLaunchKernelGGL(k_ln_stats, dim3(1024), dim3(512), 0, stream, Z, ST);
            hipLaunchKernelGGL(k_gmlp_spatial, dim3(NR / CHUNK, GG), dim3(256), 64 * 1024, stream, Z, ST, in[I_ALNG] + (size_t)idx * GW, in[I_AWS] + (size_t)idx * GG * 128 * 128, in[I_ABS] + (size_t)idx * GG * CHUNK, G);
            sgemm<EP_RES>(stream, G, GW, in[I_AWOUT] + (size_t)idx * GW * D, D, NR, D, GW, X, D, nullptr, modl + 2 * D);
        } else if (kind == 1) {
            float* QKV = BIG; float* O = B2; float* ON = B3;
            const float lambda_init = (float)(0.8 - 0.6 * exp(-0.3 * (double)l));
            sgemm<EP_STORE>(stream, XN, D, in[I_BWQKV] + (size_t)idx * D * NQKV, NQKV, NR, NQKV, D, QKV, NQKV, nullptr, nullptr);
            hipLaunchKernelGGL(k_rope_b, dim3(4096), dim3(256), 0, stream, QKV, tab);
            const size_t shm = (size_t)(64 * 129 + 32 * 129 + 32 * 256 + 64 * 33) * 4;
            const float scale = 1.0f / sqrtf(128.0f);
            hipLaunchKernelGGL((k_attn_naive<128, 256>), dim3(SEQ / 64, 16, BATCH), dim3(256), shm, stream, QKV, NQKV, 128, QKV + 2048, NQKV, 128, (const float*)nullptr, 0, QKV + 4096, NQKV, 256, 2, O, 4096, 256, 0, 0, TB, scale);
            hipLaunchKernelGGL((k_attn_naive<128, 256>), dim3(CTXL / 64, 16, BATCH), dim3(256), shm, stream, QKV, NQKV, 128, QKV + 2048, NQKV, 128, (const float*)nullptr, 0, QKV + 4096, NQKV, 256, 2, O, 4096, 256, SEQ, SEQ, CTXL, scale);
            hipLaunchKernelGGL(k_diff_combine, dim3(1024), dim3(512), 0, stream, O, in[I_BLQ1] + idx * 128, in[I_BLK1] + idx * 128, in[I_BLQ2] + idx * 128, in[I_BLK2] + idx * 128, in[I_BSUBG] + idx * 256, lambda_init, ON);
            sgemm<EP_RES>(stream, ON, 2048, in[I_BWO] + (size_t)idx * 2048 * D, D, NR, D, 2048, X, D, nullptr, modl + 2 * D);
        } else {
            float* C = B3;
            float* CQn = B3 + (size_t)NR * 1024;
            float* CKVn = CQn + (size_t)NR * 448;
            float* KR = CKVn + (size_t)NR * 512;
            float* Qm = BIG;
            float* KVm = BIG + (size_t)NR * 3072;
            float* OM = B2;
            sgemm<EP_STORE>(stream, XN, D, in[I_CWDQKV] + (size_t)idx * D * 1024, 1024, NR, 1024, D, C, 1024, nullptr, nullptr);
            hipLaunchKernelGGL(k_mla_mid, dim3(1024), dim3(512), 0, stream, C, in[I_CQNG] + idx * MQR, in[I_CKVNG] + idx * MKVR, CQn, CKVn, KR);
            hipLaunchKernelGGL(k_rope_c, dim3(1024), dim3(256), 0, stream, KR, 64, 0, 1, 0, tab);
            sgemm<EP_STORE>(stream, CQn, MQR, in[I_CWUQ] + (size_t)idx * MQR * 3072, 3072, NR, 3072, MQR, Qm, 3072, nullptr, nullptr);
            hipLaunchKernelGGL(k_rope_c, dim3(4096), dim3(256), 0, stream, Qm, 3072, 128, 16, 192, tab);
            sgemm<EP_STORE>(stream, CKVn, MKVR, in[I_CWUKV] + (size_t)idx * MKVR * 4096, 4096, NR, 4096, MKVR, KVm, 4096, nullptr, nullptr);
            const size_t shm = (size_t)(64 * 193 + 32 * 193 + 32 * 128 + 64 * 33) * 4;
            const float scale = 1.0f / sqrtf(192.0f);
            hipLaunchKernelGGL((k_attn_naive<192, 128>), dim3(SEQ / 64, 16, BATCH), dim3(256), shm, stream, Qm, 3072, 192, KVm, 4096, 256, KR, 64, KVm + 128, 4096, 256, 1, OM, 2048, 128, 0, 0, TB, scale);
            sgemm<EP_RES>(stream, OM, 2048, in[I_CWO] + (size_t)idx * 2048 * D, D, NR, D, 2048, X, D, nullptr, modl + 2 * D);
        }
        hipLaunchKernelGGL(k_norm_mod, dim3(1024), dim3(512), 0, stream, X, in[I_N2G] + (size_t)l * D, modl, 1, XN);
        sgemm<EP_RELU2>(stream, XN, D, in[I_WFF1] + (size_t)l * D * DFF, DFF, NR, DFF, D, BIG, DFF, nullptr, nullptr);
        sgemm<EP_RES>(stream, BIG, DFF, in[I_WFF2] + (size_t)l * DFF * D, D, NR, D, DFF, X, D, nullptr, modl + 5 * D);
    }
    hipLaunchKernelGGL(k_final_norm, dim3(1024), dim3(512), 0, stream, X, in[I_FING], (float*)d_out);
}
```

```cpp
#include <hip/hip_runtime.h>
#include <cstdio>
#include <cstdint>
#include <cmath>

constexpr int D = 2048, BATCH = 2, SEQ = 8192, DEPTH = 4, GRID_W = 64, CTXL = 256;
constexpr int DFF = 8192, NMOD = 6;
constexpr int TB = SEQ + CTXL;
constexpr int NR = BATCH * TB;
constexpr float EPS = 1e-6f;
constexpr int GW = 2048, GG = 16, GC = 128, CHUNK = 128;
constexpr int DH = 8, DHD = 128, DVD = 256, NQKV = 6144;
constexpr int MH = 16, MQR = 448, MKVR = 512, MNOPE = 128, MROPE = 64, MV = 128, MQK = 192;
constexpr int MODW = NMOD * D;

enum { I_X = 0, I_C, I_CTX, I_CCTX, I_WMOD, I_BMOD, I_N1G, I_N2G, I_WFF1, I_WFF2, I_AWIN, I_ABIN, I_ALNG, I_AWS, I_ABS, I_AWOUT,
       I_BWQKV, I_BLQ1, I_BLK1, I_BLQ2, I_BLK2, I_BSUBG, I_BWO, I_CWDQKV, I_CQNG, I_CWUQ, I_CKVNG, I_CWUKV, I_CWO, I_FING, N_IN };

constexpr size_t MiB = 1u << 20;
constexpr size_t WS_CTL = 0;
constexpr size_t WS_MOD = 1 * MiB;
constexpr size_t WS_ROPE = 2 * MiB;
constexpr size_t WS_X = 4 * MiB;
constexpr size_t WS_WB = 136 * MiB;
constexpr size_t WB_FF1 = 0, WB_FF2 = WB_FF1 + (size_t)4 * D * DFF, WB_AWIN = WB_FF2 + (size_t)4 * D * DFF, WB_AWOUT = WB_AWIN + (size_t)2 * D * 4096,
                 WB_BQKV = WB_AWOUT + (size_t)2 * D * D, WB_BWO = WB_BQKV + (size_t)D * NQKV, WB_CDQKV = WB_BWO + (size_t)D * D, WB_CUQ = WB_CDQKV + (size_t)D * 1024,
                 WB_CUKV = WB_CUQ + (size_t)512 * 3072, WB_CWO = WB_CUKV + (size_t)512 * 4096, WB_AWS = WB_CWO + (size_t)D * D, WB_END = WB_AWS + (size_t)2 * GG * 128 * 128;
static_assert(WB_END * 2 <= 360 * MiB, "weights region");
constexpr size_t WS_S0 = 496 * MiB;
constexpr size_t SL_XN = WS_S0;
constexpr size_t SL_BIG = SL_XN + 132 * MiB;
constexpr size_t SL_B2 = SL_BIG + 528 * MiB;
constexpr size_t SL_ST = SL_B2 + 264 * MiB;
constexpr size_t FA_XN = WS_S0;
constexpr size_t FA_H = FA_XN + 66 * MiB;
constexpr size_t FA_B = FA_H + 264 * MiB;
constexpr size_t FA_END = FA_B + 152 * MiB;
constexpr size_t WS_NEED = FA_END;
static_assert(WS_NEED <= 1536 * MiB && SL_ST + 1 * MiB <= 1536 * MiB, "workspace");

__device__ __forceinline__ int row_group(int r) { return (r % TB) >= SEQ ? 2 : r / TB; }
namespace pg8 {
#define PG8_LAS __attribute__((address_space(3)))
typedef unsigned short bf16_t;
typedef short bf16x8 __attribute__((ext_vector_type(8)));
typedef float f32x4 __attribute__((ext_vector_type(4)));
typedef unsigned u32x4 __attribute__((ext_vector_type(4)));
constexpr int BM = 256, BK = 64, HALF = 128, HTB = HALF * BK * 2  , STAGE_BYTES = 8 * HTB, NXCD = 8, WGM = 8;

__host__ __device__ __forceinline__ int lds_byte(int r, int c) { const int st = (r >> 4) * 2 + (c >> 5), rr = r & 15, cc = c & 31, ob = rr * 64 + cc * 2; return st * 1024 + (ob ^ (((ob >> 9) & 1) << 5)); }
__host__ __device__ __forceinline__ void stage_rc(int b, int& R, int& C) { const int st = b / 1024, sb = b % 1024, swz = sb ^ (((sb >> 9) & 1) << 5); R = (st >> 1) * 16 + swz / 64; C = (st & 1) * 32 + (swz % 64) / 2; }
__host__ __device__ __forceinline__ int perm32(int rho) { const int n = rho >> 4, i = rho & 15; return 8 * (i >> 2) + 4 * n + (i & 3); }

struct Unit { int pm, pn; };
struct Gemm { const bf16_t* A; const bf16_t* Bt; int M, N, K; unsigned* ctxcnt = nullptr; unsigned ctxwant = 0; };

struct StaticOrder {
    int nM, nN, nwg, G, c, lat;
    __host__ __device__ void init(int M, int N, int G_, int c_, int lat_ = 0) { nM = M / BM; nN = N / BM; nwg = nM * nN; G = G_; c = c_; lat = lat_; }
    __host__ __device__ bool next(int i, Unit& u) const {
        const long L = (long)i * G + c; if (L >= nwg) return false;
        int wgid = (int)L; { const int q = nwg / NXCD, r = nwg % NXCD, xcd = wgid % NXCD, off = wgid / NXCD; wgid = (xcd < r ? xcd * (q + 1) : r * (q + 1) + (xcd - r) * q) + off; }
        const int nig = WGM * nN, gid = wgid / nig, fm = gid * WGM, gsz = (nM - fm) < WGM ? (nM - fm) : WGM;
        u.pm = fm + ((wgid % nig) % gsz); u.pn = (wgid % nig) / gsz; if (lat) u.pm += (u.pm >= 32) ? 1 : 0; return true;
    }
    __device__ __forceinline__ void a_ready(const Unit&) const {}
    __device__ __forceinline__ void done(const Unit&) const {}
};

__device__ __forceinline__ unsigned cvt_pk_bf16(float lo, float hi) { unsigned r; asm volatile("v_cvt_pk_bf16_f32 %0, %1, %2" : "=v"(r) : "v"(lo), "v"(hi)); return r; }
typedef float f32x2 __attribute__((ext_vector_type(2)));
__device__ __forceinline__ f32x2 gelu_pk(f32x2 v) {
    const f32x2 av = __builtin_elementwise_abs(v), d = av * 0.2316418882f + 1.0f;
    f32x2 t; t.x = __builtin_amdgcn_rcpf(d.x); t.y = __builtin_amdgcn_rcpf(d.y);
    f32x2 q = t * 0.5307027145f + (-0.7265760135f); q = q * t + 0.7107068705f; q = q * t + (-0.142248368f); q = q * t + 0.127414796f; q = q * t;
    const f32x2 s = (v * v) * (-0.72134752044f);
    f32x2 e; e.x = __builtin_amdgcn_exp2f(s.x); e.y = __builtin_amdgcn_exp2f(s.y);
    const f32x2 m = v * (q * e), r = v - m;
    f32x2 o; o.x = v.x < 0.f ? m.x : r.x; o.y = v.y < 0.f ? m.y : r.y; return o;
}

template <class Epi, class Sched, bool ALIGN_EPI = false, bool SP2 = false, bool CTXMINI = false, int KSPLIT = 1>
__device__ __forceinline__ void gemm_phase(PG8_LAS unsigned char* lds, const Gemm g, const Sched& S, const Epi& E) {
    const int tid = threadIdx.x, wid = __builtin_amdgcn_readfirstlane(tid >> 6), lane = tid & 63, wr = wid >> 2, wc = wid & 3, fr = lane & 15, fq = lane >> 4;
    const int K = g.K, nt = K / BK;
    unsigned voffA[2], voffB[2];
#pragma unroll
    for (int i = 0; i < 2; ++i) { int R, C; stage_rc(tid * 16 + i * 8192, R, C); const int Rb = Epi::PERM ? ((R & ~31) + perm32(R & 31)) : R;
        voffA[i] = (unsigned)(R * K + C) * 2u; voffB[i] = (unsigned)(Rb * K + C) * 2u; }
    const size_t kstep = (size_t)(BK * 2);
    const size_t hstep = (size_t)HALF * K * 2;
    const size_t tstep = 2 * hstep;
    const unsigned ldsw = (unsigned)wid * 1024u;
    const int aoff = lds_byte(wr * 64 + fr, fq * 8), boff = lds_byte(wc * 32 + fr, fq * 8);
#define PG8_SA(b, h) (((b) * 2 + (h)) * HTB)
#define PG8_SB(b, h) ((4 + (b) * 2 + (h)) * HTB)
#define PG8_STAGE(bufoff, gbase, voff) do { _Pragma("unroll") for (int _i = 0; _i < 2; ++_i) \
        __builtin_amdgcn_global_load_lds((const unsigned*)((const char*)(gbase) + (voff)[_i]), (PG8_LAS unsigned*)(lds + (bufoff) + ldsw + _i * 8192), 16, 0, 0); } while (0)
#define PG8_LDA(dst, b, h) do { _Pragma("unroll") for (int m = 0; m < 4; ++m) _Pragma("unroll") for (int k = 0; k < 2; ++k) dst[m][k] = *(const PG8_LAS bf16x8*)(lds + PG8_SA(b, h) + aoff + m * 2048 + k * 1024); } while (0)
#define PG8_LDB(dst, b, h) do { _Pragma("unroll") for (int n = 0; n < 2; ++n) _Pragma("unroll") for (int k = 0; k < 2; ++k) dst[n][k] = *(const PG8_LAS bf16x8*)(lds + PG8_SB(b, h) + boff + n * 2048 + k * 1024); } while (0)
#define PG8_MMA(ai, bj, At, Bt) do { __builtin_amdgcn_s_setprio(1); _Pragma("unroll") for (int m = 0; m < 4; ++m) _Pragma("unroll") for (int n = 0; n < 2; ++n) _Pragma("unroll") for (int k = 0; k < 2; ++k) \
        acc[ai][bj][m][n] = __builtin_amdgcn_mfma_f32_16x16x32_bf16(Bt[n][k], At[m][k], acc[ai][bj][m][n], 0, 0, 0); __builtin_amdgcn_s_setprio(0); } while (0)
#define PG8_WAIT_V(n) asm volatile("s_waitcnt vmcnt(" #n ")" ::: "memory")
#define PG8_WAIT_L(n) asm volatile("s_waitcnt lgkmcnt(" #n ")" ::: "memory")
#define PG8_BAR __builtin_amdgcn_s_barrier()
#define PG8_SCHED __builtin_amdgcn_sched_barrier(0)
    Unit cur, nxt; int ui = 0;
    if (!S.next(0, cur)) return;
    f32x4 acc[2][2][4][2];
#pragma unroll
    for (int a = 0; a < 2; ++a)
#pragma unroll
        for (int b = 0; b < 2; ++b)
#pragma unroll
            for (int m = 0; m < 4; ++m)
#pragma unroll
                for (int n = 0; n < 2; ++n) acc[a][b][m][n] = (f32x4){0.f, 0.f, 0.f, 0.f};
    bf16x8 At[4][2], B0[2][2], B1[2][2];
    const char* cA = (const char*)g.A + (size_t)cur.pm * tstep; const char* cB = (const char*)g.Bt + (size_t)cur.pn * tstep;
    S.a_ready(cur);
    if constexpr (SP2) {
        PG8_STAGE(PG8_SB(0, 0), cB, voffB); PG8_STAGE(PG8_SB(0, 1), cB + hstep, voffB); PG8_STAGE(PG8_SA(0, 0), cA, voffA); PG8_STAGE(PG8_SA(0, 1), cA + hstep, voffA);
        if (wr == 1) PG8_BAR;
        PG8_WAIT_V(2); PG8_BAR;
        PG8_STAGE(PG8_SB(1, 0), cB + kstep, voffB); PG8_STAGE(PG8_SA(1, 0), cA + kstep, voffA); PG8_STAGE(PG8_SB(1, 1), cB + hstep + kstep, voffB);
        PG8_WAIT_V(6); PG8_BAR;
    } else {
        PG8_STAGE(PG8_SB(0, 0), cB, voffB); PG8_STAGE(PG8_SA(0, 0), cA, voffA); PG8_STAGE(PG8_SB(0, 1), cB + hstep, voffB); PG8_STAGE(PG8_SA(0, 1), cA + hstep, voffA);
        if (wr == 1) PG8_BAR;
        PG8_WAIT_V(4); PG8_BAR;
        PG8_STAGE(PG8_SB(1, 0), cB + kstep, voffB); PG8_STAGE(PG8_SA(1, 0), cA + kstep, voffA); PG8_STAGE(PG8_SB(1, 1), cB + hstep + kstep, voffB);
        PG8_WAIT_V(6); PG8_BAR;
    }
    for (;;) {
        const bool has_next = S.next(ui + 1, nxt);
        const char* nA = has_next ? (const char*)g.A + (size_t)nxt.pm * tstep : cA; const char* nB = has_next ? (const char*)g.Bt + (size_t)nxt.pn * tstep : cB;
        for (int t = 0; t < nt; t += 2) {
            const bool last = (t == nt - 2);
            const char* a1 = cA + (size_t)(t + 1) * kstep;
            const char* a2 = last ? nA : cA + (size_t)(t + 2) * kstep; const char* b2 = last ? nB : cB + (size_t)(t + 2) * kstep;
            const char* a3 = a2 + kstep; const char* b3 = b2 + kstep;
            if (last && has_next) S.a_ready(nxt);
            if constexpr (SP2) {
            PG8_LDB(B0, 0, 0); PG8_LDB(B1, 0, 1); PG8_SCHED; PG8_LDA(At, 0, 0); PG8_STAGE(PG8_SA(1, 1), a1 + hstep, voffA);
            PG8_WAIT_V(8); PG8_WAIT_L(0); PG8_BAR; PG8_MMA(0, 0, At, B0); PG8_MMA(0, 1, At, B1); PG8_BAR; PG8_SCHED;
            PG8_LDA(At, 0, 1); PG8_STAGE(PG8_SB(0, 0), b2, voffB); PG8_STAGE(PG8_SB(0, 1), b2 + hstep, voffB); PG8_STAGE(PG8_SA(0, 0), a2, voffA);
            PG8_WAIT_V(8); PG8_WAIT_L(0); PG8_BAR; PG8_MMA(1, 0, At, B0); PG8_MMA(1, 1, At, B1); PG8_BAR; PG8_SCHED;
            PG8_LDB(B0, 1, 0); PG8_LDB(B1, 1, 1); PG8_SCHED; PG8_LDA(At, 1, 0); PG8_STAGE(PG8_SA(0, 1), a2 + hstep, voffA);
            PG8_WAIT_V(8); PG8_WAIT_L(0); PG8_BAR; PG8_MMA(0, 0, At, B0); PG8_MMA(0, 1, At, B1); PG8_BAR; PG8_SCHED;
            PG8_LDA(At, 1, 1); PG8_STAGE(PG8_SB(1, 0), b3, voffB); PG8_STAGE(PG8_SB(1, 1), b3 + hstep, voffB); PG8_STAGE(PG8_SA(1, 0), a3, voffA);
            PG8_WAIT_V(8); PG8_WAIT_L(0); PG8_BAR; PG8_MMA(1, 0, At, B0); PG8_MMA(1, 1, At, B1); PG8_BAR; PG8_SCHED;
            } else {
            PG8_LDB(B0, 0, 0); PG8_SCHED; PG8_LDA(At, 0, 0); PG8_STAGE(PG8_SA(1, 1), a1 + hstep, voffA);
            PG8_WAIT_L(8); PG8_BAR; PG8_WAIT_L(0); PG8_MMA(0, 0, At, B0); PG8_BAR; PG8_SCHED;
            PG8_LDB(B1, 0, 1); PG8_STAGE(PG8_SB(0, 0), b2, voffB);
            PG8_BAR; PG8_WAIT_L(0); PG8_MMA(0, 1, At, B1); PG8_BAR;
            PG8_LDA(At, 0, 1); PG8_STAGE(PG8_SA(0, 0), a2, voffA);
            PG8_BAR; PG8_WAIT_L(0); PG8_MMA(1, 0, At, B0); PG8_BAR; PG8_SCHED;
            PG8_STAGE(PG8_SB(0, 1), b2 + hstep, voffB);
            PG8_WAIT_V(6); PG8_BAR; PG8_MMA(1, 1, At, B1); PG8_BAR;
            PG8_LDB(B0, 1, 0); PG8_SCHED; PG8_LDA(At, 1, 0); PG8_STAGE(PG8_SA(0, 1), a2 + hstep, voffA);
            PG8_WAIT_L(8); PG8_BAR; PG8_WAIT_L(0); PG8_MMA(0, 0, At, B0); PG8_BAR; PG8_SCHED;
            PG8_LDB(B1, 1, 1); PG8_STAGE(PG8_SB(1, 0), b3, voffB);
            PG8_BAR; PG8_WAIT_L(0); PG8_MMA(0, 1, At, B1); PG8_BAR;
            PG8_LDA(At, 1, 1); PG8_STAGE(PG8_SA(1, 0), a3, voffA);
            PG8_BAR; PG8_WAIT_L(0); PG8_MMA(1, 0, At, B0); PG8_BAR; PG8_SCHED;
            PG8_STAGE(PG8_SB(1, 1), b3 + hstep, voffB);
            PG8_WAIT_V(6); PG8_BAR; PG8_MMA(1, 1, At, B1); PG8_BAR;
            }
        }
        if constexpr (ALIGN_EPI) { if (wr == 0) PG8_BAR; }
        if constexpr (!Epi::AFTER_DRAIN) { E(acc, cur, wr, wc, fr, fq); S.done(cur); }
        if (!has_next) break;
#pragma unroll
        for (int a = 0; a < 2; ++a)
#pragma unroll
            for (int b = 0; b < 2; ++b)
#pragma unroll
                for (int m = 0; m < 4; ++m)
#pragma unroll
                    for (int n = 0; n < 2; ++n) acc[a][b][m][n] = (f32x4){0.f, 0.f, 0.f, 0.f};
        cur = nxt; cA = nA; cB = nB; ++ui;
        if constexpr (ALIGN_EPI) { if (wr == 1) PG8_BAR; }
    }
    PG8_WAIT_V(0);
    if constexpr (!ALIGN_EPI) { if (wr == 0) PG8_BAR; }
    PG8_BAR;
    if constexpr (Epi::AFTER_DRAIN) { E.fused(acc, cur, wr, wc, fr, fq, lds, wid, lane); S.done(cur); }
    if constexpr (CTXMINI) {
        if (g.ctxcnt) {
            if (wid == 0) { unsigned sp = 0;
                for (;;) { if ((unsigned)__builtin_amdgcn_readfirstlane(__hip_atomic_load(g.ctxcnt, __ATOMIC_RELAXED, __HIP_MEMORY_SCOPE_AGENT)) >= g.ctxwant) break;
                    __builtin_amdgcn_s_sleep(2); if (++sp > (1u << 20)) break; }
                __builtin_amdgcn_fence(__ATOMIC_ACQUIRE, "agent"); asm volatile("s_waitcnt vmcnt(0)" ::: "memory"); }
            PG8_BAR; }
#define PG8_MMAQ(Q_, At, Bt) do { __builtin_amdgcn_s_setprio(1); _Pragma("unroll") for (int m = 0; m < 4; ++m) _Pragma("unroll") for (int n = 0; n < 2; ++n) _Pragma("unroll") for (int k = 0; k < 2; ++k) \
        Q_[m][n] = __builtin_amdgcn_mfma_f32_16x16x32_bf16(Bt[n][k], At[m][k], Q_[m][n], 0, 0, 0); __builtin_amdgcn_s_setprio(0); } while (0)
        const int nNm = g.N / BM, nmini = 8 * nNm * KSPLIT, ntm = nt / KSPLIT;
        for (int mi = S.c; mi < nmini; mi += S.G) {
            const int sp = mi % KSPLIT, mq = mi / KSPLIT, bj = mq & 1, pn = (mq >> 1) % nNm, r2 = (mq >> 1) / nNm, ai = r2 & 1, pc = r2 >> 1;
            Unit u; u.pm = 32 + 33 * pc; u.pn = pn;
            const char* mA = (const char*)g.A + (size_t)u.pm * tstep + (size_t)ai * hstep + (size_t)sp * ntm * kstep;
            const char* mB = (const char*)g.Bt + (size_t)pn * tstep + (size_t)bj * hstep + (size_t)sp * ntm * kstep;
            f32x4 aq[4][2];
#pragma unroll
            for (int m = 0; m < 4; ++m)
#pragma unroll
                for (int n = 0; n < 2; ++n) aq[m][n] = (f32x4){0.f, 0.f, 0.f, 0.f};
#define PG8_MINI_STEP(s_, tt_) do { const int t_ = (tt_); \
                if (t_ + 2 < ntm) { PG8_WAIT_V(8); } else if (t_ + 1 < ntm) { PG8_WAIT_V(4); } else { PG8_WAIT_V(0); } \
                PG8_BAR; \
                if (t_ + 3 < ntm) { PG8_STAGE(PG8_SA((((s_) + 3) & 3) >> 1, ((s_) + 3) & 1), mA + (size_t)(t_ + 3) * kstep, voffA); PG8_STAGE(PG8_SB((((s_) + 3) & 3) >> 1, ((s_) + 3) & 1), mB + (size_t)(t_ + 3) * kstep, voffB); } \
                PG8_LDB(B0, (s_) >> 1, (s_) & 1); PG8_LDA(At, (s_) >> 1, (s_) & 1); PG8_WAIT_L(0); PG8_SCHED; \
                PG8_MMAQ(aq, At, B0); PG8_SCHED; } while (0)
            PG8_STAGE(PG8_SA(0, 0), mA, voffA); PG8_STAGE(PG8_SB(0, 0), mB, voffB);
            PG8_STAGE(PG8_SA(0, 1), mA + kstep, voffA); PG8_STAGE(PG8_SB(0, 1), mB + kstep, voffB);
            PG8_STAGE(PG8_SA(1, 0), mA + 2 * kstep, voffA); PG8_STAGE(PG8_SB(1, 0), mB + 2 * kstep, voffB);
            for (int t = 0; t < ntm; t += 4) { PG8_MINI_STEP(0, t); PG8_MINI_STEP(1, t + 1); PG8_MINI_STEP(2, t + 2); PG8_MINI_STEP(3, t + 3); }
#undef PG8_MINI_STEP
            if constexpr (KSPLIT > 1) E.quad_part(aq, u, ai, bj, sp, pc, wr, wc, fr, fq); else E.quad(aq, u, ai, bj, wr, wc, fr, fq);
            PG8_WAIT_V(0);
        }
#undef PG8_MMAQ
    }
#undef PG8_SA
#undef PG8_SB
#undef PG8_STAGE
#undef PG8_LDA
#undef PG8_LDB
#undef PG8_MMA
#undef PG8_WAIT_V
#undef PG8_WAIT_L
#undef PG8_BAR
#undef PG8_SCHED
}
}
#define GAS __attribute__((address_space(1)))
#define LAS __attribute__((address_space(3)))
typedef unsigned short bf16;
typedef unsigned v4u __attribute__((ext_vector_type(4)));
typedef float f32x4 __attribute__((ext_vector_type(4)));
typedef short bf16x8 __attribute__((ext_vector_type(8)));
typedef GAS unsigned gu32;
typedef GAS unsigned long long gu64;
#define RLX_AGENT __ATOMIC_RELAXED, __HIP_MEMORY_SCOPE_AGENT
#define LDS_WAIT() asm volatile("s_waitcnt lgkmcnt(0)" ::: "memory")
#define VM_WAIT() asm volatile("s_waitcnt vmcnt(0)" ::: "memory")
__device__ __forceinline__ unsigned long long rt() { return __builtin_amdgcn_s_memrealtime(); }
__device__ __forceinline__ unsigned f2bf(float f) { unsigned u = __builtin_bit_cast(unsigned, f); return (u + 0x7fffu + ((u >> 16) & 1u)) >> 16; }
__device__ __forceinline__ unsigned pk2(float lo, float hi) { return f2bf(lo) | (f2bf(hi) << 16); }

#define XB_TMO      128
#define XB_XCNT(j)  (256  + 64 * (j))
#define XB_XSUB(j)  (1280 + 64 * (j))
#define XB_XGEN(j)  (2304 + 64 * (j))
#define XB_TOP      3328
#define XB_TOPGEN   3392
#define XCD_BAR_WORDS 3456
#define XB_SPIN_CAP (1u << 18)

__device__ __forceinline__ unsigned xb_ld(unsigned* p)              { return __hip_atomic_load(p, __ATOMIC_RELAXED, __HIP_MEMORY_SCOPE_AGENT); }
__device__ __forceinline__ unsigned xb_add(unsigned* p, unsigned v) { return __hip_atomic_fetch_add(p, v, __ATOMIC_RELAXED, __HIP_MEMORY_SCOPE_AGENT); }
__device__ __forceinline__ unsigned xb_xcc_id() { return (unsigned)__builtin_amdgcn_s_getreg((3 << 11) | 20) & 0xFu; }
#define XB_SPIN(cond, bar) do { unsigned _sp = 0; while (cond) { __builtin_amdgcn_s_sleep(1); \
    if ((++_sp & 255u) == 0u) { if (xb_ld(&(bar)[XB_TMO])) break; if (_sp > XB_SPIN_CAP) { atomicAdd(&(bar)[XB_TMO], 1u); break; } } } } while (0)

struct XcdBarrier {
    unsigned* bar; unsigned x;
    volatile LAS unsigned* st;
};

__device__ __forceinline__ XcdBarrier xcd_barrier_post(unsigned* bar, volatile LAS unsigned* st) {
    XcdBarrier b; b.bar = bar; b.x = xb_xcc_id(); b.st = st;
    if (threadIdx.x == 0) (void)xb_add(&bar[XB_XCNT(b.x)], 1u);
    return b;
}
__device__ __forceinline__ void xcd_barrier_complete(unsigned* bar, unsigned x, unsigned& nloc, unsigned& nx) {
    const unsigned G = gridDim.x * gridDim.y * gridDim.z;
    unsigned sum, cnt, mine, sp = 0u;
    for (;;) {
        sum = 0u; cnt = 0u; mine = 0u;
#pragma unroll
        for (unsigned j = 0; j < 16; ++j) { const unsigned c = xb_ld(&bar[XB_XCNT(j)]); sum += c; cnt += (c > 0u) ? 1u : 0u; mine = (j == x) ? c : mine; }
        if (sum == G) break;
        __builtin_amdgcn_s_sleep(1);
        if ((++sp & 255u) == 0u) { if (xb_ld(&bar[XB_TMO])) break; if (sp > XB_SPIN_CAP) { atomicAdd(&bar[XB_TMO], 1u); break; } }
    }
    nloc = mine > 0u ? mine : 1u; nx = cnt > 0u ? cnt : 1u;
}

__device__ __forceinline__ void xcd_barrier(const XcdBarrier& b) {
    asm volatile("s_waitcnt vmcnt(0)" ::: "memory");
    __syncthreads();
    if (threadIdx.x == 0) {
        unsigned* bar = b.bar;
        __builtin_amdgcn_s_waitcnt(0);
        unsigned nloc = b.st[0], nx = b.st[1];
        if (nloc == 0u) { xcd_barrier_complete(bar, b.x, nloc, nx); b.st[0] = nloc; b.st[1] = nx; }
        const unsigned old = xb_add(&bar[XB_XSUB(b.x)], 1u);
        const unsigned gen = old / nloc;
        if (old + 1u == (gen + 1u) * nloc) {
            __builtin_amdgcn_fence(__ATOMIC_RELEASE, "agent");
            asm volatile("s_waitcnt vmcnt(0)" ::: "memory");
            const unsigned og = xb_add(&bar[XB_TOP], 1u);
            const unsigned tg = og / nx;
            if (og + 1u == (tg + 1u) * nx) xb_add(&bar[XB_TOPGEN], 1u);
            else XB_SPIN(xb_ld(&bar[XB_TOPGEN]) == tg, bar);
            __builtin_amdgcn_fence(__ATOMIC_ACQUIRE, "agent");
            xb_add(&bar[XB_XGEN(b.x)], 1u);
            asm volatile("s_waitcnt vmcnt(0)" ::: "memory");
        } else {
            XB_SPIN(xb_ld(&bar[XB_XGEN(b.x)]) == gen, bar);
            __builtin_amdgcn_fence(__ATOMIC_ACQUIRE, "agent");
            asm volatile("s_waitcnt vmcnt(0)" ::: "memory");
        }
    }
    __syncthreads();
}


constexpr int CW_BAR = 4096;
constexpr int MAX_LAUNCH = 24;
static_assert((CW_BAR + MAX_LAUNCH * XCD_BAR_WORDS) * 4 <= (int)(1 * MiB), "barrier regions inside the zeroed control MiB");
constexpr int RING_BYTES = 155648, LDSCTL_OFF = RING_BYTES, MISC_OFF = LDSCTL_OFF + 320, LDS_BYTES = 159744;

struct Args { const float* in[N_IN]; float* out; unsigned char* ws; int ph_lo, ph_hi, li, pad; };
struct Ctx { LAS unsigned char* lds; int tid, lane, wave, vcu, G; };

__device__ __forceinline__ int panel_group(int pm) { return (pm % 33) == 32 ? 2 : pm / 33; }

namespace pg8 {
template <int ACT> struct EpiAct {
    static constexpr bool PERM = true, AFTER_DRAIN = false;
    bf16_t* O; int ldc;
    __device__ __forceinline__ void quad(const f32x4 (&a)[4][2], const Unit& u, int ai, int bj, int wr, int wc, int fr, int fq) const {
        const int row0 = u.pm * BM + ai * HALF + wr * 64 + fr, col0 = u.pn * BM + bj * HALF + wc * 32 + 8 * fq;
#pragma unroll
        for (int m = 0; m < 4; ++m) { f32x4 v0 = a[m][0], v1 = a[m][1];
            if (ACT == 2) {
#pragma unroll
                for (int j = 0; j < 4; ++j) { const float x = fmaxf(v0[j], 0.f), y = fmaxf(v1[j], 0.f); v0[j] = x * x; v1[j] = y * y; } }
            u32x4 w; w.x = cvt_pk_bf16(v0[0], v0[1]); w.y = cvt_pk_bf16(v0[2], v0[3]); w.z = cvt_pk_bf16(v1[0], v1[1]); w.w = cvt_pk_bf16(v1[2], v1[3]);
            *(u32x4*)(O + (size_t)(row0 + m * 16) * ldc + col0) = w; }
    }
    __device__ __forceinline__ void operator()(const f32x4 (&acc)[2][2][4][2], const Unit& u, int wr, int wc, int fr, int fq) const {
#pragma unroll
        for (int ai = 0; ai < 2; ++ai)
#pragma unroll
            for (int bj = 0; bj < 2; ++bj) quad(acc[ai][bj], u, ai, bj, wr, wc, fr, fq);
    }
};
struct EpiRes {
    static constexpr bool PERM = false, AFTER_DRAIN = false;
    float* X; const float* gate; const float* xin; const float* cin; float* part;
    __device__ __forceinline__ const float* src_row0(const Unit& u) const {
        if (!xin) return X + (size_t)u.pm * BM * D;
        const int b = u.pm / 33, p = u.pm % 33;
        return p < 32 ? xin + ((size_t)b * SEQ + (size_t)p * BM) * D : cin + (size_t)b * CTXL * D;
    }
    __device__ __forceinline__ void quad(const f32x4 (&a)[4][2], const Unit& u, int ai, int bj, int wr, int wc, int fr, int fq) const {
        const int row0 = u.pm * BM + ai * HALF + wr * 64 + fr, col0 = u.pn * BM + bj * HALF + wc * 32 + 4 * fq;
        const float* gp = gate + (size_t)panel_group(u.pm) * MODW + col0;
        const f32x4 g0 = *(const f32x4*)(gp), g1 = *(const f32x4*)(gp + 16);
        const float* sp = src_row0(u) + (size_t)(ai * HALF + wr * 64 + fr) * D + col0;
#pragma unroll
        for (int m = 0; m < 4; ++m) { float* rowp = X + (size_t)(row0 + m * 16) * D + col0; const float* sr = sp + (size_t)(m * 16) * D;
            const f32x4 x0 = *(const f32x4*)sr, x1 = *(const f32x4*)(sr + 16); *(f32x4*)rowp = x0 + g0 * a[m][0]; *(f32x4*)(rowp + 16) = x1 + g1 * a[m][1]; }
    }
    __device__ __forceinline__ void quad_part(const f32x4 (&a)[4][2], const Unit& u, int ai, int bj, int sp, int pc, int wr, int wc, int fr, int fq) const {
        const int col0 = u.pn * BM + bj * HALF + wc * 32 + 4 * fq, rl0 = pc * BM + ai * HALF + wr * 64 + fr;
        const float* gp = gate + (size_t)2 * MODW + col0;
        const f32x4 g0 = *(const f32x4*)(gp), g1 = *(const f32x4*)(gp + 16);
#pragma unroll
        for (int m = 0; m < 4; ++m) { float* rowp = part + ((size_t)sp * 512 + rl0 + m * 16) * D + col0; *(f32x4*)rowp = g0 * a[m][0]; *(f32x4*)(rowp + 16) = g1 * a[m][1]; }
    }
    __device__ __forceinline__ void operator()(const f32x4 (&acc)[2][2][4][2], const Unit& u, int wr, int wc, int fr, int fq) const {
        const int colb = u.pn * BM + wc * 32 + 4 * fq;
        const float* gp = gate + (size_t)panel_group(u.pm) * MODW + colb;
        f32x4 gv[2][2];
#pragma unroll
        for (int bj = 0; bj < 2; ++bj)
#pragma unroll
            for (int n = 0; n < 2; ++n) gv[bj][n] = *(const f32x4*)(gp + bj * HALF + n * 16);
#pragma unroll
        for (int ai = 0; ai < 2; ++ai) {
            float* base = X + (size_t)(u.pm * BM + ai * HALF + wr * 64 + fr) * D + colb;
            const float* sbase = src_row0(u) + (size_t)(ai * HALF + wr * 64 + fr) * D + colb;
            f32x4 xin[4][2][2];
#pragma unroll
            for (int m = 0; m < 4; ++m)
#pragma unroll
                for (int bj = 0; bj < 2; ++bj)
#pragma unroll
                    for (int n = 0; n < 2; ++n) xin[m][bj][n] = *(const f32x4*)(sbase + (size_t)(m * 16) * D + bj * HALF + n * 16);
#pragma unroll
            for (int m = 0; m < 4; ++m)
#pragma unroll
                for (int bj = 0; bj < 2; ++bj)
#pragma unroll
                    for (int n = 0; n < 2; ++n) *(f32x4*)(base + (size_t)(m * 16) * D + bj * HALF + n * 16) = xin[m][bj][n] + gv[bj][n] * acc[ai][bj][m][n];
        }
    }
};
struct SliceOrder {
    int c, s, G;
    __device__ __forceinline__ bool next(int i, Unit& u) const { if (i != 0) return false; const int x = c & 7, r = c >> 3, pl = 8 * x + 4 * s + (r & 3); u.pm = pl + (pl >= 32 ? 1 : 0); u.pn = r >> 2; return true; }
    __device__ __forceinline__ void a_ready(const Unit&) const {}
    __device__ __forceinline__ void done(const Unit&) const {}
};
struct EpiResNorm {
    static constexpr bool PERM = false, AFTER_DRAIN = true;
    float* X; const float* gate;
    const float* ng; const float* nmod;
    bf16_t* XN; float* out;
    float* slots; unsigned* cnt; unsigned* tmo;
    const float* xin; float* part;
    __device__ __forceinline__ void fused(f32x4 (&acc)[2][2][4][2], const Unit& u, int wr, int wc, int fr, int fq, PG8_LAS unsigned char* lds, int wid, int lane) const {
        PG8_LAS float* P = (PG8_LAS float*)lds;
        PG8_LAS float* S = (PG8_LAS float*)(lds + 4096);
        PG8_LAS unsigned char* stg = lds + 8192;
        const int colb = u.pn * BM + wc * 32 + 4 * fq, grp = panel_group(u.pm);
        {   const float* gp = gate + (size_t)grp * MODW + colb;
            f32x4 gv[2][2];
#pragma unroll
            for (int bj = 0; bj < 2; ++bj)
#pragma unroll
                for (int n = 0; n < 2; ++n) gv[bj][n] = *(const f32x4*)(gp + bj * HALF + n * 16);
#pragma unroll
            for (int ai = 0; ai < 2; ++ai) {
                float* base = X + (size_t)(u.pm * BM + ai * HALF + wr * 64 + fr) * D + colb;
                const float* sbase = xin ? xin + ((size_t)(u.pm / 33) * SEQ + (size_t)(u.pm % 33) * BM + ai * HALF + wr * 64 + fr) * D + colb : base;
#pragma unroll
                for (int mh = 0; mh < 2; ++mh) {
                    f32x4 xv[2][2][2];
#pragma unroll
                    for (int mm = 0; mm < 2; ++mm)
#pragma unroll
                        for (int bj = 0; bj < 2; ++bj)
#pragma unroll
                            for (int n = 0; n < 2; ++n) xv[mm][bj][n] = *(const f32x4*)(sbase + (size_t)((2 * mh + mm) * 16) * D + bj * HALF + n * 16);
#pragma unroll
                    for (int mm = 0; mm < 2; ++mm) { const int m = 2 * mh + mm; float q = 0.f;
#pragma unroll
                        for (int bj = 0; bj < 2; ++bj)
#pragma unroll
                            for (int n = 0; n < 2; ++n) { const f32x4 y = xv[mm][bj][n] + gv[bj][n] * acc[ai][bj][m][n]; acc[ai][bj][m][n] = y;
                                q += (y[0] * y[0] + y[1] * y[1]) + (y[2] * y[2] + y[3] * y[3]); }
                        q += __shfl_xor(q, 16); q += __shfl_xor(q, 32);
                        if (fq == 0) P[(ai * HALF + wr * 64 + m * 16 + fr) * 4 + wc] = q; }
                    asm volatile("" ::: "memory"); }
            } }
        f32x4 cgs[2][2], csh[2][2];
        {   const float* mg = nmod ? nmod + (size_t)grp * MODW + colb : nullptr;
#pragma unroll
            for (int bj = 0; bj < 2; ++bj)
#pragma unroll
                for (int n = 0; n < 2; ++n) { const int co = bj * HALF + n * 16; const f32x4 g4 = *(const f32x4*)(ng + colb + co);
                    if (nmod) { cgs[bj][n] = g4 * (*(const f32x4*)(mg + D + co) + 1.0f); csh[bj][n] = *(const f32x4*)(mg + co); } else { cgs[bj][n] = g4; csh[bj][n] = (f32x4){0.f, 0.f, 0.f, 0.f}; } } }
        asm volatile("s_waitcnt lgkmcnt(0)" ::: "memory"); __builtin_amdgcn_s_barrier(); asm volatile("" ::: "memory");
        const int row = wid * 32 + (lane & 31);
        if (lane < 32) { const float t = (P[row * 4 + 0] + P[row * 4 + 1]) + (P[row * 4 + 2] + P[row * 4 + 3]);
            __hip_atomic_store((unsigned*)slots + ((size_t)(u.pm * BM + row) * 8 + u.pn), __float_as_uint(t), __ATOMIC_RELAXED, __HIP_MEMORY_SCOPE_AGENT); }
        asm volatile("s_waitcnt vmcnt(0)" ::: "memory");
        if (lane == 0) __hip_atomic_fetch_add(cnt + 64 * u.pm, 1u, __ATOMIC_RELAXED, __HIP_MEMORY_SCOPE_AGENT);
        if (nmod) {
            int t2 = threadIdx.x; asm volatile("" : "+v"(t2));
            const int w2 = t2 >> 6, l2 = t2 & 63; float* xb2 = X + (size_t)(u.pm * BM + (w2 >> 2) * 64 + (l2 & 15)) * D + u.pn * BM + (w2 & 3) * 32 + 4 * (l2 >> 4);
#pragma unroll
            for (int ai = 0; ai < 2; ++ai) { float* base = xb2 + (size_t)(ai * HALF) * D;
#pragma unroll
                for (int m = 0; m < 4; ++m)
#pragma unroll
                    for (int bj = 0; bj < 2; ++bj)
#pragma unroll
                        for (int n = 0; n < 2; ++n) *(f32x4*)(base + (size_t)(m * 16) * D + bj * HALF + n * 16) = acc[ai][bj][m][n]; } }
        if (wid == 0) { unsigned sp = 0;
            for (;;) { if ((unsigned)__builtin_amdgcn_readfirstlane(__hip_atomic_load(cnt + 64 * u.pm, __ATOMIC_RELAXED, __HIP_MEMORY_SCOPE_AGENT)) >= 64u) break;
                __builtin_amdgcn_s_sleep(2);
                if (++sp > (1u << 22)) { if (lane == 0) __hip_atomic_store(tmo, 1u, __ATOMIC_RELAXED, __HIP_MEMORY_SCOPE_AGENT); break; } }
            __builtin_amdgcn_fence(__ATOMIC_ACQUIRE, "agent"); }
        asm volatile("s_waitcnt vmcnt(0) lgkmcnt(0)" ::: "memory"); __builtin_amdgcn_s_barrier(); asm volatile("" ::: "memory");
        if (lane < 32) { const unsigned* sl = (const unsigned*)slots + (size_t)(u.pm * BM + row) * 8; float t = 0.f;
#pragma unroll
            for (int k = 0; k < 8; ++k) t += __uint_as_float(__hip_atomic_load(sl + k, __ATOMIC_RELAXED, __HIP_MEMORY_SCOPE_AGENT));
            S[row] = rsqrtf(t * (1.0f / D) + EPS); }
        asm volatile("s_waitcnt vmcnt(0) lgkmcnt(0)" ::: "memory"); __builtin_amdgcn_s_barrier(); asm volatile("" ::: "memory");
        if (nmod) {
#pragma unroll
            for (int bj = 0; bj < 2; ++bj)
#pragma unroll
                for (int n = 0; n < 2; ++n) { const int co = bj * HALF + n * 16;
                    const f32x4 gs = cgs[bj][n], sh = csh[bj][n];
#pragma unroll
                    for (int ai = 0; ai < 2; ++ai)
#pragma unroll
                        for (int m = 0; m < 4; ++m) { const int r = ai * HALF + wr * 64 + m * 16 + fr; const float rs = S[r]; const f32x4 y = acc[ai][bj][m][n] * rs * gs + sh;
                            *(PG8_LAS unsigned long long*)(stg + r * 528 + (wc * 32 + 4 * fq + co) * 2) = (unsigned long long)cvt_pk_bf16(y[0], y[1]) | ((unsigned long long)cvt_pk_bf16(y[2], y[3]) << 32); } }
            asm volatile("s_waitcnt lgkmcnt(0)" ::: "memory"); __builtin_amdgcn_s_barrier(); asm volatile("" ::: "memory");
            const int tid = wid * 64 + lane;
#pragma unroll
            for (int it = 0; it < 16; ++it) { const int p = it * 512 + tid, r = p >> 5, ch = p & 31;
                const u32x4 v = *(const PG8_LAS u32x4*)(stg + r * 528 + ch * 16);
                *(u32x4*)(XN + (size_t)(u.pm * BM + r) * D + u.pn * BM + ch * 8) = v; }
            asm volatile("s_waitcnt lgkmcnt(0)" ::: "memory"); __builtin_amdgcn_s_barrier(); asm volatile("" ::: "memory");
        } else {
            const int b = u.pm / 33, p = u.pm % 33;
            float* ob = out + ((size_t)b * SEQ + (size_t)p * BM) * D + colb;
#pragma unroll
            for (int bj = 0; bj < 2; ++bj)
#pragma unroll
                for (int n = 0; n < 2; ++n) { const int co = bj * HALF + n * 16; const f32x4 g4 = cgs[bj][n];
#pragma unroll
                    for (int ai = 0; ai < 2; ++ai)
#pragma unroll
                        for (int m = 0; m < 4; ++m) { const int r = ai * HALF + wr * 64 + m * 16 + fr; *(f32x4*)(ob + (size_t)r * D + co) = acc[ai][bj][m][n] * S[r] * g4; } }
        }
    }
    __device__ __forceinline__ void quad(const f32x4 (&)[4][2], const Unit&, int, int, int, int, int, int) const {}
    __device__ __forceinline__ void quad_part(const f32x4 (&a)[4][2], const Unit& u, int ai, int bj, int sp, int pc, int wr, int wc, int fr, int fq) const {
        const int col0 = u.pn * BM + bj * HALF + wc * 32 + 4 * fq, rl0 = pc * BM + ai * HALF + wr * 64 + fr;
        const float* gp = gate + (size_t)2 * MODW + col0;
        const f32x4 g0 = *(const f32x4*)(gp), g1 = *(const f32x4*)(gp + 16);
#pragma unroll
        for (int m = 0; m < 4; ++m) { float* rowp = part + ((size_t)sp * 512 + rl0 + m * 16) * D + col0; *(f32x4*)rowp = g0 * a[m][0]; *(f32x4*)(rowp + 16) = g1 * a[m][1]; }
    }
};
}

__device__ __forceinline__ int perm_row(int n, int mode) {
    if (mode == 1) { if (n >= 4096) return n; const int dd = n & 63; return (n & ~63) + (dd < 32 ? 2 * dd : 2 * (dd - 32) + 1); }
    if (mode == 2) { const int hd = n % 192; if (hd < 128) return n; const int e = hd - 128, dd = e & 31; return n - (e & 31) + (dd < 16 ? 2 * dd : 2 * (dd - 16) + 1); }
    return n;
}
struct TrJob { const float* src; bf16* dst; int N, Kp, mode, n0; };
__device__ __forceinline__ TrJob tr_job(const float* W, int N, bf16* WT, int Kp, int mode, int item) {
    const int nblk = N / 64, kb = item / nblk, nb = item % nblk;
    TrJob j; j.src = W + (size_t)(64 * kb) * N + 64 * nb; j.dst = WT + 64 * kb; j.N = N; j.Kp = Kp; j.mode = mode; j.n0 = 64 * nb; return j;
}
__device__ __forceinline__ void tr_load(f32x4 (&v)[16], const TrJob& j, int lane) {
    const int c = lane & 15, kq = lane >> 4;
#pragma unroll
    for (int i = 0; i < 16; ++i) v[i] = *(const GAS f32x4*)(j.src + (size_t)(4 * i + kq) * j.N + 4 * c);
}
__device__ __forceinline__ void tr_store(const f32x4 (&v)[16], const TrJob& jb, LAS unsigned char* scr, int lane) {
    const int c = lane & 15, kq = lane >> 4;
#pragma unroll
    for (int i = 0; i < 16; ++i) { LAS unsigned short* p = (LAS unsigned short*)(scr + (4 * c) * 132 + (4 * i + kq) * 2);
        p[0] = (unsigned short)f2bf(v[i].x); p[66] = (unsigned short)f2bf(v[i].y); p[132] = (unsigned short)f2bf(v[i].z); p[198] = (unsigned short)f2bf(v[i].w); }
    LDS_WAIT(); asm volatile("" ::: "memory");
    const int j = lane & 7;
#pragma unroll
    for (int m = 0; m < 8; ++m) { const int n = (lane >> 3) + 8 * m; const LAS unsigned* q = (const LAS unsigned*)(scr + n * 132 + j * 16);
        v4u o; o.x = q[0]; o.y = q[1]; o.z = q[2]; o.w = q[3];
        *(GAS v4u*)(jb.dst + (size_t)perm_row(jb.n0 + n, jb.mode) * jb.Kp + 8 * j) = o; }
    LDS_WAIT(); asm volatile("" ::: "memory");
}
__device__ __forceinline__ float silu_f(float v) { return v / (1.0f + __expf(-v)); }

__device__ __forceinline__ void ph_prologue(const Args& a, const Ctx& C, unsigned* pub = nullptr) {
    LAS unsigned char* scr = C.lds + C.wave * 16384;
    const int gw = C.vcu * 8 + C.wave, NGW = C.G * 8, lane = C.lane;
    bf16* WB = (bf16*)(a.ws + WS_WB);
    constexpr int IT_FF1 = (D / 64) * (DFF / 64), IT_FF2 = (DFF / 64) * (D / 64), IT_AIN = (D / 64) * (4096 / 64), IT_AOUT = (D / 64) * (D / 64), IT_BQKV = (D / 64) * (NQKV / 64),
                  IT_CDQ = (D / 64) * (1024 / 64), IT_CUQ = (MQR / 64) * (3072 / 64), IT_CUKV = (MKVR / 64) * (4096 / 64);
    constexpr int NITEMS = 4 * IT_FF1 + 4 * IT_FF2 + 2 * IT_AIN + 2 * IT_AOUT + IT_BQKV + IT_AOUT + IT_CDQ + IT_CUQ + IT_CUKV + IT_AOUT;
    auto job = [&](int it) -> TrJob {
        int r = it;
        if (r < 4 * IT_FF1) { const int l = r / IT_FF1; return tr_job(a.in[I_WFF1] + (size_t)l * D * DFF, DFF, WB + WB_FF1 + (size_t)l * D * DFF, D, 0, r % IT_FF1); } r -= 4 * IT_FF1;
        if (r < 4 * IT_FF2) { const int l = r / IT_FF2; return tr_job(a.in[I_WFF2] + (size_t)l * D * DFF, D, WB + WB_FF2 + (size_t)l * D * DFF, DFF, 0, r % IT_FF2); } r -= 4 * IT_FF2;
        if (r < 2 * IT_AIN) { const int l = r / IT_AIN; return tr_job(a.in[I_AWIN] + (size_t)l * D * 4096, 4096, WB + WB_AWIN + (size_t)l * D * 4096, D, 0, r % IT_AIN); } r -= 2 * IT_AIN;
        if (r < 2 * IT_AOUT) { const int l = r / IT_AOUT; return tr_job(a.in[I_AWOUT] + (size_t)l * D * D, D, WB + WB_AWOUT + (size_t)l * D * D, D, 0, r % IT_AOUT); } r -= 2 * IT_AOUT;
        if (r < IT_BQKV) return tr_job(a.in[I_BWQKV], NQKV, WB + WB_BQKV, D, 1, r); r -= IT_BQKV;
        if (r < IT_AOUT) return tr_job(a.in[I_BWO], D, WB + WB_BWO, D, 0, r); r -= IT_AOUT;
        if (r < IT_CDQ) return tr_job(a.in[I_CWDQKV], 1024, WB + WB_CDQKV, D, 0, r); r -= IT_CDQ;
        if (r < IT_CUQ) return tr_job(a.in[I_CWUQ], 3072, WB + WB_CUQ, 512, 2, r); r -= IT_CUQ;
        if (r < IT_CUKV) return tr_job(a.in[I_CWUKV], 4096, WB + WB_CUKV, 512, 0, r); r -= IT_CUKV;
        return tr_job(a.in[I_CWO], D, WB + WB_CWO, D, 0, r);
    };
    { int it = gw; TrJob j0, j1; f32x4 va[16], vb[16];
      if (it < NITEMS) { j0 = job(it); tr_load(va, j0, lane); }
      while (it < NITEMS) {
          const int it1 = it + NGW; if (it1 < NITEMS) { j1 = job(it1); tr_load(vb, j1, lane); }
          tr_store(va, j0, scr, lane);
          if (it1 >= NITEMS) break;
          const int it2 = it1 + NGW; if (it2 < NITEMS) { j0 = job(it2); tr_load(va, j0, lane); }
          tr_store(vb, j1, scr, lane);
          it = it2;
      } }
    const int gt = C.vcu * 512 + C.tid, NGT = C.G * 512;
    for (int i = gt; i < 3072 * 8; i += NGT) { const int n = i >> 3, c8 = i & 7; *(GAS v4u*)(WB + WB_CUQ + (size_t)n * 512 + 448 + c8 * 8) = (v4u){0u, 0u, 0u, 0u}; }
    { const float* wsrc = a.in[I_AWS]; for (int i = gt; i < 2 * GG * 128 * 128 / 8; i += NGT) { const f32x4 x0 = *(const GAS f32x4*)(wsrc + (size_t)i * 8), x1 = *(const GAS f32x4*)(wsrc + (size_t)i * 8 + 4);
        v4u o; o.x = pk2(x0.x, x0.y); o.y = pk2(x0.z, x0.w); o.z = pk2(x1.x, x1.y); o.w = pk2(x1.z, x1.w); *(GAS v4u*)(WB + WB_AWS + (size_t)i * 8) = o; } }
    { float* tab = (float*)(a.ws + WS_ROPE);
      for (int i = gt; i < 128 * 32; i += NGT) { const int pos = i / 32, f = i % 32; const float inv = powf(10000.0f, -(float)(2 * f) / 64.0f); const float an = (float)pos * inv; tab[i] = cosf(an); tab[4096 + i] = sinf(an); }
      for (int i = gt; i < 128 * 16; i += NGT) { const int pos = i / 16, f = i % 16; const float inv = powf(10000.0f, -(float)(2 * f) / 32.0f); const float an = (float)pos * inv; tab[8192 + i] = cosf(an); tab[8192 + 2048 + i] = sinf(an); } }
    __syncthreads();
    { LAS float* s = (LAS float*)C.lds; LAS float* red = s + 3 * D;
      const float* c = a.in[I_C]; const float* cctx = a.in[I_CCTX]; const float* wmod = a.in[I_WMOD]; const float* bmod = a.in[I_BMOD]; float* mod = (float*)(a.ws + WS_MOD);
      for (int i = C.tid; i < 3 * D; i += 512) { const int g = i / D, k = i % D; const float v = g < 2 ? c[g * D + k] : cctx[k]; s[i] = silu_f(v); }
      __syncthreads();
      const int cq = lane & 15, kr = lane >> 4, wave = C.wave;
      for (int u = C.vcu; u < DEPTH * (MODW / 192); u += C.G) {
          const int l = u / (MODW / 192), n0 = (u % (MODW / 192)) * 192;
          const float* W = wmod + (size_t)l * D * MODW + n0 + cq * 4;
          f32x4 acc[3][3];
#pragma unroll
          for (int c3 = 0; c3 < 3; ++c3)
#pragma unroll
              for (int g = 0; g < 3; ++g) acc[c3][g] = (f32x4){0.f, 0.f, 0.f, 0.f};
          for (int kk = 0; kk < 256; kk += 32) { f32x4 w[8][3];
#pragma unroll
              for (int q = 0; q < 8; ++q)
#pragma unroll
                  for (int c3 = 0; c3 < 3; ++c3) w[q][c3] = *(const GAS f32x4*)(W + (size_t)(wave * 256 + kr + kk + 4 * q) * MODW + c3 * 64);
#pragma unroll
              for (int q = 0; q < 8; ++q) { const int k = wave * 256 + kr + kk + 4 * q; const float s0 = s[k], s1 = s[D + k], s2 = s[2 * D + k];
#pragma unroll
                  for (int c3 = 0; c3 < 3; ++c3) { acc[c3][0] += s0 * w[q][c3]; acc[c3][1] += s1 * w[q][c3]; acc[c3][2] += s2 * w[q][c3]; } } }
#pragma unroll
          for (int c3 = 0; c3 < 3; ++c3)
#pragma unroll
              for (int g = 0; g < 3; ++g)
#pragma unroll
                  for (int j = 0; j < 4; ++j) { float v = acc[c3][g][j]; v += __shfl_xor(v, 16); v += __shfl_xor(v, 32); acc[c3][g][j] = v; }
          if (kr == 0) {
#pragma unroll
              for (int c3 = 0; c3 < 3; ++c3)
#pragma unroll
                  for (int g = 0; g < 3; ++g)
#pragma unroll
                      for (int j = 0; j < 4; ++j) red[(wave * 3 + g) * 192 + c3 * 64 + cq * 4 + j] = acc[c3][g][j]; }
          __syncthreads();
          for (int i = C.tid; i < 3 * 192; i += 512) { const int g = i / 192, n = i % 192; float v = bmod[(size_t)l * MODW + n0 + n];
#pragma unroll
              for (int w = 0; w < 8; ++w) v += red[(w * 3 + g) * 192 + n];
              if (pub) __hip_atomic_store((unsigned*)(mod + ((size_t)l * 3 + g) * MODW + n0 + n), __float_as_uint(v), __ATOMIC_RELAXED, __HIP_MEMORY_SCOPE_AGENT);
              else mod[((size_t)l * 3 + g) * MODW + n0 + n] = v; }
          __syncthreads();
      } }
    if (pub) { asm volatile("s_waitcnt vmcnt(0)" ::: "memory"); if (C.lane == 0) __hip_atomic_fetch_add(pub, 1u, __ATOMIC_RELAXED, __HIP_MEMORY_SCOPE_AGENT); }
}

__device__ __forceinline__ float wsum(float v) {
#pragma unroll
    for (int o = 1; o < 64; o <<= 1) v += __shfl_xor(v, o);
    return v;
}
__device__ __forceinline__ void ph_norm(const Ctx& C, float* X, const float* g, const float* modl, int which, bf16* XN, int lat_only, const float* xin = nullptr, const float* cin = nullptr, const float* part = nullptr, int nsplit = 0, int g0 = 0, unsigned* pub = nullptr) {
    const int gw = C.vcu * 8 + C.wave, NGW = C.G * 8, lane = C.lane;
    for (int grp = g0; grp < (lat_only ? 2 : 3); ++grp) {
        const float* mg = modl + (size_t)grp * MODW + which * 3 * D;
        f32x4 gs[8], sh[8];
#pragma unroll
        for (int j = 0; j < 8; ++j) { const int c4 = j * 64 + lane; gs[j] = ((const GAS f32x4*)g)[c4] * (((const GAS f32x4*)(mg + D))[c4] + 1.0f); sh[j] = ((const GAS f32x4*)mg)[c4]; }
        const int count = grp < 2 ? SEQ : BATCH * CTXL;
        for (int i = gw; i < count; i += NGW) {
            const bool isc = grp == 2;
            const int b_ = isc ? i / CTXL : grp, t_ = isc ? SEQ + i % CTXL : i, r = b_ * TB + t_;
            const float* srow = isc ? (cin ? cin + (size_t)i * D : X + (size_t)r * D) : (xin ? xin + ((size_t)b_ * SEQ + t_) * D : X + (size_t)r * D);
            const GAS f32x4* xr = (const GAS f32x4*)srow;
            f32x4 v[8]; float ss = 0.f;
#pragma unroll
            for (int j = 0; j < 8; ++j) v[j] = xr[j * 64 + lane];
            if (part && isc) {
                for (int sp = 0; sp < nsplit; ++sp) { const GAS f32x4* pr = (const GAS f32x4*)(part + ((size_t)sp * 512 + i) * D);
#pragma unroll
                    for (int j = 0; j < 8; ++j) v[j] += pr[j * 64 + lane]; }
                GAS f32x4* xw = (GAS f32x4*)(X + (size_t)r * D);
#pragma unroll
                for (int j = 0; j < 8; ++j) xw[j * 64 + lane] = v[j]; }
#pragma unroll
            for (int j = 0; j < 8; ++j) ss += v[j].x * v[j].x + v[j].y * v[j].y + v[j].z * v[j].z + v[j].w * v[j].w;
            const float rstd = rsqrtf(wsum(ss) * (1.0f / D) + EPS);
            GAS unsigned long long* o8 = (GAS unsigned long long*)(XN + (size_t)r * D);
#pragma unroll
            for (int j = 0; j < 8; ++j) { const f32x4 y = v[j] * rstd * gs[j] + sh[j];
                if (pub) { unsigned* o4 = (unsigned*)(XN + (size_t)r * D) + 2 * (j * 64 + lane);
                    __hip_atomic_store(o4, pk2(y.x, y.y), __ATOMIC_RELAXED, __HIP_MEMORY_SCOPE_AGENT); __hip_atomic_store(o4 + 1, pk2(y.z, y.w), __ATOMIC_RELAXED, __HIP_MEMORY_SCOPE_AGENT); }
                else o8[j * 64 + lane] = (unsigned long long)pk2(y.x, y.y) | ((unsigned long long)pk2(y.z, y.w) << 32); }
        }
    }
    if (pub) { asm volatile("s_waitcnt vmcnt(0)" ::: "memory"); if (lane == 0) __hip_atomic_fetch_add(pub, 1u, __ATOMIC_RELAXED, __HIP_MEMORY_SCOPE_AGENT); }
}
__device__ __forceinline__ void ph_final(const Ctx& C, const float* X, const float* g, float* out) {
    const int gw = C.vcu * 8 + C.wave, NGW = C.G * 8, lane = C.lane;
    f32x4 gg[8];
#pragma unroll
    for (int j = 0; j < 8; ++j) gg[j] = ((const GAS f32x4*)g)[j * 64 + lane];
    for (int q = gw; q < BATCH * SEQ; q += NGW) {
        const int b = q / SEQ, t = q % SEQ, r = b * TB + t;
        const GAS f32x4* xr = (const GAS f32x4*)(X + (size_t)r * D);
        f32x4 v[8]; float ss = 0.f;
#pragma unroll
        for (int j = 0; j < 8; ++j) { v[j] = xr[j * 64 + lane]; ss += v[j].x * v[j].x + v[j].y * v[j].y + v[j].z * v[j].z + v[j].w * v[j].w; }
        const float rstd = rsqrtf(wsum(ss) * (1.0f / D) + EPS);
        GAS f32x4* o = (GAS f32x4*)(out + (size_t)q * D);
#pragma unroll
        for (int j = 0; j < 8; ++j) o[j * 64 + lane] = v[j] * rstd * gg[j];
    }
}

namespace pg8 {
__device__ __forceinline__ float gelu_tanh_f(float x) {
    const float t = x * (1.0f + 0.044715f * x * x);
    return x * __builtin_amdgcn_rcpf(1.0f + __builtin_amdgcn_exp2f(-2.3022081987f * t));
}
struct EpiGeluStats {
    static constexpr bool PERM = true, AFTER_DRAIN = false;
    bf16_t* O; PG8_LAS const float* bias; float* st;
    __device__ __forceinline__ void quad(const f32x4 (&a)[4][2], const Unit& u, int ai, int bj, int wr, int wc, int fr, int fq) const {
        const int row0 = u.pm * BM + ai * HALF + wr * 64 + fr, col0 = u.pn * BM + bj * HALF + wc * 32 + 8 * fq;
        const f32x4 b0 = *(PG8_LAS const f32x4*)(bias + col0), b1 = *(PG8_LAS const f32x4*)(bias + col0 + 4);
        const bool vhalf = u.pn >= 8;
#pragma unroll
        for (int m = 0; m < 4; ++m) { const int row = row0 + m * 16; float s = 0.f, q = 0.f;
            f32x4 v0 = a[m][0] + b0, v1 = a[m][1] + b1;
#pragma unroll
            for (int j = 0; j < 4; ++j) { v0[j] = gelu_tanh_f(v0[j]); v1[j] = gelu_tanh_f(v1[j]); s += v0[j] + v1[j]; q += v0[j] * v0[j] + v1[j] * v1[j]; }
            u32x4 w; w.x = cvt_pk_bf16(v0[0], v0[1]); w.y = cvt_pk_bf16(v0[2], v0[3]); w.z = cvt_pk_bf16(v1[0], v1[1]); w.w = cvt_pk_bf16(v1[2], v1[3]);
            *(u32x4*)(O + (size_t)row * 4096 + col0) = w;
            if (vhalf) { s += __shfl_xor(s, 16); s += __shfl_xor(s, 32); q += __shfl_xor(q, 16); q += __shfl_xor(q, 32);
                if (fq == 0) { f32x2 o; o.x = s; o.y = q; *(f32x2*)(st + ((size_t)row * 64 + (u.pn - 8) * 8 + bj * 4 + wc) * 2) = o; } } }
    }
    __device__ __forceinline__ void operator()(const f32x4 (&acc)[2][2][4][2], const Unit& u, int wr, int wc, int fr, int fq) const {
        const bool vhalf = u.pn >= 8;
#pragma unroll
        for (int ai = 0; ai < 2; ++ai) {
            float ss[4] = {0.f, 0.f, 0.f, 0.f}, qq[4] = {0.f, 0.f, 0.f, 0.f};
#pragma unroll
            for (int bj = 0; bj < 2; ++bj) {
                const int row0 = u.pm * BM + ai * HALF + wr * 64 + fr, col0 = u.pn * BM + bj * HALF + wc * 32 + 8 * fq;
                const f32x4 b0 = *(PG8_LAS const f32x4*)(bias + col0), b1 = *(PG8_LAS const f32x4*)(bias + col0 + 4);
#pragma unroll
                for (int m = 0; m < 4; ++m) { const int row = row0 + m * 16;
                    f32x4 v0 = acc[ai][bj][m][0] + b0, v1 = acc[ai][bj][m][1] + b1;
#pragma unroll
                    for (int j = 0; j < 4; ++j) { v0[j] = gelu_tanh_f(v0[j]); v1[j] = gelu_tanh_f(v1[j]); ss[m] += v0[j] + v1[j]; qq[m] += v0[j] * v0[j] + v1[j] * v1[j]; }
                    u32x4 w; w.x = cvt_pk_bf16(v0[0], v0[1]); w.y = cvt_pk_bf16(v0[2], v0[3]); w.z = cvt_pk_bf16(v1[0], v1[1]); w.w = cvt_pk_bf16(v1[2], v1[3]);
                    *(u32x4*)(O + (size_t)row * 4096 + col0) = w; } }
            if (vhalf) {
#pragma unroll
                for (int m = 0; m < 4; ++m) { float s = ss[m], q = qq[m]; s += __shfl_xor(s, 16); s += __shfl_xor(s, 32); q += __shfl_xor(q, 16); q += __shfl_xor(q, 32);
                    if (fq == 0) { f32x2 o; o.x = s; o.y = q; *(f32x2*)(st + ((size_t)(u.pm * BM + ai * HALF + wr * 64 + fr + m * 16) * 64 + (u.pn - 8) * 4 + wc) * 2) = o; } } }
        }
    }
};
}

typedef float f32x2 __attribute__((ext_vector_type(2)));
typedef short s16x4_t __attribute__((ext_vector_type(4)));
__device__ __forceinline__ void ph_gmlp_spatial(const Ctx& C, const bf16* Z, const float* st, const float* lng, const bf16* Wsb, const float* bs, bf16* G, int lat_only) {
    LAS unsigned char* Vs = C.lds;
    LAS float* stat = (LAS float*)(C.lds + 128 * 264);
    const int tid = C.tid, lane = C.lane, w = C.wave, fr = lane & 15, fq = lane >> 4;
    const int nchunk = lat_only ? (BATCH * SEQ / CHUNK) : (NR / CHUNK), nunits = nchunk * GG;
    LAS unsigned char* Wl = C.lds + 40960;
    LAS unsigned char* Ol = C.lds + 77824;
    int gl = -1;
    for (int un = C.vcu; un < nunits; un += C.G) {
        if (un % GG != gl) { gl = un % GG; __syncthreads();
            const bf16* wsrc = Wsb + (size_t)gl * 128 * 128;
#pragma unroll
            for (int it = 0; it < 4; ++it) { const int idx = it * 512 + tid, p = idx >> 4, c8 = idx & 15;
                *(LAS v4u*)(Wl + p * 272 + c8 * 16) = *(const GAS v4u*)(wsrc + (size_t)p * 128 + c8 * 8); } }
        const int g = un % GG, chl = un / GG; const int ch = lat_only ? chl + 2 * (chl / 64) : chl;
        const int r0 = ch * CHUNK;
        const int c8 = tid & 15; v4u raw[4];
#pragma unroll
        for (int it = 0; it < 4; ++it) raw[it] = *(const GAS v4u*)(Z + (size_t)(r0 + it * 32 + (tid >> 4)) * 4096 + GW + g * GC + c8 * 8);
        const bool cx = (r0 % TB) >= SEQ; f32x4 sp0[4], sp1[4];
#pragma unroll
        for (int it = 0; it < 4; ++it) { const GAS f32x4* p = (const GAS f32x4*)(st + (size_t)(r0 + it * 32 + (tid >> 4)) * 128); sp0[it] = p[c8]; sp1[it] = cx ? p[16 + c8] : (f32x4){0.f, 0.f, 0.f, 0.f}; }
        __syncthreads();
        float mean4[4], rstd4[4];
#pragma unroll
        for (int it = 0; it < 4; ++it) { float s = (sp0[it].x + sp0[it].z) + (sp1[it].x + sp1[it].z), q = (sp0[it].y + sp0[it].w) + (sp1[it].y + sp1[it].w);
#pragma unroll
            for (int o = 1; o < 16; o <<= 1) { s += __shfl_xor(s, o); q += __shfl_xor(q, o); }
            const float mean = s * (1.0f / GW), var = q * (1.0f / GW) - mean * mean; mean4[it] = mean; rstd4[it] = rsqrtf(fmaxf(var, 0.f) + EPS); }
        {   const f32x4 g0 = *(const GAS f32x4*)(lng + g * GC + c8 * 8), g1 = *(const GAS f32x4*)(lng + g * GC + c8 * 8 + 4);
#pragma unroll
            for (int it = 0; it < 4; ++it) { const int q = it * 32 + (tid >> 4);
                const float mean = mean4[it], rstd = rstd4[it];
                float x[8];
#pragma unroll
                for (int j = 0; j < 4; ++j) { x[2 * j] = __builtin_bit_cast(float, raw[it][j] << 16); x[2 * j + 1] = __builtin_bit_cast(float, raw[it][j] & 0xffff0000u); }
                unsigned o0 = pk2((x[0] - mean) * rstd * g0.x, (x[1] - mean) * rstd * g0.y), o1 = pk2((x[2] - mean) * rstd * g0.z, (x[3] - mean) * rstd * g0.w);
                unsigned o2 = pk2((x[4] - mean) * rstd * g1.x, (x[5] - mean) * rstd * g1.y), o3 = pk2((x[6] - mean) * rstd * g1.z, (x[7] - mean) * rstd * g1.w);
                LAS unsigned long long* d = (LAS unsigned long long*)(Vs + q * 264 + c8 * 16);
                d[0] = (unsigned long long)o0 | ((unsigned long long)o1 << 32); d[1] = (unsigned long long)o2 | ((unsigned long long)o3 << 32); } }
        v4u uraw[4];
#pragma unroll
        for (int it = 0; it < 4; ++it) uraw[it] = *(const GAS v4u*)(Z + (size_t)(r0 + it * 32 + (tid >> 4)) * 4096 + g * GC + c8 * 8);
        float bv[4];
#pragma unroll
        for (int it = 0; it < 4; ++it) bv[it] = *(const GAS float*)(bs + g * CHUNK + it * 32 + (tid >> 4));
        __syncthreads();
        bf16x8 af[4];
        {   const int ab = (int)(unsigned)(size_t)Vs + (8 * fq + (fr >> 2)) * 264 + 32 * w + 8 * (fr & 3);
            s16x4_t tl[4], th[4];
#pragma unroll
            for (int ks = 0; ks < 4; ++ks) { asm volatile("ds_read_b64_tr_b16 %0, %1" : "=&v"(tl[ks]) : "v"(ab + ks * 32 * 264) : "memory");
                                             asm volatile("ds_read_b64_tr_b16 %0, %1" : "=&v"(th[ks]) : "v"(ab + ks * 32 * 264 + 4 * 264) : "memory"); }
            asm volatile("s_waitcnt lgkmcnt(0)" ::: "memory");
#pragma unroll
            for (int ks = 0; ks < 4; ++ks) af[ks] = (bf16x8){tl[ks][0], tl[ks][1], tl[ks][2], tl[ks][3], th[ks][0], th[ks][1], th[ks][2], th[ks][3]}; }
#pragma unroll
        for (int pt = 0; pt < 8; ++pt) {
            f32x4 acc = {0.f, 0.f, 0.f, 0.f};
#pragma unroll
            for (int ks = 0; ks < 4; ++ks) { const bf16x8 bfrag = *(const LAS bf16x8*)(Wl + (16 * pt + fr) * 272 + 64 * ks + 16 * fq);
                acc = __builtin_amdgcn_mfma_f32_16x16x32_bf16(af[ks], bfrag, acc, 0, 0, 0); }
            *(LAS f32x4*)(Ol + (16 * pt + fr) * 528 + (16 * w + 4 * fq) * 4) = acc;
        }
        __syncthreads();
#pragma unroll
        for (int it = 0; it < 4; ++it) { const int p = it * 32 + (tid >> 4);
            const f32x4 s0 = *(const LAS f32x4*)(Ol + p * 528 + c8 * 32), s1 = *(const LAS f32x4*)(Ol + p * 528 + c8 * 32 + 16);
            const float b = bv[it];
            float u[8];
#pragma unroll
            for (int j = 0; j < 4; ++j) { u[2 * j] = __builtin_bit_cast(float, uraw[it][j] << 16); u[2 * j + 1] = __builtin_bit_cast(float, uraw[it][j] & 0xffff0000u); }
            v4u o; o.x = pk2(u[0] * (s0.x + b), u[1] * (s0.y + b)); o.y = pk2(u[2] * (s0.z + b), u[3] * (s0.w + b)); o.z = pk2(u[4] * (s1.x + b), u[5] * (s1.y + b)); o.w = pk2(u[6] * (s1.z + b), u[7] * (s1.w + b));
            *(GAS v4u*)(G + (size_t)(r0 + p) * GW + g * GC + c8 * 8) = o; }
    }
    __syncthreads();
}

namespace att {
using bf16x8 = __attribute__((ext_vector_type(8))) short;
using s16x4  = __attribute__((ext_vector_type(4))) short;
using f32x16 = __attribute__((ext_vector_type(16))) float;
using u32x4  = __attribute__((ext_vector_type(4))) unsigned;
typedef unsigned short bf16;
constexpr int KVBLK = 64, QBLK = 32, NW = 8;
constexpr float THR = 8.f;
#define ATT_KSWZ(row, colB) ((row) * 256 + ((colB) ^ (((row) & 7) << 4)))
#define ATT_SBAR() __builtin_amdgcn_sched_barrier(0)
__device__ __forceinline__ int crow(int r, int hi) { return (r & 3) + 8 * (r >> 2) + 4 * hi; }
__device__ __forceinline__ unsigned cvtpk(float lo, float hi) { unsigned r; asm volatile("v_cvt_pk_bf16_f32 %0, %1, %2" : "=v"(r) : "v"(lo), "v"(hi)); return r; }

__device__ __forceinline__ void partialSM(f32x16& p0, f32x16& p1, float& m_reg, float& mn, float& alpha, float Cs, float thr) {
  float pmax = p0[0];
#pragma unroll
  for (int r = 1; r < 16; ++r) pmax = fmaxf(pmax, p0[r]);
#pragma unroll
  for (int r = 0; r < 16; ++r) pmax = fmaxf(pmax, p1[r]);
  { auto rr = __builtin_amdgcn_permlane32_swap(__float_as_uint(pmax), __float_as_uint(pmax), false, false);
    pmax = fmaxf(__uint_as_float(rr[0]), __uint_as_float(rr[1])); }
  if (__builtin_expect(__all(pmax - m_reg <= thr), 1)) { mn = m_reg; alpha = 1.f; }
  else { mn = fmaxf(m_reg, pmax); alpha = __builtin_amdgcn_exp2f((m_reg - mn) * Cs); m_reg = mn; }
  float mnC = -mn * Cs;
#pragma unroll
  for (int r = 0; r < 16; ++r) p0[r] = fmaf(p0[r], Cs, mnC);
#pragma unroll
  for (int r = 0; r < 16; ++r) p1[r] = fmaf(p1[r], Cs, mnC);
#pragma unroll
  for (int r = 0; r < 16; ++r) p0[r] = __builtin_amdgcn_exp2f(p0[r]);
}
__device__ __forceinline__ void finishSM(f32x16& p0, f32x16& p1, float alpha, float& l_reg, bf16x8& pa0, bf16x8& pa1, bf16x8& pa2, bf16x8& pa3) {
#pragma unroll
  for (int r = 0; r < 16; ++r) p1[r] = __builtin_amdgcn_exp2f(p1[r]);
  float ps = 0;
#pragma unroll
  for (int r = 0; r < 16; ++r) ps += p0[r];
#pragma unroll
  for (int r = 0; r < 16; ++r) ps += p1[r];
  { auto rr = __builtin_amdgcn_permlane32_swap(__float_as_uint(ps), __float_as_uint(ps), false, false);
    ps = __uint_as_float(rr[0]) + __uint_as_float(rr[1]); }
  l_reg = l_reg * alpha + ps;
#define ATT_PK4(P, BASE, OUT) do { unsigned a0 = cvtpk(P[BASE + 0], P[BASE + 1]), a1 = cvtpk(P[BASE + 2], P[BASE + 3]);   \
    unsigned b0 = cvtpk(P[BASE + 4], P[BASE + 5]), b1 = cvtpk(P[BASE + 6], P[BASE + 7]);                              \
    auto r0 = __builtin_amdgcn_permlane32_swap(a0, b0, false, false); auto r1 = __builtin_amdgcn_permlane32_swap(a1, b1, false, false); \
    u32x4 w = {r0[0], r1[0], r0[1], r1[1]}; OUT = *reinterpret_cast<bf16x8*>(&w); } while (0)
  ATT_PK4(p0, 0, pa0); ATT_PK4(p0, 8, pa1); ATT_PK4(p1, 0, pa2); ATT_PK4(p1, 8, pa3);
#undef ATT_PK4
}
__device__ __forceinline__ int v_st(int k, int c) { const int kk = (k & ~0xC) | ((k & 4) << 1) | ((k & 8) >> 1); return ((kk >> 3) * 4 + (c >> 5)) * 512 + ((kk & 7) * 32 + (c & 31)) * 2; }
__device__ __forceinline__ int v_rd_base(int lane) { return ((lane & 3) << 3) | (((lane >> 2) & 3) << 6) | (((lane >> 4) & 1) << 5) | (((lane >> 5) & 1) << 8); }
constexpr int v_rd_off(int d0, int ks, int half) { return d0 * 512 + ks * 4096 + half * 2048; }
template <int OFF> __device__ __forceinline__ s16x4 tr_read(int vb) {
  s16x4 r; asm volatile("ds_read_b64_tr_b16 %0, %1 offset:%2" : "=&v"(r) : "v"(vb), "i"(OFF) : "memory"); return r;
}
template <int D0> __device__ __forceinline__ void pv_one(f32x16& od, int vb, bf16x8 pa0, bf16x8 pa1, bf16x8 pa2, bf16x8 pa3) {
  const s16x4 l0 = tr_read<v_rd_off(D0, 0, 0)>(vb), h0 = tr_read<v_rd_off(D0, 0, 1)>(vb), l1 = tr_read<v_rd_off(D0, 1, 0)>(vb), h1 = tr_read<v_rd_off(D0, 1, 1)>(vb);
  const s16x4 l2 = tr_read<v_rd_off(D0, 2, 0)>(vb), h2 = tr_read<v_rd_off(D0, 2, 1)>(vb), l3 = tr_read<v_rd_off(D0, 3, 0)>(vb), h3 = tr_read<v_rd_off(D0, 3, 1)>(vb);
  asm volatile("s_waitcnt lgkmcnt(0)" ::: "memory"); ATT_SBAR();
#define ATT_PK(L, H) (bf16x8){L[0], L[1], L[2], L[3], H[0], H[1], H[2], H[3]}
  od = __builtin_amdgcn_mfma_f32_32x32x16_bf16(pa0, ATT_PK(l0, h0), od, 0, 0, 0);
  od = __builtin_amdgcn_mfma_f32_32x32x16_bf16(pa1, ATT_PK(l1, h1), od, 0, 0, 0);
  od = __builtin_amdgcn_mfma_f32_32x32x16_bf16(pa2, ATT_PK(l2, h2), od, 0, 0, 0);
  od = __builtin_amdgcn_mfma_f32_32x32x16_bf16(pa3, ATT_PK(l3, h3), od, 0, 0, 0);
#undef ATT_PK
}
__device__ __forceinline__ void pv_d0(f32x16* o, int vb, bf16x8 pa0, bf16x8 pa1, bf16x8 pa2, bf16x8 pa3) {
  pv_one<0>(o[0], vb, pa0, pa1, pa2, pa3); pv_one<1>(o[1], vb, pa0, pa1, pa2, pa3); pv_one<2>(o[2], vb, pa0, pa1, pa2, pa3); pv_one<3>(o[3], vb, pa0, pa1, pa2, pa3);
}
constexpr size_t SHM_V = KVBLK * 128 * 2, SHM_K = KVBLK * 128 * 2, SHM_ATTN = 2 * SHM_V + 2 * SHM_K + NW * 64 * 4;

}

namespace pg8 {
struct EpiQkvRope {
    static constexpr bool PERM = true, AFTER_DRAIN = false;
    bf16_t* O; const float* tab; PG8_LAS const _Float16* tl;
    __device__ __forceinline__ void quad(const f32x4 (&a)[4][2], const Unit& u, int ai, int bj, int wr, int wc, int fr, int fq) const {
        const int row0 = u.pm * BM + ai * HALF + wr * 64 + fr, col0 = u.pn * BM + bj * HALF + wc * 32 + 8 * fq;
        const bool rope = (u.pn < 16) && ((u.pm % 33) != 32);
        const int half = wc >> 1, f0 = 16 * (wc & 1) + 4 * fq;
#pragma unroll
        for (int m = 0; m < 4; ++m) { const int row = row0 + m * 16;
            f32x4 cs = {1.f, 1.f, 1.f, 1.f}, sn = {0.f, 0.f, 0.f, 0.f};
            if (rope) { const int t = row % TB, pos = half ? (t % GRID_W) : (t / GRID_W);
                typedef _Float16 h16x4 __attribute__((ext_vector_type(4)));
                const h16x4 ch = *(PG8_LAS const h16x4*)(tl + pos * 32 + f0), sh = *(PG8_LAS const h16x4*)(tl + 4096 + pos * 32 + f0);
                cs = (f32x4){(float)ch[0], (float)ch[1], (float)ch[2], (float)ch[3]}; sn = (f32x4){(float)sh[0], (float)sh[1], (float)sh[2], (float)sh[3]}; }
            const f32x4 v0 = a[m][0], v1 = a[m][1];
            const float a0 = v0[0] * cs[0] - v0[1] * sn[0], b0 = v0[1] * cs[0] + v0[0] * sn[0], a1 = v0[2] * cs[1] - v0[3] * sn[1], b1 = v0[3] * cs[1] + v0[2] * sn[1];
            const float a2 = v1[0] * cs[2] - v1[1] * sn[2], b2 = v1[1] * cs[2] + v1[0] * sn[2], a3 = v1[2] * cs[3] - v1[3] * sn[3], b3 = v1[3] * cs[3] + v1[2] * sn[3];
            u32x4 w; w.x = cvt_pk_bf16(a0, b0); w.y = cvt_pk_bf16(a1, b1); w.z = cvt_pk_bf16(a2, b2); w.w = cvt_pk_bf16(a3, b3);
            *(u32x4*)(O + (size_t)row * 6144 + col0) = w; }
    }
    __device__ __forceinline__ void operator()(const f32x4 (&acc)[2][2][4][2], const Unit& u, int wr, int wc, int fr, int fq) const {
#pragma unroll
        for (int ai = 0; ai < 2; ++ai)
#pragma unroll
            for (int bj = 0; bj < 2; ++bj) quad(acc[ai][bj], u, ai, bj, wr, wc, fr, fq);
    }
};
}

__device__ __forceinline__ void ph_diff_combine(const Ctx& C, const bf16* O, const float* lq1, const float* lk1, const float* lq2, const float* lk2, const float* subg, float lambda_init, bf16* ON) {
    const int gw = C.vcu * 8 + C.wave, NGW = C.G * 8, lane = C.lane, l32 = lane & 31;
    float d1 = lq1[lane] * lk1[lane] + lq1[lane + 64] * lk1[lane + 64], d2 = lq2[lane] * lk2[lane] + lq2[lane + 64] * lk2[lane + 64];
    d1 = wsum(d1); d2 = wsum(d2);
    const float lam = expf(d1) - expf(d2) + lambda_init;
    const f32x4 g0 = *(const GAS f32x4*)(subg + l32 * 8), g1 = *(const GAS f32x4*)(subg + l32 * 8 + 4);
    for (int r = gw; r < NR; r += NGW) {
        v4u raw[DH];
#pragma unroll
        for (int h = 0; h < DH; ++h) raw[h] = *(const GAS v4u*)(O + (size_t)r * 4096 + h * 512 + lane * 8);
#pragma unroll
        for (int h = 0; h < DH; ++h) {
            float v[8]; float ss = 0.f;
#pragma unroll
            for (int j = 0; j < 4; ++j) { const unsigned mine = raw[h][j], other = (unsigned)__shfl((int)mine, l32 + 32);
                const float a0 = __builtin_bit_cast(float, mine << 16), a1 = __builtin_bit_cast(float, mine & 0xffff0000u), b0 = __builtin_bit_cast(float, other << 16), b1 = __builtin_bit_cast(float, other & 0xffff0000u);
                v[2 * j] = a0 - lam * b0; v[2 * j + 1] = a1 - lam * b1; ss += v[2 * j] * v[2 * j] + v[2 * j + 1] * v[2 * j + 1]; }
#pragma unroll
            for (int o = 1; o < 32; o <<= 1) ss += __shfl_xor(ss, o);
            const float k = rsqrtf(ss * (1.0f / 256) + EPS) * (1.0f - lambda_init);
            v4u ow; ow.x = pk2(v[0] * k * g0.x, v[1] * k * g0.y); ow.y = pk2(v[2] * k * g0.z, v[3] * k * g0.w); ow.z = pk2(v[4] * k * g1.x, v[5] * k * g1.y); ow.w = pk2(v[6] * k * g1.z, v[7] * k * g1.w);
            if (lane < 32) *(GAS v4u*)(ON + (size_t)r * 2048 + h * 256 + l32 * 8) = ow;
        }
    }
}

namespace att {
constexpr int NQR2 = 4;
constexpr int D2_K = 0, D2_V = 2 * 16384, D2_Q = D2_V + 2 * 32768, D2_WS = D2_Q + NW * (8 - NQR2) * 1024, SHM_D2 = D2_WS + NW * 64 * 4;
constexpr int v_rd_off2(int d0, int ks, int half) { return d0 * 512 + ks * 8192 + half * 4096; }
template <int D0, int SLOT> __device__ __forceinline__ void pv_one2(f32x16& od, int vb, bf16x8 pa0, bf16x8 pa1, bf16x8 pa2, bf16x8 pa3) {
  constexpr int B = SLOT * 32768;
  const s16x4 l0 = tr_read<B + v_rd_off2(D0, 0, 0)>(vb), h0 = tr_read<B + v_rd_off2(D0, 0, 1)>(vb), l1 = tr_read<B + v_rd_off2(D0, 1, 0)>(vb), h1 = tr_read<B + v_rd_off2(D0, 1, 1)>(vb);
  const s16x4 l2 = tr_read<B + v_rd_off2(D0, 2, 0)>(vb), h2 = tr_read<B + v_rd_off2(D0, 2, 1)>(vb), l3 = tr_read<B + v_rd_off2(D0, 3, 0)>(vb), h3 = tr_read<B + v_rd_off2(D0, 3, 1)>(vb);
  asm volatile("s_waitcnt lgkmcnt(0)" ::: "memory"); ATT_SBAR();
#define ATT_PK(L, H) (bf16x8){L[0], L[1], L[2], L[3], H[0], H[1], H[2], H[3]}
  od = __builtin_amdgcn_mfma_f32_32x32x16_bf16(pa0, ATT_PK(l0, h0), od, 0, 0, 0);
  od = __builtin_amdgcn_mfma_f32_32x32x16_bf16(pa1, ATT_PK(l1, h1), od, 0, 0, 0);
  od = __builtin_amdgcn_mfma_f32_32x32x16_bf16(pa2, ATT_PK(l2, h2), od, 0, 0, 0);
  od = __builtin_amdgcn_mfma_f32_32x32x16_bf16(pa3, ATT_PK(l3, h3), od, 0, 0, 0);
#undef ATT_PK
}
__device__ __forceinline__ void qkt2(f32x16& p0, f32x16& p1, const char* Ks, const int (&kb)[4], const bf16x8* qr, const char* qrl) {
  p0 = f32x16{}; p1 = f32x16{};
#pragma unroll
  for (int d0 = 0; d0 < 8; ++d0) {
    bf16x8 b0 = *reinterpret_cast<const bf16x8*>(Ks + kb[d0 & 3] + (d0 >> 2) * 128);
    bf16x8 b1 = *reinterpret_cast<const bf16x8*>(Ks + kb[d0 & 3] + (d0 >> 2) * 128 + 8192);
    bf16x8 q; if (d0 < NQR2) q = qr[d0]; else q = *reinterpret_cast<const bf16x8*>(qrl + (d0 - NQR2) * 1024);
    p0 = __builtin_amdgcn_mfma_f32_32x32x16_bf16(b0, q, p0, 0, 0, 0);
    p1 = __builtin_amdgcn_mfma_f32_32x32x16_bf16(b1, q, p1, 0, 0, 0); }
}
template <int LDQ, int LDK, int LDV, int LDO, int MODE>
__device__ __forceinline__ void attn_dv256_body(const bf16* __restrict__ Qb, const bf16* __restrict__ Kh, const bf16* __restrict__ Vh, bf16* __restrict__ Ob, float* __restrict__ S1, float lam, const float* __restrict__ subg, float osc,
                                                int seq, char* lds, LAS unsigned char* ldsL, float scale) {
  const float Cs = scale * 1.4426950408889634f, thr = THR / scale;
  const int tid = threadIdx.x, wid = __builtin_amdgcn_readfirstlane(tid >> 6), lane = tid & 63, r32 = lane & 31, hi = lane >> 5;
  float* ws = (float*)(lds + D2_WS) + wid * 64; float* li_l = ws; float* al_l = ws + 32;
  const char* qrl = lds + D2_Q + wid * (8 - NQR2) * 1024 + lane * 16;
  float m_reg = -1e30f, l_reg = 0; f32x16 o[8] = {}; bf16x8 qr[NQR2 > 0 ? NQR2 : 1];
  { int t1 = threadIdx.x; asm volatile("" : "+v"(t1));
    const int w1 = t1 >> 6, l1 = t1 & 63;
    const bf16* Qw = Qb + (long)(w1 * QBLK + (l1 & 31)) * LDQ + (l1 >> 5) * 8;
    char* ql1 = lds + D2_Q + w1 * (8 - NQR2) * 1024 + l1 * 16;
#pragma unroll
    for (int d0 = 0; d0 < NQR2; ++d0) qr[d0] = *reinterpret_cast<const bf16x8*>(Qw + d0 * 16);
#pragma unroll
    for (int d0 = NQR2; d0 < 8; ++d0) *reinterpret_cast<bf16x8*>(ql1 + (d0 - NQR2) * 1024) = *reinterpret_cast<const bf16x8*>(Qw + d0 * 16); }
  unsigned ko[2], vo[4];
#pragma unroll
  for (int i = 0; i < 2; ++i) { const int ch = (wid * 2 + i) * 64 + lane, row = ch >> 4, cpos = ch & 15; ko[i] = (unsigned)(row * LDK + ((cpos ^ (row & 7)) * 8)) * 2u; }
#pragma unroll
  for (int i = 0; i < 4; ++i) { const int ch = (wid * 4 + i) * 64 + lane, st = ch >> 5, w16 = ch & 31, kk = ((st >> 3) << 3) | (w16 >> 2), k = (kk & ~0xC) | ((kk & 4) << 1) | ((kk & 8) >> 1), col = (st & 7) * 32 + (w16 & 3) * 8;
    vo[i] = (unsigned)(k * LDV + col) * 2u; }
  int kb[4];
#pragma unroll
  for (int k = 0; k < 4; ++k) kb[k] = r32 * 256 + (((hi << 4) ^ ((r32 & 7) << 4)) ^ (k << 5));
  const int vb0 = (int)(uintptr_t)(lds + D2_V) + v_rd_base(lane);
#define D2_DMA(slot, k0) do { const char* kt_ = (const char*)Kh + (size_t)(k0) * (LDK * 2); const char* vt_ = (const char*)Vh + (size_t)(k0) * (LDV * 2); \
    _Pragma("unroll") for (int i_ = 0; i_ < 2; ++i_) __builtin_amdgcn_global_load_lds((const unsigned*)(kt_ + ko[i_]), (LAS unsigned*)(ldsL + D2_K + (slot) * 16384 + (wid * 2 + i_) * 1024), 16, 0, 0); \
    _Pragma("unroll") for (int i_ = 0; i_ < 4; ++i_) __builtin_amdgcn_global_load_lds((const unsigned*)(vt_ + vo[i_]), (LAS unsigned*)(ldsL + D2_V + (slot) * 32768 + (wid * 4 + i_) * 1024), 16, 0, 0); } while (0)
#define D2_RESC(a) do { if (__any((a) < 1.f)) { if (hi == 0) al_l[r32] = (a); asm volatile("s_waitcnt lgkmcnt(0)" ::: "memory"); \
    _Pragma("unroll") for (int d = 0; d < 8; ++d) _Pragma("unroll") for (int r = 0; r < 16; ++r) o[d][r] *= al_l[crow(r, hi)]; } } while (0)
#define D2_TILE(slot, jj) do { \
    asm volatile("s_waitcnt vmcnt(0)" ::: "memory"); __builtin_amdgcn_s_barrier(); asm volatile("" ::: "memory");        \
    if ((jj) + 1 < NT) D2_DMA(1 - (slot), ((jj) + 1) * KVBLK); \
    f32x16 p0, p1; float mn, al; bf16x8 pa0, pa1, pa2, pa3; \
    ATT_SBAR(); qkt2(p0, p1, lds + D2_K + (slot) * 16384, kb, qr, qrl); \
    partialSM(p0, p1, m_reg, mn, al, Cs, thr); D2_RESC(al); \
    finishSM(p0, p1, al, l_reg, pa0, pa1, pa2, pa3); ATT_SBAR(); \
    pv_one2<0, slot>(o[0], vb0, pa0, pa1, pa2, pa3); pv_one2<1, slot>(o[1], vb0, pa0, pa1, pa2, pa3); pv_one2<2, slot>(o[2], vb0, pa0, pa1, pa2, pa3); pv_one2<3, slot>(o[3], vb0, pa0, pa1, pa2, pa3); \
    pv_one2<4, slot>(o[4], vb0, pa0, pa1, pa2, pa3); pv_one2<5, slot>(o[5], vb0, pa0, pa1, pa2, pa3); pv_one2<6, slot>(o[6], vb0, pa0, pa1, pa2, pa3); pv_one2<7, slot>(o[7], vb0, pa0, pa1, pa2, pa3); } while (0)
  const int NT = seq / KVBLK;
  D2_DMA(0, 0);
  for (int j = 0; j < NT; j += 2) { D2_TILE(0, j); D2_TILE(1, j + 1); }
  if (hi == 0) li_l[r32] = l_reg; asm volatile("s_waitcnt lgkmcnt(0)" ::: "memory");
  { int t2 = threadIdx.x; asm volatile("" : "+v"(t2));
    const int w2 = t2 >> 6, l2 = t2 & 63, r2 = l2 & 31, h2 = l2 >> 5;
    const float* li2 = (const float*)(lds + D2_WS) + w2 * 64;
    float* Sw = S1 + (w2 * QBLK) * 256 + r2;
    if constexpr (MODE == 0) {
#pragma unroll
      for (int r = 0; r < 16; ++r) { const int orow = crow(r, h2); const float rl = __builtin_amdgcn_rcpf(li2[orow]);
#pragma unroll
        for (int d0 = 0; d0 < 8; ++d0) Sw[orow * 256 + d0 * 32] = o[d0][r] * rl; }
    } else {
      bf16* Ow = Ob + (long)(w2 * QBLK) * LDO + r2;
      float sg[8];
#pragma unroll
      for (int d0 = 0; d0 < 8; ++d0) sg[d0] = subg[d0 * 32 + r2] * osc;
#pragma unroll
      for (int r = 0; r < 16; ++r) { const int orow = crow(r, h2); const float rl = __builtin_amdgcn_rcpf(li2[orow]) * lam;
        float dv[8]; float ss = 0.f;
#pragma unroll
        for (int d0 = 0; d0 < 8; ++d0) { dv[d0] = Sw[orow * 256 + d0 * 32] - o[d0][r] * rl; ss += dv[d0] * dv[d0]; }
#pragma unroll
        for (int sh = 1; sh < 32; sh <<= 1) ss += __shfl_xor(ss, sh);
        const float kk = rsqrtf(ss * (1.0f / 256) + EPS);
#pragma unroll
        for (int d0 = 0; d0 < 8; ++d0) Ow[(long)orow * LDO + d0 * 32] = (bf16)::f2bf(dv[d0] * kk * sg[d0]); } } }
  asm volatile("s_waitcnt vmcnt(0) lgkmcnt(0)" ::: "memory"); __builtin_amdgcn_s_barrier(); asm volatile("" ::: "memory");
#undef D2_DMA
#undef D2_RESC
#undef D2_TILE
}
}

__device__ __forceinline__ void ph_diff_attn3(const Ctx& C, const bf16* QKV, float* S1g, const float* lq1, const float* lk1, const float* lq2, const float* lk2, const float* subg, float lambda_init, bf16* ON) {
    const float scale = 0.08838834764831845f;
    const int lane = C.lane;
    float d1 = lq1[lane] * lk1[lane] + lq1[lane + 64] * lk1[lane + 64], d2 = lq2[lane] * lk2[lane] + lq2[lane + 64] * lk2[lane + 64];
    d1 = wsum(d1); d2 = wsum(d2);
    const float lam = expf(d1) - expf(d2) + lambda_init, osc = 1.0f - lambda_init;
    float* S1 = S1g + (size_t)C.vcu * 256 * 256;
    constexpr int NLAT = BATCH * DH * (SEQ / 256), NUN = NLAT + BATCH * DH;
    for (int u = C.vcu; u < NUN; u += C.G) {
        const bool isctx = u >= NLAT; const int combo = isctx ? (u - NLAT) : (u >> 5), qb = isctx ? 32 : (u & 31);
        const int h = combo & (DH - 1), b = combo / DH;
        const size_t qrow = (size_t)b * TB + (size_t)qb * 256, krow = (size_t)b * TB + (isctx ? SEQ : 0);
        const att::bf16* Qp = (const att::bf16*)QKV + qrow * NQKV + h * 256; const att::bf16* Kp = (const att::bf16*)QKV + krow * NQKV + 2048 + h * 256; const att::bf16* Vp = (const att::bf16*)QKV + krow * NQKV + 4096 + h * 256;
        att::attn_dv256_body<NQKV, NQKV, NQKV, 2048, 0>(Qp, Kp, Vp, nullptr, S1, lam, subg, osc, isctx ? CTXL : TB, (char*)C.lds, C.lds, scale);
        att::attn_dv256_body<NQKV, NQKV, NQKV, 2048, 1>(Qp + 128, Kp + 128, Vp, (att::bf16*)ON + qrow * 2048 + h * 256, S1, lam, subg, osc, isctx ? CTXL : TB, (char*)C.lds, C.lds, scale);
    }
}

namespace att {
constexpr size_t SHM_K2 = KVBLK * 192 * 2;
constexpr size_t MLA_OFF_K = 2 * SHM_V, MLA_OFF_WS = MLA_OFF_K + 2 * SHM_K2, MLA_OFF_QR = MLA_OFF_WS + NW * 64 * 4, SHM_MLA = MLA_OFF_QR + NW * 4 * 1024;
#define ATT_KSWZ2(row, colB) ((row) * 384 + ((colB) ^ (((row) & 7) << 4)))
constexpr int NQREG = 8;
__device__ __forceinline__ void qkt192(f32x16& p0, f32x16& p1, const char* Ks, const int (&kb)[4], const bf16x8* qr, const char* qrl) {
  p0 = f32x16{}; p1 = f32x16{};
#pragma unroll
  for (int d0 = 0; d0 < 12; ++d0) {
    bf16x8 b0 = *reinterpret_cast<const bf16x8*>(Ks + kb[d0 & 3] + (d0 >> 2) * 128);
    bf16x8 b1 = *reinterpret_cast<const bf16x8*>(Ks + kb[d0 & 3] + (d0 >> 2) * 128 + 32 * 384);
    bf16x8 q; if (d0 < NQREG) q = qr[d0]; else q = *reinterpret_cast<const bf16x8*>(qrl + (d0 - NQREG) * 1024);
    p0 = __builtin_amdgcn_mfma_f32_32x32x16_bf16(b0, q, p0, 0, 0, 0);
    p1 = __builtin_amdgcn_mfma_f32_32x32x16_bf16(b1, q, p1, 0, 0, 0); }
}
template <int LDQ, int LDKN, int LDKR, int LDO>
__device__ __forceinline__ void attn_mla_body(const bf16* __restrict__ Qb, const bf16* __restrict__ Kn, const bf16* __restrict__ Kr, bf16* __restrict__ Ob, int seq, char* lds, float scale) {
  const float Cs = scale * 1.4426950408889634f, thr = THR / scale;
  const int tid = threadIdx.x, wid = tid >> 6, lane = tid & 63, r32 = lane & 31, hi = lane >> 5;
  bf16* V_lds = (bf16*)lds; bf16* K_lds = (bf16*)(lds + MLA_OFF_K);
  float* ws = (float*)(lds + MLA_OFF_WS) + wid * 64; float* li_l = ws; float* al_l = ws + 32;
  char* qrl = lds + MLA_OFF_QR + wid * (12 - NQREG) * 1024 + lane * 16;
  float m_reg = -1e30f, l_reg = 0; f32x16 o[4] = {}; bf16x8 qr[NQREG > 0 ? NQREG : 1];
  { int t1 = threadIdx.x; asm volatile("" : "+v"(t1));
    const int w1 = t1 >> 6, l1 = t1 & 63;
    const bf16* Qw = Qb + (long)(w1 * QBLK + (l1 & 31)) * LDQ + (l1 >> 5) * 8;
    char* ql1 = lds + MLA_OFF_QR + w1 * (12 - NQREG) * 1024 + l1 * 16;
#pragma unroll
    for (int d0 = 0; d0 < NQREG; ++d0) qr[d0] = *reinterpret_cast<const bf16x8*>(Qw + d0 * 16);
#pragma unroll
    for (int d0 = NQREG; d0 < 12; ++d0) *reinterpret_cast<bf16x8*>(ql1 + (d0 - NQREG) * 1024) = *reinterpret_cast<const bf16x8*>(Qw + d0 * 16); }
  const int sr = tid >> 4, sc = (tid & 15) * 8, vst0 = v_st(sr, sc), vst1 = v_st(32 + sr, sc);
  const int r3 = tid >> 3, c3 = (tid & 7) * 8;
  const int vb0 = (int)(uintptr_t)V_lds + v_rd_base(lane);
  struct { bf16x8 vs0, vs1, ks0, ks1, kr; } sr_[2];
  const unsigned oK = (unsigned)(sr * LDKN + sc) * 2u, oR = (unsigned)(r3 * LDKR + c3) * 2u;
  int kb[4];
#pragma unroll
  for (int k = 0; k < 4; ++k) kb[k] = r32 * 384 + (((hi << 4) ^ ((r32 & 7) << 4)) ^ (k << 5));
#define SLOAD(i, k0) do { const char* kt_ = (const char*)Kn + (size_t)(k0) * (LDKN * 2); const char* rt_ = (const char*)Kr + (size_t)(k0) * (LDKR * 2); \
    sr_[i].vs0 = *reinterpret_cast<const bf16x8*>(kt_ + oK + 256); sr_[i].vs1 = *reinterpret_cast<const bf16x8*>(kt_ + (size_t)32 * LDKN * 2 + oK + 256); \
    sr_[i].ks0 = *reinterpret_cast<const bf16x8*>(kt_ + oK); sr_[i].ks1 = *reinterpret_cast<const bf16x8*>(kt_ + (size_t)32 * LDKN * 2 + oK); \
    sr_[i].kr = *reinterpret_cast<const bf16x8*>(rt_ + oR); } while (0)
#define SWRITE(b, i) do { *(bf16x8*)((char*)V_lds + (b) * SHM_V + vst0) = sr_[i].vs0;          \
    *(bf16x8*)((char*)V_lds + (b) * SHM_V + vst1) = sr_[i].vs1; int kc = sc * 2;               \
    *(bf16x8*)((char*)K_lds + (b) * SHM_K2 + ATT_KSWZ2(sr, kc)) = sr_[i].ks0;                       \
    *(bf16x8*)((char*)K_lds + (b) * SHM_K2 + ATT_KSWZ2(32 + sr, kc)) = sr_[i].ks1;                  \
    *(bf16x8*)((char*)K_lds + (b) * SHM_K2 + ATT_KSWZ2(r3, 256 + c3 * 2)) = sr_[i].kr; } while (0)
#define SWAIT() asm volatile("s_waitcnt vmcnt(5)" ::: "memory")
#define RESC(a) do { if (__any((a) < 1.f)) { if (hi == 0) al_l[r32] = (a); asm volatile("s_waitcnt lgkmcnt(0)" ::: "memory"); \
    _Pragma("unroll") for (int d = 0; d < 4; ++d) _Pragma("unroll") for (int r = 0; r < 16; ++r) o[d][r] *= al_l[crow(r, hi)]; } } while (0)
  f32x16 pA0, pA1, pB0, pB1; float mnA, mnB, alA, alB; bf16x8 pa0, pa1, pa2, pa3; const int NT = seq / KVBLK;
  constexpr int SE = 0, SO = 1;
  SLOAD(SE, 0); asm volatile("s_waitcnt vmcnt(0)" ::: "memory"); SWRITE(0, SE); __syncthreads();
  qkt192(pA0, pA1, (const char*)K_lds, kb, qr, qrl); partialSM(pA0, pA1, m_reg, mnA, alA, Cs, thr);
  SLOAD(SO, KVBLK); if (2 < NT) SLOAD(SE, 2 * KVBLK);
  SWAIT(); SWRITE(1, SO); __syncthreads();
  for (int j = 1; j + 1 < NT; j += 2) {
    ATT_SBAR(); qkt192(pB0, pB1, (const char*)K_lds + SHM_K2, kb, qr, qrl);
    finishSM(pA0, pA1, alA, l_reg, pa0, pa1, pa2, pa3); ATT_SBAR();
    SLOAD(SO, (j + 2) * KVBLK); ATT_SBAR();
    pv_d0(o, vb0, pa0, pa1, pa2, pa3); partialSM(pB0, pB1, m_reg, mnB, alB, Cs, thr);
    __syncthreads(); SWAIT(); SWRITE(0, SE);
    RESC(alB); __syncthreads();
    ATT_SBAR(); qkt192(pA0, pA1, (const char*)K_lds, kb, qr, qrl);
    finishSM(pB0, pB1, alB, l_reg, pa0, pa1, pa2, pa3); ATT_SBAR();
    if (j + 3 < NT) SLOAD(SE, (j + 3) * KVBLK); ATT_SBAR();
    pv_d0(o, vb0 + (int)SHM_V, pa0, pa1, pa2, pa3); partialSM(pA0, pA1, m_reg, mnA, alA, Cs, thr);
    __syncthreads(); SWAIT(); SWRITE(1, SO);
    RESC(alA); __syncthreads();
  }
  ATT_SBAR(); qkt192(pB0, pB1, (const char*)K_lds + SHM_K2, kb, qr, qrl);
  finishSM(pA0, pA1, alA, l_reg, pa0, pa1, pa2, pa3); ATT_SBAR();
  pv_d0(o, vb0, pa0, pa1, pa2, pa3); partialSM(pB0, pB1, m_reg, mnB, alB, Cs, thr);
  __syncthreads(); RESC(alB);
  finishSM(pB0, pB1, alB, l_reg, pa0, pa1, pa2, pa3); ATT_SBAR();
  pv_d0(o, vb0 + (int)SHM_V, pa0, pa1, pa2, pa3);
  if (hi == 0) li_l[r32] = l_reg; asm volatile("s_waitcnt lgkmcnt(0)" ::: "memory");
  {
    int t2 = threadIdx.x; asm volatile("" : "+v"(t2));
    const int w2 = t2 >> 6, l2 = t2 & 63, r2 = l2 & 31, h2 = l2 >> 5;
    const float* li2 = (const float*)(lds + MLA_OFF_WS) + w2 * 64;
    bf16* Ow = Ob + (long)(w2 * QBLK) * LDO + r2;
#pragma unroll
    for (int r = 0; r < 16; ++r) { const int orow = crow(r, h2); const float rl = __builtin_amdgcn_rcpf(li2[orow]);
#pragma unroll
      for (int d0 = 0; d0 < 4; ++d0) Ow[(long)orow * LDO + d0 * 32] = (bf16)::f2bf(o[d0][r] * rl); } }
  asm volatile("s_waitcnt vmcnt(0) lgkmcnt(0)" ::: "memory"); __syncthreads();
#undef SLOAD
#undef SWRITE
#undef SWAIT
#undef RESC
}
}

namespace pg8 {
struct EpiF32Store {
    static constexpr bool PERM = false, AFTER_DRAIN = false;
    float* Cc; int ldc; float* part;
    __device__ __forceinline__ void quad(const f32x4 (&a)[4][2], const Unit& u, int ai, int bj, int wr, int wc, int fr, int fq) const {
        const int row0 = u.pm * BM + ai * HALF + wr * 64 + fr, col0 = u.pn * BM + bj * HALF + wc * 32 + 4 * fq;
#pragma unroll
        for (int m = 0; m < 4; ++m) { float* rowp = Cc + (size_t)(row0 + m * 16) * ldc + col0; *(f32x4*)rowp = a[m][0]; *(f32x4*)(rowp + 16) = a[m][1]; }
    }
    __device__ __forceinline__ void quad_part(const f32x4 (&a)[4][2], const Unit& u, int ai, int bj, int sp, int pc, int wr, int wc, int fr, int fq) const {
        const int col0 = u.pn * BM + bj * HALF + wc * 32 + 4 * fq, rl0 = pc * BM + ai * HALF + wr * 64 + fr;
#pragma unroll
        for (int m = 0; m < 4; ++m) { float* rowp = part + ((size_t)sp * 512 + rl0 + m * 16) * ldc + col0; *(f32x4*)rowp = a[m][0]; *(f32x4*)(rowp + 16) = a[m][1]; }
    }
    __device__ __forceinline__ void operator()(const f32x4 (&acc)[2][2][4][2], const Unit& u, int wr, int wc, int fr, int fq) const {
#pragma unroll
        for (int ai = 0; ai < 2; ++ai)
#pragma unroll
            for (int bj = 0; bj < 2; ++bj) quad(acc[ai][bj], u, ai, bj, wr, wc, fr, fq);
    }
};
struct EpiMlaDown {
    static constexpr bool PERM = false, AFTER_DRAIN = true;
    float* part; const float* gq; const float* gkv; const float* tab; bf16_t* CQn; bf16_t* CKVn; bf16_t* KR; float* slots; unsigned* cnt; unsigned* tmo;
    __device__ __forceinline__ void fused(f32x4 (&acc)[2][2][4][2], const Unit& u, int wr, int wc, int fr, int fq, PG8_LAS unsigned char* lds, int wid, int lane) const {
        PG8_LAS float* P = (PG8_LAS float*)lds;
        PG8_LAS float* S = (PG8_LAS float*)(lds + 8192);
        PG8_LAS unsigned char* stg = lds + 12288;
#pragma unroll
        for (int ai = 0; ai < 2; ++ai)
#pragma unroll
            for (int m = 0; m < 4; ++m)
#pragma unroll
                for (int bj = 0; bj < 2; ++bj) { const f32x4 a0 = acc[ai][bj][m][0], a1 = acc[ai][bj][m][1];
                    float q = (a0[0] * a0[0] + a0[1] * a0[1]) + (a0[2] * a0[2] + a0[3] * a0[3]) + (a1[0] * a1[0] + a1[1] * a1[1]) + (a1[2] * a1[2] + a1[3] * a1[3]);
                    q += __shfl_xor(q, 16); q += __shfl_xor(q, 32);
                    if (fq == 0) P[(ai * HALF + wr * 64 + m * 16 + fr) * 8 + bj * 4 + wc] = q; }
        asm volatile("s_waitcnt lgkmcnt(0)" ::: "memory"); __builtin_amdgcn_s_barrier(); asm volatile("" ::: "memory");
        const int row = wid * 32 + (lane & 31);
        if (lane < 32) { float tq = 0.f, tkv = 0.f;
#pragma unroll
            for (int s8 = 0; s8 < 8; ++s8) { const int ci = u.pn * 8 + s8; const float v = P[row * 8 + s8]; if (ci < 14) tq += v; else if (ci < 30) tkv += v; }
            unsigned* sl = (unsigned*)slots + ((size_t)(u.pm * BM + row) * 8 + u.pn * 2);
            __hip_atomic_store(sl, __float_as_uint(tq), __ATOMIC_RELAXED, __HIP_MEMORY_SCOPE_AGENT); __hip_atomic_store(sl + 1, __float_as_uint(tkv), __ATOMIC_RELAXED, __HIP_MEMORY_SCOPE_AGENT); }
        asm volatile("s_waitcnt vmcnt(0)" ::: "memory");
        if (lane == 0) __hip_atomic_fetch_add(cnt + 64 * u.pm, 1u, __ATOMIC_RELAXED, __HIP_MEMORY_SCOPE_AGENT);
        if (wid == 0) { unsigned sp = 0;
            for (;;) { if ((unsigned)__builtin_amdgcn_readfirstlane(__hip_atomic_load(cnt + 64 * u.pm, __ATOMIC_RELAXED, __HIP_MEMORY_SCOPE_AGENT)) >= 32u) break;
                __builtin_amdgcn_s_sleep(2);
                if (++sp > (1u << 18)) { if (lane == 0) __hip_atomic_store(tmo, 1u, __ATOMIC_RELAXED, __HIP_MEMORY_SCOPE_AGENT); break; } }
            __builtin_amdgcn_fence(__ATOMIC_ACQUIRE, "agent"); }
        asm volatile("s_waitcnt vmcnt(0) lgkmcnt(0)" ::: "memory"); __builtin_amdgcn_s_barrier(); asm volatile("" ::: "memory");
        if (lane < 32) { const unsigned* sl = (const unsigned*)slots + (size_t)(u.pm * BM + row) * 8; float tq = 0.f, tkv = 0.f;
#pragma unroll
            for (int k = 0; k < 4; ++k) { tq += __uint_as_float(__hip_atomic_load(sl + 2 * k, __ATOMIC_RELAXED, __HIP_MEMORY_SCOPE_AGENT)); tkv += __uint_as_float(__hip_atomic_load(sl + 2 * k + 1, __ATOMIC_RELAXED, __HIP_MEMORY_SCOPE_AGENT)); }
            S[row * 2] = rsqrtf(tq * (1.0f / MQR) + EPS); S[row * 2 + 1] = rsqrtf(tkv * (1.0f / MKVR) + EPS); }
        asm volatile("s_waitcnt vmcnt(0) lgkmcnt(0)" ::: "memory"); __builtin_amdgcn_s_barrier(); asm volatile("" ::: "memory");
#pragma unroll
        for (int bj = 0; bj < 2; ++bj) { const int ci = u.pn * 8 + bj * 4 + wc, cg = ci * 32 + 4 * fq;
            if (ci < 30) { const bool isq = ci < 14; const float* gp = isq ? gq + cg : gkv + (cg - MQR);
                const f32x4 g0 = *(const f32x4*)gp, g1 = *(const f32x4*)(gp + 16);
#pragma unroll
                for (int ai = 0; ai < 2; ++ai)
#pragma unroll
                    for (int m = 0; m < 4; ++m) { const int r = ai * HALF + wr * 64 + m * 16 + fr; const float rs = S[r * 2 + (isq ? 0 : 1)];
                        const f32x4 y0 = acc[ai][bj][m][0] * rs * g0, y1 = acc[ai][bj][m][1] * rs * g1;
                        PG8_LAS unsigned char* d = stg + r * 528 + (bj * HALF + wc * 32 + 4 * fq) * 2;
                        *(PG8_LAS unsigned long long*)d = (unsigned long long)cvt_pk_bf16(y0[0], y0[1]) | ((unsigned long long)cvt_pk_bf16(y0[2], y0[3]) << 32);
                        *(PG8_LAS unsigned long long*)(d + 32) = (unsigned long long)cvt_pk_bf16(y1[0], y1[1]) | ((unsigned long long)cvt_pk_bf16(y1[2], y1[3]) << 32); }
            } else { const int half = ci - 30;
#pragma unroll
                for (int ai = 0; ai < 2; ++ai)
#pragma unroll
                    for (int m = 0; m < 4; ++m) { const int r = ai * HALF + wr * 64 + m * 16 + fr, t = (u.pm * BM + r) % TB, pos = half ? (t % GRID_W) : (t / GRID_W);
                        const f32x4 cs = *(const f32x4*)(tab + 8192 + pos * 16 + 4 * fq), sn = *(const f32x4*)(tab + 8192 + 2048 + pos * 16 + 4 * fq);
                        const f32x4 lo = acc[ai][bj][m][0], hi = acc[ai][bj][m][1]; const f32x4 ylo = lo * cs - hi * sn, yhi = hi * cs + lo * sn;
                        u32x4 w; w.x = cvt_pk_bf16(ylo[0], yhi[0]); w.y = cvt_pk_bf16(ylo[1], yhi[1]); w.z = cvt_pk_bf16(ylo[2], yhi[2]); w.w = cvt_pk_bf16(ylo[3], yhi[3]);
                        *(PG8_LAS u32x4*)(stg + r * 528 + (bj * HALF + wc * 32 + 8 * fq) * 2) = w; }
            } }
        asm volatile("s_waitcnt lgkmcnt(0)" ::: "memory"); __builtin_amdgcn_s_barrier(); asm volatile("" ::: "memory");
        const int tid = wid * 64 + lane;
#pragma unroll
        for (int it = 0; it < 16; ++it) { const int p = it * 512 + tid, r = p >> 5, ch = p & 31, c = u.pn * BM + ch * 8; const size_t grow = (size_t)(u.pm * BM + r);
            const u32x4 v = *(const PG8_LAS u32x4*)(stg + r * 528 + ch * 16);
            if (c < MQR) *(u32x4*)(CQn + grow * 512 + c) = v;
            else if (c < MQR + MKVR) { *(u32x4*)(CKVn + grow * 512 + (c - MQR)) = v; if (c < 512) *(u32x4*)(CQn + grow * 512 + c) = (u32x4){0u, 0u, 0u, 0u}; }
            else *(u32x4*)(KR + grow * 64 + (c - MQR - MKVR)) = v; }
        asm volatile("s_waitcnt lgkmcnt(0)" ::: "memory"); __builtin_amdgcn_s_barrier(); asm volatile("" ::: "memory");
    }
    __device__ __forceinline__ void quad(const f32x4 (&)[4][2], const Unit&, int, int, int, int, int, int) const {}
    __device__ __forceinline__ void quad_part(const f32x4 (&a)[4][2], const Unit& u, int ai, int bj, int sp, int pc, int wr, int wc, int fr, int fq) const {
        const int col0 = u.pn * BM + bj * HALF + wc * 32 + 4 * fq, rl0 = pc * BM + ai * HALF + wr * 64 + fr;
#pragma unroll
        for (int m = 0; m < 4; ++m) { float* rowp = part + ((size_t)sp * 512 + rl0 + m * 16) * 1024 + col0; *(f32x4*)rowp = a[m][0]; *(f32x4*)(rowp + 16) = a[m][1]; }
    }
};
struct EpiMlaQ {
    static constexpr bool PERM = true, AFTER_DRAIN = false;
    bf16_t* O; PG8_LAS const float* tl;
    __device__ __forceinline__ void quad(const f32x4 (&a)[4][2], const Unit& u, int ai, int bj, int wr, int wc, int fr, int fq) const {
        const int row0 = u.pm * BM + ai * HALF + wr * 64 + fr, col0 = u.pn * BM + bj * HALF + wc * 32 + 8 * fq;
        const int hd = col0 % 192, e0 = hd - 128; const bool rope = hd >= 128; const int half = (e0 >> 5) & 1, f0 = (e0 & 31) >> 1;
#pragma unroll
        for (int m = 0; m < 4; ++m) { const int row = row0 + m * 16, t = row % TB; const f32x4 v0 = a[m][0], v1 = a[m][1];
            f32x4 cs = {1.f, 1.f, 1.f, 1.f}, sn = {0.f, 0.f, 0.f, 0.f};
            if (rope) { const int pos = half ? (t % GRID_W) : (t / GRID_W); cs = *(PG8_LAS const f32x4*)(tl + pos * 16 + f0); sn = *(PG8_LAS const f32x4*)(tl + 2048 + pos * 16 + f0); }
            const float a0 = v0[0] * cs[0] - v0[1] * sn[0], b0 = v0[1] * cs[0] + v0[0] * sn[0], a1 = v0[2] * cs[1] - v0[3] * sn[1], b1 = v0[3] * cs[1] + v0[2] * sn[1];
            const float a2 = v1[0] * cs[2] - v1[1] * sn[2], b2 = v1[1] * cs[2] + v1[0] * sn[2], a3 = v1[2] * cs[3] - v1[3] * sn[3], b3 = v1[3] * cs[3] + v1[2] * sn[3];
            u32x4 w; w.x = cvt_pk_bf16(a0, b0); w.y = cvt_pk_bf16(a1, b1); w.z = cvt_pk_bf16(a2, b2); w.w = cvt_pk_bf16(a3, b3);
            *(u32x4*)(O + (size_t)row * 3072 + col0) = w; }
    }
    __device__ __forceinline__ void operator()(const f32x4 (&acc)[2][2][4][2], const Unit& u, int wr, int wc, int fr, int fq) const {
#pragma unroll
        for (int ai = 0; ai < 2; ++ai)
#pragma unroll
            for (int bj = 0; bj < 2; ++bj) quad(acc[ai][bj], u, ai, bj, wr, wc, fr, fq);
    }
};
}

__device__ __forceinline__ void ph_mla_mid(const Ctx& C, const float* Cf, const float* part, const float* qg, const float* kvg, const float* tab, bf16* CQn, bf16* CKVn, bf16* KR, int ctx_only = 0, unsigned* pub = nullptr) {
    const int gw = C.vcu * 8 + C.wave, NGW = C.G * 8, lane = C.lane;
    float qgr[7], kvgr[8];
#pragma unroll
    for (int j = 0; j < 7; ++j) qgr[j] = qg[j * 64 + lane];
#pragma unroll
    for (int j = 0; j < 8; ++j) kvgr[j] = kvg[j * 64 + lane];
    for (int i = gw; i < (ctx_only ? BATCH * CTXL : NR); i += NGW) {
        const int r = ctx_only ? (i / CTXL) * TB + SEQ + i % CTXL : i;
        const int tt = r % TB; const bool isctx = tt >= SEQ;
        const float* cr = isctx ? part + ((size_t)(r / TB) * CTXL + (tt - SEQ)) * 1024 : Cf + (size_t)r * 1024;
        float q[7], kv[8]; float sq = 0.f, sk = 0.f; float x;
        if (isctx) {
#pragma unroll
            for (int j = 0; j < 7; ++j) q[j] = (cr[j * 64 + lane] + cr[512 * 1024 + j * 64 + lane]) + (cr[2 * 512 * 1024 + j * 64 + lane] + cr[3 * 512 * 1024 + j * 64 + lane]);
#pragma unroll
            for (int j = 0; j < 8; ++j) kv[j] = (cr[448 + j * 64 + lane] + cr[512 * 1024 + 448 + j * 64 + lane]) + (cr[2 * 512 * 1024 + 448 + j * 64 + lane] + cr[3 * 512 * 1024 + 448 + j * 64 + lane]);
            x = (cr[960 + lane] + cr[512 * 1024 + 960 + lane]) + (cr[2 * 512 * 1024 + 960 + lane] + cr[3 * 512 * 1024 + 960 + lane]);
        } else {
#pragma unroll
            for (int j = 0; j < 7; ++j) q[j] = cr[j * 64 + lane];
#pragma unroll
            for (int j = 0; j < 8; ++j) kv[j] = cr[448 + j * 64 + lane];
            x = cr[960 + lane];
        }
#pragma unroll
        for (int j = 0; j < 7; ++j) sq += q[j] * q[j];
#pragma unroll
        for (int j = 0; j < 8; ++j) sk += kv[j] * kv[j];
        const float rq = rsqrtf(wsum(sq) * (1.0f / 448) + EPS), rk = rsqrtf(wsum(sk) * (1.0f / 512) + EPS);
#pragma unroll
        for (int j = 0; j < 7; ++j) CQn[(size_t)r * 512 + j * 64 + lane] = (bf16)f2bf(q[j] * rq * qgr[j]);
        CQn[(size_t)r * 512 + 448 + lane] = (bf16)0;
#pragma unroll
        for (int j = 0; j < 8; ++j) { const unsigned me = f2bf(kv[j] * rk * kvgr[j]);
            if (pub) { const unsigned nb = (unsigned)__shfl_xor((int)me, 1); if ((lane & 1) == 0) __hip_atomic_store((unsigned*)(CKVn + (size_t)r * 512 + j * 64 + lane), me | (nb << 16), __ATOMIC_RELAXED, __HIP_MEMORY_SCOPE_AGENT); }
            else CKVn[(size_t)r * 512 + j * 64 + lane] = (bf16)me; }
        const int t = r % TB, half = lane >> 5, dd = lane & 31, f = dd & 15;
        const float xp = __shfl_xor(x, 16);
        float y = x;
        if (t < SEQ) { const int pos = half ? (t % GRID_W) : (t / GRID_W); const float cs = tab[8192 + pos * 16 + f], sn = tab[8192 + 2048 + pos * 16 + f];
            y = (dd < 16) ? (x * cs - xp * sn) : (x * cs + xp * sn); }
        const int np = (dd < 16) ? 2 * dd : 2 * (dd - 16) + 1;
        KR[(size_t)r * 64 + half * 32 + np] = (bf16)f2bf(y);
    }
    if (pub) { asm volatile("s_waitcnt vmcnt(0)" ::: "memory"); if (lane == 0) __hip_atomic_fetch_add(pub, 1u, __ATOMIC_RELAXED, __HIP_MEMORY_SCOPE_AGENT); }
}
__device__ __forceinline__ void ph_mla_attn(const Ctx& C, const bf16* Qm, const bf16* KVm, const bf16* KRm, bf16* OM) {
    const float scale = 0.07216878364870323f;
    constexpr int NUN = BATCH * MH * (SEQ / 256);
    for (int u = C.vcu; u < NUN; u += C.G) {
        const int combo = u >> 5, qb = u & 31, h = combo & 15, b = combo >> 4;
        const size_t qrow = (size_t)b * TB + (size_t)qb * 256, krow = (size_t)b * TB;
        att::attn_mla_body<3072, 4096, 64, 2048>((const att::bf16*)Qm + qrow * 3072 + h * 192, (const att::bf16*)KVm + krow * 4096 + h * 256, (const att::bf16*)KRm + krow * 64,
            (att::bf16*)OM + qrow * 2048 + h * 128, TB, (char*)C.lds, scale);
    }
}
static_assert(att::SHM_D2 <= RING_BYTES && att::SHM_MLA <= (size_t)RING_BYTES && att::SHM_ATTN <= (size_t)RING_BYTES, "attention LDS images fit below the control words");

#define PH(l, s) (1 + 10 * (l) + (s))
#ifndef GEMM_ALIGN
#define GEMM_ALIGN false
#define GEMM_SP2 true
#endif
constexpr int PH_FINAL = 41, PH_END = 42;

__global__ void __launch_bounds__(512, 2) mega(Args args) {
    extern __shared__ __attribute__((aligned(16))) unsigned char lds_raw[];
    Ctx C; C.lds = (LAS unsigned char*)lds_raw; C.tid = threadIdx.x; C.lane = C.tid & 63; C.wave = __builtin_amdgcn_readfirstlane(C.tid >> 6);
    C.G = gridDim.x; { const int bx = blockIdx.x; C.vcu = (C.G % 8 == 0) ? (bx % 8) * (C.G / 8) + bx / 8 : bx; }
    volatile LAS unsigned* MISC = (volatile LAS unsigned*)(C.lds + MISC_OFF);
    for (int u = C.tid; u < (LDS_BYTES - LDSCTL_OFF) / 4; u += 512) ((LAS unsigned*)(C.lds + LDSCTL_OFF))[u] = 0u;
    __syncthreads();
    unsigned char* ws = args.ws;
    XcdBarrier bar = xcd_barrier_post((unsigned*)(ws + WS_CTL) + CW_BAR + args.li * XCD_BAR_WORDS, MISC + 8);
    const int lo = args.ph_lo, hi = args.ph_hi; bool started = false;
#define PHASE_BEGIN(k) if (lo <= (k) && (k) < hi) { if (started) xcd_barrier(bar); started = true;
#define PHASE_END }
    float* X = (float*)(ws + WS_X); const float* mod = (const float*)(ws + WS_MOD);
    const pg8::bf16_t* WB = (const pg8::bf16_t*)(ws + WS_WB);
    bf16* XNb = (bf16*)(ws + FA_XN); bf16* Hb = (bf16*)(ws + FA_H);
    float* PARTf = (float*)(ws + FA_B + 136 * MiB);
    float* SLOTf = (float*)(ws + FA_B + 120 * MiB); unsigned* CNTw = (unsigned*)(ws + WS_CTL) + 131072; unsigned* TMOw = CNTw - 64;
    const bool fuse = (C.G == 256);
    unsigned* CTXC = CNTw + 9 * 66 * 64;
#define FUSED_RES(Aop, Wop, Kdim, gatep, ngp, nmodp, gid, xinp, CTX) { pg8::Gemm g{Aop, Wop, NR, D, Kdim}; \
        pg8::EpiResNorm E{X, gatep, ngp, nmodp, (pg8::bf16_t*)XNb, args.out, SLOTf, CNTw + (gid) * 66 * 64, TMOw, xinp, PARTf}; \
        pg8::SliceOrder S0{(int)blockIdx.x, 0, C.G}; pg8::gemm_phase<pg8::EpiResNorm, pg8::SliceOrder, GEMM_ALIGN, GEMM_SP2>(C.lds, g, S0, E); __syncthreads(); \
        pg8::SliceOrder S1{(int)blockIdx.x, 1, C.G}; pg8::gemm_phase<pg8::EpiResNorm, pg8::SliceOrder, GEMM_ALIGN, GEMM_SP2, (CTX), ((CTX) ? 4 : 1)>(C.lds, g, S1, E); }

    PHASE_BEGIN(0) ph_prologue(args, C, fuse ? CTXC + 6 * 64 : (unsigned*)nullptr);
        if (fuse) { if (C.wave == 0) { unsigned sp_ = 0; const unsigned want_ = (unsigned)C.G * 8u;
                for (;;) { if ((unsigned)__builtin_amdgcn_readfirstlane(__hip_atomic_load(CTXC + 6 * 64, __ATOMIC_RELAXED, __HIP_MEMORY_SCOPE_AGENT)) >= want_) break; __builtin_amdgcn_s_sleep(2); if (++sp_ > (1u << 20)) break; }
                __builtin_amdgcn_fence(__ATOMIC_ACQUIRE, "agent"); asm volatile("s_waitcnt vmcnt(0)" ::: "memory"); }
            __syncthreads();
            ph_norm(C, X, args.in[I_N1G], mod, 0, XNb, 0, args.in[I_X], args.in[I_CTX]); }
    PHASE_END

#define FFN_PHASES(l) \
    if (!fuse) { PHASE_BEGIN(PH(l, 6)) ph_norm(C, X, args.in[I_N2G] + (size_t)(l) * D, mod + (size_t)(l) * 3 * MODW, 1, XNb, (l) >= 2, nullptr, (l) == 0 ? args.in[I_CTX] : nullptr, (l) < 2 ? PARTf : nullptr, 4, 0); PHASE_END } \
    PHASE_BEGIN(PH(l, 7)) { pg8::Gemm g{XNb, WB + WB_FF1 + (size_t)(l) * D * DFF, NR, DFF, D}; \
        if (fuse && (l) < 2) { ph_norm(C, X, args.in[I_N2G] + (size_t)(l) * D, mod + (size_t)(l) * 3 * MODW, 1, XNb, 0, nullptr, (l) == 0 ? args.in[I_CTX] : nullptr, PARTf, 4, 2, CTXC + (l) * 64); g.ctxcnt = CTXC + (l) * 64; g.ctxwant = (unsigned)C.G * 8u; }     \
        pg8::StaticOrder S; S.init(BATCH * SEQ, DFF, C.G, (int)blockIdx.x, 1); \
        pg8::EpiAct<2> E{Hb, DFF}; pg8::gemm_phase<pg8::EpiAct<2>, pg8::StaticOrder, GEMM_ALIGN, GEMM_SP2, ((l) < 2)>(C.lds, g, S, E); } PHASE_END \
    PHASE_BEGIN(PH(l, 8)) if (fuse) FUSED_RES(Hb, WB + WB_FF2 + (size_t)(l) * D * DFF, DFF, mod + (size_t)(l) * 3 * MODW + 5 * D, (l) == 3 ? args.in[I_FING] : args.in[I_N1G] + (size_t)((l) + 1) * D, (l) == 3 ? (const float*)nullptr : mod + (size_t)((l) + 1) * 3 * MODW, 4 + (l), (const float*)nullptr, ((l) < 2)) \
        else { pg8::Gemm g{Hb, WB + WB_FF2 + (size_t)(l) * D * DFF, NR, D, DFF}; pg8::StaticOrder S; S.init(BATCH * SEQ, D, C.G, (int)blockIdx.x, 1); \
        pg8::EpiRes E{X, mod + (size_t)(l) * 3 * MODW + 5 * D, nullptr, nullptr, PARTf};  pg8::gemm_phase<pg8::EpiRes, pg8::StaticOrder, GEMM_ALIGN, GEMM_SP2, ((l) < 2), 4>(C.lds, g, S, E); } PHASE_END

    bf16* Zb = (bf16*)(ws + FA_H); bf16* Gb = XNb; float* STf = (float*)(ws + FA_B);
#define GMLP_PHASES(l, idx) \
    if (!fuse) { PHASE_BEGIN(PH(l, 0)) ph_norm(C, X, args.in[I_N1G] + (size_t)(l) * D, mod + (size_t)(l) * 3 * MODW, 0, XNb, (l) == 3, (l) == 0 ? args.in[I_X] : nullptr, (l) == 0 ? args.in[I_CTX] : nullptr); PHASE_END } \
    PHASE_BEGIN(PH(l, 1)) { pg8::Gemm g{XNb, WB + WB_AWIN + (size_t)(idx) * D * 4096, NR, 4096, D}; pg8::StaticOrder S; S.init(BATCH * SEQ, 4096, C.G, (int)blockIdx.x, 1); \
        { LAS float* bl_ = (LAS float*)(C.lds + 131072); const float* bs_ = args.in[I_ABIN] + (size_t)(idx) * 4096; for (int i_ = C.tid; i_ < 4096; i_ += 512) bl_[i_] = bs_[i_]; } __syncthreads();     \
        pg8::EpiGeluStats E{Zb, (LAS const float*)(C.lds + 131072), STf}; pg8::gemm_phase<pg8::EpiGeluStats, pg8::StaticOrder, GEMM_ALIGN, GEMM_SP2, ((l) != 3)>(C.lds, g, S, E); } PHASE_END \
    PHASE_BEGIN(PH(l, 2)) ph_gmlp_spatial(C, Zb, STf, args.in[I_ALNG] + (size_t)(idx) * GW, (const bf16*)WB + WB_AWS + (size_t)(idx) * GG * 128 * 128, args.in[I_ABS] + (size_t)(idx) * GG * CHUNK, Gb, (l) == 3); PHASE_END \
    PHASE_BEGIN(PH(l, 3)) if (fuse) FUSED_RES(Gb, WB + WB_AWOUT + (size_t)(idx) * D * D, GW, mod + (size_t)(l) * 3 * MODW + 2 * D, args.in[I_N2G] + (size_t)(l) * D, mod + (size_t)(l) * 3 * MODW + 3 * D, (l), (l) == 0 ? args.in[I_X] : (const float*)nullptr, ((l) != 3)) \
        else { pg8::Gemm g{Gb, WB + WB_AWOUT + (size_t)(idx) * D * D, NR, D, GW}; pg8::StaticOrder S; S.init(BATCH * SEQ, D, C.G, (int)blockIdx.x, 1); \
        pg8::EpiRes E{X, mod + (size_t)(l) * 3 * MODW + 2 * D, (l) == 0 ? args.in[I_X] : nullptr, (l) == 0 ? args.in[I_CTX] : nullptr, PARTf};  pg8::gemm_phase<pg8::EpiRes, pg8::StaticOrder, GEMM_ALIGN, GEMM_SP2, ((l) != 3), 4>(C.lds, g, S, E); } PHASE_END

    bf16* QKVb = (bf16*)(ws + FA_H); bf16* Of = (bf16*)(ws + FA_B); const float* tab = (const float*)(ws + WS_ROPE);
#define DIFF_PHASES(l, idx) \
    if (!fuse) { PHASE_BEGIN(PH(l, 0)) ph_norm(C, X, args.in[I_N1G] + (size_t)(l) * D, mod + (size_t)(l) * 3 * MODW, 0, XNb, 0, nullptr, nullptr, PARTf, 4, 0); PHASE_END } \
    PHASE_BEGIN(PH(l, 1)) { pg8::Gemm g{XNb, WB + WB_BQKV, NR, NQKV, D}; \
        if (fuse) { ph_norm(C, X, args.in[I_N1G] + (size_t)(l) * D, mod + (size_t)(l) * 3 * MODW, 0, XNb, 0, nullptr, nullptr, PARTf, 4, 2, CTXC + (2 + (l)) * 64); g.ctxcnt = CTXC + (2 + (l)) * 64; g.ctxwant = (unsigned)C.G * 8u; } \
        pg8::StaticOrder S; S.init(BATCH * SEQ, NQKV, C.G, (int)blockIdx.x, 1); \
        { LAS _Float16* tl_ = (LAS _Float16*)(C.lds + 131072); for (int i_ = C.tid; i_ < 8192; i_ += 512) tl_[i_] = (_Float16)tab[i_]; } __syncthreads();     \
        pg8::EpiQkvRope E{QKVb, tab, (LAS const _Float16*)(C.lds + 131072)}; pg8::gemm_phase<pg8::EpiQkvRope, pg8::StaticOrder, GEMM_ALIGN, GEMM_SP2, true>(C.lds, g, S, E); } PHASE_END \
    PHASE_BEGIN(PH(l, 2)) ph_diff_attn3(C, QKVb, (float*)Of, args.in[I_BLQ1], args.in[I_BLK1], args.in[I_BLQ2], args.in[I_BLK2], args.in[I_BSUBG], 0.35550906759097f, XNb); PHASE_END \
    PHASE_BEGIN(PH(l, 4)) if (fuse) FUSED_RES(XNb, WB + WB_BWO, 2048, mod + (size_t)(l) * 3 * MODW + 2 * D, args.in[I_N2G] + (size_t)(l) * D, mod + (size_t)(l) * 3 * MODW + 3 * D, (l), (const float*)nullptr, true) \
        else { pg8::Gemm g{XNb, WB + WB_BWO, NR, D, 2048}; pg8::StaticOrder S; S.init(BATCH * SEQ, D, C.G, (int)blockIdx.x, 1); \
        pg8::EpiRes E{X, mod + (size_t)(l) * 3 * MODW + 2 * D, nullptr, nullptr, PARTf};  pg8::gemm_phase<pg8::EpiRes, pg8::StaticOrder, GEMM_ALIGN, GEMM_SP2, true, 4>(C.lds, g, S, E); } PHASE_END

    GMLP_PHASES(0, 0)
    FFN_PHASES(0)
    DIFF_PHASES(1, 0)
    FFN_PHASES(1)
    float* Cf = (float*)(ws + FA_B); bf16* CQn = (bf16*)(ws + FA_B + 66 * MiB); bf16* CKVn = (bf16*)(ws + FA_B + 83 * MiB); bf16* KRb = (bf16*)(ws + FA_B + 100 * MiB);
    bf16* Qmb = (bf16*)(ws + FA_H); bf16* KVmb = (bf16*)(ws + FA_H + 99 * MiB);
#define MLA_PHASES(l) \
    if (!fuse) { PHASE_BEGIN(PH(l, 0)) ph_norm(C, X, args.in[I_N1G] + (size_t)(l) * D, mod + (size_t)(l) * 3 * MODW, 0, XNb, 0, nullptr, nullptr, PARTf, 4, 0); PHASE_END } \
    PHASE_BEGIN(PH(l, 1)) { pg8::Gemm g{XNb, WB + WB_CDQKV, NR, 1024, D}; \
        if (fuse) { ph_norm(C, X, args.in[I_N1G] + (size_t)(l) * D, mod + (size_t)(l) * 3 * MODW, 0, XNb, 0, nullptr, nullptr, PARTf, 4, 2, CTXC + (2 + (l)) * 64); g.ctxcnt = CTXC + (2 + (l)) * 64; g.ctxwant = (unsigned)C.G * 8u; } \
        pg8::StaticOrder S; S.init(BATCH * SEQ, 1024, C.G, (int)blockIdx.x, 1); \
        if (fuse) { pg8::EpiMlaDown E{PARTf, args.in[I_CQNG], args.in[I_CKVNG], tab, (pg8::bf16_t*)CQn, (pg8::bf16_t*)CKVn, (pg8::bf16_t*)KRb, SLOTf, CNTw + 8 * 66 * 64, TMOw}; \
            pg8::gemm_phase<pg8::EpiMlaDown, pg8::StaticOrder, GEMM_ALIGN, GEMM_SP2, true, 4>(C.lds, g, S, E); } \
        else { pg8::EpiF32Store E{Cf, 1024, PARTf}; pg8::gemm_phase<pg8::EpiF32Store, pg8::StaticOrder, GEMM_ALIGN, GEMM_SP2, true, 4>(C.lds, g, S, E); } } PHASE_END \
    if (!fuse) { PHASE_BEGIN(PH(l, 2)) ph_mla_mid(C, Cf, PARTf, args.in[I_CQNG], args.in[I_CKVNG], tab, CQn, CKVn, KRb, 0); PHASE_END } \
    PHASE_BEGIN(PH(l, 3)) { if (fuse) ph_mla_mid(C, Cf, PARTf, args.in[I_CQNG], args.in[I_CKVNG], tab, CQn, CKVn, KRb, 1, CTXC + 5 * 64);     \
        { pg8::Gemm g{CQn, WB + WB_CUQ, NR, 3072, 512}; pg8::StaticOrder S; S.init(BATCH * SEQ, 3072, C.G, (int)blockIdx.x, 1); \
        { LAS float* tl_ = (LAS float*)(C.lds + 131072); for (int i_ = C.tid; i_ < 4096; i_ += 512) tl_[i_] = tab[8192 + i_]; } __syncthreads();     \
        pg8::EpiMlaQ E{Qmb, (LAS const float*)(C.lds + 131072)}; pg8::gemm_phase<pg8::EpiMlaQ, pg8::StaticOrder, GEMM_ALIGN, GEMM_SP2>(C.lds, g, S, E); } \
        { pg8::Gemm g{CKVn, WB + WB_CUKV, NR, 4096, 512}; if (fuse) { g.ctxcnt = CTXC + 5 * 64; g.ctxwant = (unsigned)C.G * 8u; } pg8::StaticOrder S; S.init(BATCH * SEQ, 4096, C.G, (int)blockIdx.x, 1); \
        pg8::EpiAct<0> E{KVmb, 4096}; pg8::gemm_phase<pg8::EpiAct<0>, pg8::StaticOrder, GEMM_ALIGN, GEMM_SP2, true>(C.lds, g, S, E); } } PHASE_END \
    PHASE_BEGIN(PH(l, 4)) ph_mla_attn(C, Qmb, KVmb, KRb, XNb); PHASE_END \
    PHASE_BEGIN(PH(l, 5)) if (fuse) FUSED_RES(XNb, WB + WB_CWO, 2048, mod + (size_t)(l) * 3 * MODW + 2 * D, args.in[I_N2G] + (size_t)(l) * D, mod + (size_t)(l) * 3 * MODW + 3 * D, (l), (const float*)nullptr, false) \
        else { pg8::Gemm g{XNb, WB + WB_CWO, NR, D, 2048}; pg8::StaticOrder S; S.init(BATCH * SEQ, D, C.G, (int)blockIdx.x, 1); \
        pg8::EpiRes E{X, mod + (size_t)(l) * 3 * MODW + 2 * D, nullptr, nullptr, nullptr};  pg8::gemm_phase<pg8::EpiRes, pg8::StaticOrder, GEMM_ALIGN, GEMM_SP2>(C.lds, g, S, E); } PHASE_END
    MLA_PHASES(2)
    FFN_PHASES(2)
    GMLP_PHASES(3, 1)
    FFN_PHASES(3)

    if (!fuse) { PHASE_BEGIN(PH_FINAL) ph_final(C, X, args.in[I_FING], args.out); PHASE_END }
#undef PHASE_BEGIN
#undef PHASE_END
}

extern "C" void kernel_launch(void* const* d_in, const int* in_sizes, int n_in, void* d_out, int out_size, void* d_ws, size_t ws_size, hipStream_t stream) {
    if (n_in != N_IN || in_sizes[I_X] != BATCH * SEQ * D || out_size != BATCH * SEQ * D || ws_size < WS_NEED) {
        fprintf(stderr, "kernel_launch: unexpected shapes (n_in %d, x %d, out %d, ws %zu; need ws %zu); nothing launched\n", n_in, n_in > 0 ? in_sizes[0] : -1, out_size, ws_size, (size_t)WS_NEED);
        return;
    }
    static int grid = 0;
    if (grid == 0) {
        int dev = 0, cus = 0, per_cu = 0;
        if (hipGetDevice(&dev) != hipSuccess || hipDeviceGetAttribute(&cus, hipDeviceAttributeMultiprocessorCount, dev) != hipSuccess) { grid = -1; return; }
        if (hipFuncSetAttribute((const void*)mega, hipFuncAttributeMaxDynamicSharedMemorySize, LDS_BYTES) != hipSuccess) { fprintf(stderr, "kernel_launch: cannot get %d B of LDS\n", LDS_BYTES); grid = -1; return; }
        if (hipOccupancyMaxActiveBlocksPerMultiprocessor(&per_cu, (const void*)mega, 512, LDS_BYTES) != hipSuccess || per_cu < 1) fprintf(stderr, "kernel_launch: occupancy query says %d blocks per CU\n", per_cu);
        (void)hipGetLastError();
        grid = cus;
    }
    if (grid < 0) return;
    unsigned char* ws = (unsigned char*)d_ws;
    (void)hipMemsetAsync(ws + WS_CTL, 0, 1 * MiB, stream);
    Args a{}; for (int i = 0; i < N_IN; ++i) a.in[i] = (const float*)d_in[i]; a.out = (float*)d_out; a.ws = ws;
    a.ph_lo = 0; a.ph_hi = PH_END; a.li = 0; a.pad = 0;
    hipLaunchKernelGGL(mega, dim3(grid), dim3(512), LDS_BYTES, stream, a);
    const hipError_t le = hipPeekAtLastError();
    if (le != hipSuccess) fprintf(stderr, "kernel_launch: launch failed: %s\n", hipGetErrorName(le));
}
```

```cpp
#include <hip/hip_runtime.h>
#include <cstdio>
#include <cstdint>
#include <cmath>

constexpr int D = 2048, BATCH = 2, SEQ = 8192, DEPTH = 4, GRID_W = 64, CTXL = 256;
constexpr int DFF = 8192, NMOD = 6;
constexpr int TB = SEQ + CTXL;
constexpr int NR = BATCH * TB;
constexpr float EPS = 1e-6f;
constexpr int GW = 2048, GG = 16, GC = 128, CHUNK = 128;
constexpr int DH = 8, DHD = 128, DVD = 256, NQKV = 6144;
constexpr int MH = 16, MQR = 448, MKVR = 512, MNOPE = 128, MROPE = 64, MV = 128, MQK = 192;
constexpr int MODW = NMOD * D;

enum { I_X = 0, I_C, I_CTX, I_CCTX, I_WMOD, I_BMOD, I_N1G, I_N2G, I_WFF1, I_WFF2, I_AWIN, I_ABIN, I_ALNG, I_AWS, I_ABS, I_AWOUT,
       I_BWQKV, I_BLQ1, I_BLK1, I_BLQ2, I_BLK2, I_BSUBG, I_BWO, I_CWDQKV, I_CQNG, I_CWUQ, I_CKVNG, I_CWUKV, I_CWO, I_FING, N_IN };

constexpr size_t MiB = 1u << 20;
constexpr size_t WS_CTL = 0;
constexpr size_t WS_MOD = 1 * MiB;
constexpr size_t WS_ROPE = 2 * MiB;
constexpr size_t WS_X = 4 * MiB;
constexpr size_t WS_WB = 136 * MiB;
constexpr size_t WB_FF1 = 0, WB_FF2 = WB_FF1 + (size_t)4 * D * DFF, WB_AWIN = WB_FF2 + (size_t)4 * D * DFF, WB_AWOUT = WB_AWIN + (size_t)2 * D * 4096,
                 WB_BQKV = WB_AWOUT + (size_t)2 * D * D, WB_BWO = WB_BQKV + (size_t)D * NQKV, WB_CDQKV = WB_BWO + (size_t)D * D, WB_CUQ = WB_CDQKV + (size_t)D * 1024,
                 WB_CUKV = WB_CUQ + (size_t)512 * 3072, WB_CWO = WB_CUKV + (size_t)512 * 4096, WB_AWS = WB_CWO + (size_t)D * D, WB_END = WB_AWS + (size_t)2 * GG * 128 * 128;
static_assert(WB_END * 2 <= 360 * MiB, "weights region");
constexpr size_t WS_S0 = 496 * MiB;
constexpr size_t SL_XN = WS_S0;
constexpr size_t SL_BIG = SL_XN + 132 * MiB;
constexpr size_t SL_B2 = SL_BIG + 528 * MiB;
constexpr size_t SL_ST = SL_B2 + 264 * MiB;
constexpr size_t FA_XN = WS_S0;
constexpr size_t FA_H = FA_XN + 66 * MiB;
constexpr size_t FA_B = FA_H + 264 * MiB;
constexpr size_t FA_END = FA_B + 152 * MiB;
constexpr size_t WS_NEED = FA_END;
static_assert(WS_NEED <= 1536 * MiB && SL_ST + 1 * MiB <= 1536 * MiB, "workspace");

__device__ __forceinline__ int row_group(int r) { return (r % TB) >= SEQ ? 2 : r / TB; }
namespace pg8 {
#define PG8_LAS __attribute__((address_space(3)))
typedef unsigned short bf16_t;
typedef short bf16x8 __attribute__((ext_vector_type(8)));
typedef float f32x4 __attribute__((ext_vector_type(4)));
typedef unsigned u32x4 __attribute__((ext_vector_type(4)));
constexpr int BM = 256, BK = 64, HALF = 128, HTB = HALF * BK * 2  , STAGE_BYTES = 8 * HTB, NXCD = 8, WGM = 8;

__host__ __device__ __forceinline__ int lds_byte(int r, int c) { const int st = (r >> 4) * 2 + (c >> 5), rr = r & 15, cc = c & 31, ob = rr * 64 + cc * 2; return st * 1024 + (ob ^ (((ob >> 9) & 1) << 5)); }
__host__ __device__ __forceinline__ void stage_rc(int b, int& R, int& C) { const int st = b / 1024, sb = b % 1024, swz = sb ^ (((sb >> 9) & 1) << 5); R = (st >> 1) * 16 + swz / 64; C = (st & 1) * 32 + (swz % 64) / 2; }
__host__ __device__ __forceinline__ int perm32(int rho) { const int n = rho >> 4, i = rho & 15; return 8 * (i >> 2) + 4 * n + (i & 3); }

struct Unit { int pm, pn; };
struct Gemm { const bf16_t* A; const bf16_t* Bt; int M, N, K; unsigned* ctxcnt = nullptr; unsigned ctxwant = 0; };

struct StaticOrder {
    int nM, nN, nwg, G, c, lat;
    __host__ __device__ void init(int M, int N, int G_, int c_, int lat_ = 0) { nM = M / BM; nN = N / BM; nwg = nM * nN; G = G_; c = c_; lat = lat_; }
    __host__ __device__ bool next(int i, Unit& u) const {
        const long L = (long)i * G + c; if (L >= nwg) return false;
        int wgid = (int)L; { const int q = nwg / NXCD, r = nwg % NXCD, xcd = wgid % NXCD, off = wgid / NXCD; wgid = (xcd < r ? xcd * (q + 1) : r * (q + 1) + (xcd - r) * q) + off; }
        const int nig = WGM * nN, gid = wgid / nig, fm = gid * WGM, gsz = (nM - fm) < WGM ? (nM - fm) : WGM;
        u.pm = fm + ((wgid % nig) % gsz); u.pn = (wgid % nig) / gsz; if (lat) u.pm += (u.pm >= 32) ? 1 : 0; return true;
    }
    __device__ __forceinline__ void a_ready(const Unit&) const {}
    __device__ __forceinline__ void done(const Unit&) const {}
};

__device__ __forceinline__ unsigned cvt_pk_bf16(float lo, float hi) { unsigned r; asm volatile("v_cvt_pk_bf16_f32 %0, %1, %2" : "=v"(r) : "v"(lo), "v"(hi)); return r; }
typedef float f32x2 __attribute__((ext_vector_type(2)));
__device__ __forceinline__ f32x2 gelu_pk(f32x2 v) {
    const f32x2 av = __builtin_elementwise_abs(v), d = av * 0.2316418882f + 1.0f;
    f32x2 t; t.x = __builtin_amdgcn_rcpf(d.x); t.y = __builtin_amdgcn_rcpf(d.y);
    f32x2 q = t * 0.5307027145f + (-0.7265760135f); q = q * t + 0.7107068705f; q = q * t + (-0.142248368f); q = q * t + 0.127414796f; q = q * t;
    const f32x2 s = (v * v) * (-0.72134752044f);
    f32x2 e; e.x = __builtin_amdgcn_exp2f(s.x); e.y = __builtin_amdgcn_exp2f(s.y);
    const f32x2 m = v * (q * e), r = v - m;
    f32x2 o; o.x = v.x < 0.f ? m.x : r.x; o.y = v.y < 0.f ? m.y : r.y; return o;
}

template <class Epi, class Sched, bool ALIGN_EPI = false, bool SP2 = false, bool CTXMINI = false, int KSPLIT = 1>
__device__ __forceinline__ void gemm_phase(PG8_LAS unsigned char* lds, const Gemm g, const Sched& S, const Epi& E) {
    const int tid = threadIdx.x, wid = __builtin_amdgcn_readfirstlane(tid >> 6), lane = tid & 63, wr = wid >> 2, wc = wid & 3, fr = lane & 15, fq = lane >> 4;
    const int K = g.K, nt = K / BK;
    unsigned voffA[2], voffB[2];
#pragma unroll
    for (int i = 0; i < 2; ++i) { int R, C; stage_rc(tid * 16 + i * 8192, R, C); const int Rb = Epi::PERM ? ((R & ~31) + perm32(R & 31)) : R;
        voffA[i] = (unsigned)(R * K + C) * 2u; voffB[i] = (unsigned)(Rb * K + C) * 2u; }
    const size_t kstep = (size_t)(BK * 2);
    const size_t hstep = (size_t)HALF * K * 2;
    const size_t tstep = 2 * hstep;
    const unsigned ldsw = (unsigned)wid * 1024u;
    const int aoff = lds_byte(wr * 64 + fr, fq * 8), boff = lds_byte(wc * 32 + fr, fq * 8);
#define PG8_SA(b, h) (((b) * 2 + (h)) * HTB)
#define PG8_SB(b, h) ((4 + (b) * 2 + (h)) * HTB)
#define PG8_STAGE(bufoff, gbase, voff) do { _Pragma("unroll") for (int _i = 0; _i < 2; ++_i) \
        __builtin_amdgcn_global_load_lds((const unsigned*)((const char*)(gbase) + (voff)[_i]), (PG8_LAS unsigned*)(lds + (bufoff) + ldsw + _i * 8192), 16, 0, 0); } while (0)
#define PG8_LDA(dst, b, h) do { _Pragma("unroll") for (int m = 0; m < 4; ++m) _Pragma("unroll") for (int k = 0; k < 2; ++k) dst[m][k] = *(const PG8_LAS bf16x8*)(lds + PG8_SA(b, h) + aoff + m * 2048 + k * 1024); } while (0)
#define PG8_LDB(dst, b, h) do { _Pragma("unroll") for (int n = 0; n < 2; ++n) _Pragma("unroll") for (int k = 0; k < 2; ++k) dst[n][k] = *(const PG8_LAS bf16x8*)(lds + PG8_SB(b, h) + boff + n * 2048 + k * 1024); } while (0)
#define PG8_MMA(ai, bj, At, Bt) do { __builtin_amdgcn_s_setprio(1); _Pragma("unroll") for (int m = 0; m < 4; ++m) _Pragma("unroll") for (int n = 0; n < 2; ++n) _Pragma("unroll") for (int k = 0; k < 2; ++k) \
        acc[ai][bj][m][n] = __builtin_amdgcn_mfma_f32_16x16x32_bf16(Bt[n][k], At[m][k], acc[ai][bj][m][n], 0, 0, 0); __builtin_amdgcn_s_setprio(0); } while (0)
#define PG8_WAIT_V(n) asm volatile("s_waitcnt vmcnt(" #n ")" ::: "memory")
#define PG8_WAIT_L(n) asm volatile("s_waitcnt lgkmcnt(" #n ")" ::: "memory")
#define PG8_BAR __builtin_amdgcn_s_barrier()
#define PG8_SCHED __builtin_amdgcn_sched_barrier(0)
    Unit cur, nxt; int ui = 0;
    if (!S.next(0, cur)) return;
    f32x4 acc[2][2][4][2];
#pragma unroll
    for (int a = 0; a < 2; ++a)
#pragma unroll
        for (int b = 0; b < 2; ++b)
#pragma unroll
            for (int m = 0; m < 4; ++m)
#pragma unroll
                for (int n = 0; n < 2; ++n) acc[a][b][m][n] = (f32x4){0.f, 0.f, 0.f, 0.f};
    bf16x8 At[4][2], B0[2][2], B1[2][2];
    const char* cA = (const char*)g.A + (size_t)cur.pm * tstep; const char* cB = (const char*)g.Bt + (size_t)cur.pn * tstep;
    S.a_ready(cur);
    if constexpr (SP2) {
        PG8_STAGE(PG8_SB(0, 0), cB, voffB); PG8_STAGE(PG8_SB(0, 1), cB + hstep, voffB); PG8_STAGE(PG8_SA(0, 0), cA, voffA); PG8_STAGE(PG8_SA(0, 1), cA + hstep, voffA);
        if (wr == 1) PG8_BAR;
        PG8_WAIT_V(2); PG8_BAR;
        PG8_STAGE(PG8_SB(1, 0), cB + kstep, voffB); PG8_STAGE(PG8_SA(1, 0), cA + kstep, voffA); PG8_STAGE(PG8_SB(1, 1), cB + hstep + kstep, voffB);
        PG8_WAIT_V(6); PG8_BAR;
    } else {
        PG8_STAGE(PG8_SB(0, 0), cB, voffB); PG8_STAGE(PG8_SA(0, 0), cA, voffA); PG8_STAGE(PG8_SB(0, 1), cB + hstep, voffB); PG8_STAGE(PG8_SA(0, 1), cA + hstep, voffA);
        if (wr == 1) PG8_BAR;
        PG8_WAIT_V(4); PG8_BAR;
        PG8_STAGE(PG8_SB(1, 0), cB + kstep, voffB); PG8_STAGE(PG8_SA(1, 0), cA + kstep, voffA); PG8_STAGE(PG8_SB(1, 1), cB + hstep + kstep, voffB);
        PG8_WAIT_V(6); PG8_BAR;
    }
    for (;;) {
        const bool has_next = S.next(ui + 1, nxt);
        const char* nA = has_next ? (const char*)g.A + (size_t)nxt.pm * tstep : cA; const char* nB = has_next ? (const char*)g.Bt + (size_t)nxt.pn * tstep : cB;
        for (int t = 0; t < nt; t += 2) {
            const bool last = (t == nt - 2);
            const char* a1 = cA + (size_t)(t + 1) * kstep;
            const char* a2 = last ? nA : cA + (size_t)(t + 2) * kstep; const char* b2 = last ? nB : cB + (size_t)(t + 2) * kstep;
            const char* a3 = a2 + kstep; const char* b3 = b2 + kstep;
            if (last && has_next) S.a_ready(nxt);
            if constexpr (SP2) {
            PG8_LDB(B0, 0, 0); PG8_LDB(B1, 0, 1); PG8_SCHED; PG8_LDA(At, 0, 0); PG8_STAGE(PG8_SA(1, 1), a1 + hstep, voffA);
            PG8_WAIT_V(8); PG8_WAIT_L(0); PG8_BAR; PG8_MMA(0, 0, At, B0); PG8_MMA(0, 1, At, B1); PG8_BAR; PG8_SCHED;
            PG8_LDA(At, 0, 1); PG8_STAGE(PG8_SB(0, 0), b2, voffB); PG8_STAGE(PG8_SB(0, 1), b2 + hstep, voffB); PG8_STAGE(PG8_SA(0, 0), a2, voffA);
            PG8_WAIT_V(8); PG8_WAIT_L(0); PG8_BAR; PG8_MMA(1, 0, At, B0); PG8_MMA(1, 1, At, B1); PG8_BAR; PG8_SCHED;
            PG8_LDB(B0, 1, 0); PG8_LDB(B1, 1, 1); PG8_SCHED; PG8_LDA(At, 1, 0); PG8_STAGE(PG8_SA(0, 1), a2 + hstep, voffA);
            PG8_WAIT_V(8); PG8_WAIT_L(0); PG8_BAR; PG8_MMA(0, 0, At, B0); PG8_MMA(0, 1, At, B1); PG8_BAR; PG8_SCHED;
            PG8_LDA(At, 1, 1); PG8_STAGE(PG8_SB(1, 0), b3, voffB); PG8_STAGE(PG8_SB(1, 1), b3 + hstep, voffB); PG8_STAGE(PG8_SA(1, 0), a3, voffA);
            PG8_WAIT_V(8); PG8_WAIT_L(0); PG8_BAR; PG8_MMA(1, 0, At, B0); PG8_MMA(1, 1, At, B1); PG8_BAR; PG8_SCHED;
            } else {
            PG8_LDB(B0, 0, 0); PG8_SCHED; PG8_LDA(At, 0, 0); PG8_STAGE(PG8_SA(1, 1), a1 + hstep, voffA);
            PG8_WAIT_L(8); PG8_BAR; PG8_WAIT_L(0); PG8_MMA(0, 0, At, B0); PG8_BAR; PG8_SCHED;
            PG8_LDB(B1, 0, 1); PG8_STAGE(PG8_SB(0, 0), b2, voffB);
            PG8_BAR; PG8_WAIT_L(0); PG8_MMA(0, 1, At, B1); PG8_BAR;
            PG8_LDA(At, 0, 1); PG8_STAGE(PG8_SA(0, 0), a2, voffA);
            PG8_BAR; PG8_WAIT_L(0); PG8_MMA(1, 0, At, B0); PG8_BAR; PG8_SCHED;
            PG8_STAGE(PG8_SB(0, 1), b2 + hstep, voffB);
            PG8_WAIT_V(6); PG8_BAR; PG8_MMA(1, 1, At, B1); PG8_BAR;
            PG8_LDB(B0, 1, 0); PG8_SCHED; PG8_LDA(At, 1, 0); PG8_STAGE(PG8_SA(0, 1), a2 + hstep, voffA);
            PG8_WAIT_L(8); PG8_BAR; PG8_WAIT_L(0); PG8_MMA(0, 0, At, B0); PG8_BAR; PG8_SCHED;
            PG8_LDB(B1, 1, 1); PG8_STAGE(PG8_SB(1, 0), b3, voffB);
            PG8_BAR; PG8_WAIT_L(0); PG8_MMA(0, 1, At, B1); PG8_BAR;
            PG8_LDA(At, 1, 1); PG8_STAGE(PG8_SA(1, 0), a3, voffA);
            PG8_BAR; PG8_WAIT_L(0); PG8_MMA(1, 0, At, B0); PG8_BAR; PG8_SCHED;
            PG8_STAGE(PG8_SB(1, 1), b3 + hstep, voffB);
            PG8_WAIT_V(6); PG8_BAR; PG8_MMA(1, 1, At, B1); PG8_BAR;
            }
        }
        if constexpr (ALIGN_EPI) { if (wr == 0) PG8_BAR; }
        if constexpr (!Epi::AFTER_DRAIN) { E(acc, cur, wr, wc, fr, fq); S.done(cur); }
        if (!has_next) break;
#pragma unroll
        for (int a = 0; a < 2; ++a)
#pragma unroll
            for (int b = 0; b < 2; ++b)
#pragma unroll
                for (int m = 0; m < 4; ++m)
#pragma unroll
                    for (int n = 0; n < 2; ++n) acc[a][b][m][n] = (f32x4){0.f, 0.f, 0.f, 0.f};
        cur = nxt; cA = nA; cB = nB; ++ui;
        if constexpr (ALIGN_EPI) { if (wr == 1) PG8_BAR; }
    }
    PG8_WAIT_V(0);
    if constexpr (!ALIGN_EPI) { if (wr == 0) PG8_BAR; }
    PG8_BAR;
    if constexpr (Epi::AFTER_DRAIN) { E.fused(acc, cur, wr, wc, fr, fq, lds, wid, lane); S.done(cur); }
    if constexpr (CTXMINI) {
        if (g.ctxcnt) {
            if (wid == 0) { unsigned sp = 0;
                for (;;) { if ((unsigned)__builtin_amdgcn_readfirstlane(__hip_atomic_load(g.ctxcnt, __ATOMIC_RELAXED, __HIP_MEMORY_SCOPE_AGENT)) >= g.ctxwant) break;
                    __builtin_amdgcn_s_sleep(2); if (++sp > (1u << 20)) break; }
                __builtin_amdgcn_fence(__ATOMIC_ACQUIRE, "agent"); asm volatile("s_waitcnt vmcnt(0)" ::: "memory"); }
            PG8_BAR; }
#define PG8_MMAQ(Q_, At, Bt) do { __builtin_amdgcn_s_setprio(1); _Pragma("unroll") for (int m = 0; m < 4; ++m) _Pragma("unroll") for (int n = 0; n < 2; ++n) _Pragma("unroll") for (int k = 0; k < 2; ++k) \
        Q_[m][n] = __builtin_amdgcn_mfma_f32_16x16x32_bf16(Bt[n][k], At[m][k], Q_[m][n], 0, 0, 0); __builtin_amdgcn_s_setprio(0); } while (0)
        const int nNm = g.N / BM, nmini = 8 * nNm * KSPLIT, ntm = nt / KSPLIT;
        for (int mi = S.c; mi < nmini; mi += S.G) {
            const int sp = mi % KSPLIT, mq = mi / KSPLIT, bj = mq & 1, pn = (mq >> 1) % nNm, r2 = (mq >> 1) / nNm, ai = r2 & 1, pc = r2 >> 1;
            Unit u; u.pm = 32 + 33 * pc; u.pn = pn;
            const char* mA = (const char*)g.A + (size_t)u.pm * tstep + (size_t)ai * hstep + (size_t)sp * ntm * kstep;
            const char* mB = (const char*)g.Bt + (size_t)pn * tstep + (size_t)bj * hstep + (size_t)sp * ntm * kstep;
            f32x4 aq[4][2];
#pragma unroll
            for (int m = 0; m < 4; ++m)
#pragma unroll
                for (int n = 0; n < 2; ++n) aq[m][n] = (f32x4){0.f, 0.f, 0.f, 0.f};
#define PG8_MINI_STEP(s_, tt_) do { const int t_ = (tt_); \
                if (t_ + 2 < ntm) { PG8_WAIT_V(8); } else if (t_ + 1 < ntm) { PG8_WAIT_V(4); } else { PG8_WAIT_V(0); } \
                PG8_BAR; \
                if (t_ + 3 < ntm) { PG8_STAGE(PG8_SA((((s_) + 3) & 3) >> 1, ((s_) + 3) & 1), mA + (size_t)(t_ + 3) * kstep, voffA); PG8_STAGE(PG8_SB((((s_) + 3) & 3) >> 1, ((s_) + 3) & 1), mB + (size_t)(t_ + 3) * kstep, voffB); } \
                PG8_LDB(B0, (s_) >> 1, (s_) & 1); PG8_LDA(At, (s_) >> 1, (s_) & 1); PG8_WAIT_L(0); PG8_SCHED; \
                PG8_MMAQ(aq, At, B0); PG8_SCHED; } while (0)
            PG8_STAGE(PG8_SA(0, 0), mA, voffA); PG8_STAGE(PG8_SB(0, 0), mB, voffB);
            PG8_STAGE(PG8_SA(0, 1), mA + kstep, voffA); PG8_STAGE(PG8_SB(0, 1), mB + kstep, voffB);
            PG8_STAGE(PG8_SA(1, 0), mA + 2 * kstep, voffA); PG8_STAGE(PG8_SB(1, 0), mB + 2 * kstep, voffB);
            for (int t = 0; t < ntm; t += 4) { PG8_MINI_STEP(0, t); PG8_MINI_STEP(1, t + 1); PG8_MINI_STEP(2, t + 2); PG8_MINI_STEP(3, t + 3); }
#undef PG8_MINI_STEP
            if constexpr (KSPLIT > 1) E.quad_part(aq, u, ai, bj, sp, pc, wr, wc, fr, fq); else E.quad(aq, u, ai, bj, wr, wc, fr, fq);
            PG8_WAIT_V(0);
        }
#undef PG8_MMAQ
    }
#undef PG8_SA
#undef PG8_SB
#undef PG8_STAGE
#undef PG8_LDA
#undef PG8_LDB
#undef PG8_MMA
#undef PG8_WAIT_V
#undef PG8_WAIT_L
#undef PG8_BAR
#undef PG8_SCHED
}
}
#define GAS __attribute__((address_space(1)))
#define LAS __attribute__((address_space(3)))
typedef unsigned short bf16;
typedef unsigned v4u __attribute__((ext_vector_type(4)));
typedef float f32x4 __attribute__((ext_vector_type(4)));
typedef short bf16x8 __attribute__((ext_vector_type(8)));
typedef GAS unsigned gu32;
typedef GAS unsigned long long gu64;
#define RLX_AGENT __ATOMIC_RELAXED, __HIP_MEMORY_SCOPE_AGENT
#define LDS_WAIT() asm volatile("s_waitcnt lgkmcnt(0)" ::: "memory")
#define VM_WAIT() asm volatile("s_waitcnt vmcnt(0)" ::: "memory")
__device__ __forceinline__ unsigned long long rt() { return __builtin_amdgcn_s_memrealtime(); }
__device__ __forceinline__ unsigned f2bf(float f) { unsigned u = __builtin_bit_cast(unsigned, f); return (u + 0x7fffu + ((u >> 16) & 1u)) >> 16; }
__device__ __forceinline__ unsigned pk2(float lo, float hi) { return f2bf(lo) | (f2bf(hi) << 16); }

#define XB_TMO      128
#define XB_XCNT(j)  (256  + 64 * (j))
#define XB_XSUB(j)  (1280 + 64 * (j))
#define XB_XGEN(j)  (2304 + 64 * (j))
#define XB_TOP      3328
#define XB_TOPGEN   3392
#define XCD_BAR_WORDS 3456
#define XB_SPIN_CAP (1u << 18)

__device__ __forceinline__ unsigned xb_ld(unsigned* p)              { return __hip_atomic_load(p, __ATOMIC_RELAXED, __HIP_MEMORY_SCOPE_AGENT); }
__device__ __forceinline__ unsigned xb_add(unsigned* p, unsigned v) { return __hip_atomic_fetch_add(p, v, __ATOMIC_RELAXED, __HIP_MEMORY_SCOPE_AGENT); }
__device__ __forceinline__ unsigned xb_xcc_id() { return (unsigned)__builtin_amdgcn_s_getreg((3 << 11) | 20) & 0xFu; }
#define XB_SPIN(cond, bar) do { unsigned _sp = 0; while (cond) { __builtin_amdgcn_s_sleep(1); \
    if ((++_sp & 255u) == 0u) { if (xb_ld(&(bar)[XB_TMO])) break; if (_sp > XB_SPIN_CAP) { atomicAdd(&(bar)[XB_TMO], 1u); break; } } } } while (0)

struct XcdBarrier {
    unsigned* bar; unsigned x;
    volatile LAS unsigned* st;
};

__device__ __forceinline__ XcdBarrier xcd_barrier_post(unsigned* bar, volatile LAS unsigned* st) {
    XcdBarrier b; b.bar = bar; b.x = xb_xcc_id(); b.st = st;
    if (threadIdx.x == 0) (void)xb_add(&bar[XB_XCNT(b.x)], 1u);
    return b;
}
__device__ __forceinline__ void xcd_barrier_complete(unsigned* bar, unsigned x, unsigned& nloc, unsigned& nx) {
    const unsigned G = gridDim.x * gridDim.y * gridDim.z;
    unsigned sum, cnt, mine, sp = 0u;
    for (;;) {
        sum = 0u; cnt = 0u; mine = 0u;
#pragma unroll
        for (unsigned j = 0; j < 16; ++j) { const unsigned c = xb_ld(&bar[XB_XCNT(j)]); sum += c; cnt += (c > 0u) ? 1u : 0u; mine = (j == x) ? c : mine; }
        if (sum == G) break;
        __builtin_amdgcn_s_sleep(1);
        if ((++sp & 255u) == 0u) { if (xb_ld(&bar[XB_TMO])) break; if (sp > XB_SPIN_CAP) { atomicAdd(&bar[XB_TMO], 1u); break; } }
    }
    nloc = mine > 0u ? mine : 1u; nx = cnt > 0u ? cnt : 1u;
}

__device__ __forceinline__ void xcd_barrier(const XcdBarrier& b) {
    asm volatile("s_waitcnt vmcnt(0)" ::: "memory");
    __syncthreads();
    if (threadIdx.x == 0) {
        unsigned* bar = b.bar;
        __builtin_amdgcn_s_waitcnt(0);
        unsigned nloc = b.st[0], nx = b.st[1];
        if (nloc == 0u) { xcd_barrier_complete(bar, b.x, nloc, nx); b.st[0] = nloc; b.st[1] = nx; }
        const unsigned old = xb_add(&bar[XB_XSUB(b.x)], 1u);
        const unsigned gen = old / nloc;
        if (old + 1u == (gen + 1u) * nloc) {
            __builtin_amdgcn_fence(__ATOMIC_RELEASE, "agent");
            asm volatile("s_waitcnt vmcnt(0)" ::: "memory");
            const unsigned og = xb_add(&bar[XB_TOP], 1u);
            const unsigned tg = og / nx;
            if (og + 1u == (tg + 1u) * nx) xb_add(&bar[XB_TOPGEN], 1u);
            else XB_SPIN(xb_ld(&bar[XB_TOPGEN]) == tg, bar);
            __builtin_amdgcn_fence(__ATOMIC_ACQUIRE, "agent");
            xb_add(&bar[XB_XGEN(b.x)], 1u);
            asm volatile("s_waitcnt vmcnt(0)" ::: "memory");
        } else {
            XB_SPIN(xb_ld(&bar[XB_XGEN(b.x)]) == gen, bar);
            __builtin_amdgcn_fence(__ATOMIC_ACQUIRE, "agent");
            asm volatile("s_waitcnt vmcnt(0)" ::: "memory");
        }
    }
    __syncthreads();
}


constexpr int CW_BAR = 4096;
constexpr int MAX_LAUNCH = 24;
static_assert((CW_BAR + MAX_LAUNCH * XCD_BAR_WORDS) * 4 <= (int)(1 * MiB), "barrier regions inside the zeroed control MiB");
constexpr int RING_BYTES = 155648, LDSCTL_OFF = RING_BYTES, MISC_OFF = LDSCTL_OFF + 320, LDS_BYTES = 159744;

struct Args { const float* in[N_IN]; float* out; unsigned char* ws; int ph_lo, ph_hi, li, pad; };
struct Ctx { LAS unsigned char* lds; int tid, lane, wave, vcu, G; };

__device__ __forceinline__ int panel_group(int pm) { return (pm % 33) == 32 ? 2 : pm / 33; }

namespace pg8 {
template <int ACT> struct EpiAct {
    static constexpr bool PERM = true, AFTER_DRAIN = false;
    bf16_t* O; int ldc;
    __device__ __forceinline__ void quad(const f32x4 (&a)[4][2], const Unit& u, int ai, int bj, int wr, int wc, int fr, int fq) const {
        const int row0 = u.pm * BM + ai * HALF + wr * 64 + fr, col0 = u.pn * BM + bj * HALF + wc * 32 + 8 * fq;
#pragma unroll
        for (int m = 0; m < 4; ++m) { f32x4 v0 = a[m][0], v1 = a[m][1];
            if (ACT == 2) {
#pragma unroll
                for (int j = 0; j < 4; ++j) { const float x = fmaxf(v0[j], 0.f), y = fmaxf(v1[j], 0.f); v0[j] = x * x; v1[j] = y * y; } }
            u32x4 w; w.x = cvt_pk_bf16(v0[0], v0[1]); w.y = cvt_pk_bf16(v0[2], v0[3]); w.z = cvt_pk_bf16(v1[0], v1[1]); w.w = cvt_pk_bf16(v1[2], v1[3]);
            *(u32x4*)(O + (size_t)(row0 + m * 16) * ldc + col0) = w; }
    }
    __device__ __forceinline__ void operator()(const f32x4 (&acc)[2][2][4][2], const Unit& u, int wr, int wc, int fr, int fq) const {
#pragma unroll
        for (int ai = 0; ai < 2; ++ai)
#pragma unroll
            for (int bj = 0; bj < 2; ++bj) quad(acc[ai][bj], u, ai, bj, wr, wc, fr, fq);
    }
};
struct EpiRes {
    static constexpr bool PERM = false, AFTER_DRAIN = false;
    float* X; const float* gate; const float* xin; const float* cin; float* part;
    __device__ __forceinline__ const float* src_row0(const Unit& u) const {
        if (!xin) return X + (size_t)u.pm * BM * D;
        const int b = u.pm / 33, p = u.pm % 33;
        return p < 32 ? xin + ((size_t)b * SEQ + (size_t)p * BM) * D : cin + (size_t)b * CTXL * D;
    }
    __device__ __forceinline__ void quad(const f32x4 (&a)[4][2], const Unit& u, int ai, int bj, int wr, int wc, int fr, int fq) const {
        const int row0 = u.pm * BM + ai * HALF + wr * 64 + fr, col0 = u.pn * BM + bj * HALF + wc * 32 + 4 * fq;
        const float* gp = gate + (size_t)panel_group(u.pm) * MODW + col0;
        const f32x4 g0 = *(const f32x4*)(gp), g1 = *(const f32x4*)(gp + 16);
        const float* sp = src_row0(u) + (size_t)(ai * HALF + wr * 64 + fr) * D + col0;
#pragma unroll
        for (int m = 0; m < 4; ++m) { float* rowp = X + (size_t)(row0 + m * 16) * D + col0; const float* sr = sp + (size_t)(m * 16) * D;
            const f32x4 x0 = *(const f32x4*)sr, x1 = *(const f32x4*)(sr + 16); *(f32x4*)rowp = x0 + g0 * a[m][0]; *(f32x4*)(rowp + 16) = x1 + g1 * a[m][1]; }
    }
    __device__ __forceinline__ void quad_part(const f32x4 (&a)[4][2], const Unit& u, int ai, int bj, int sp, int pc, int wr, int wc, int fr, int fq) const {
        const int col0 = u.pn * BM + bj * HALF + wc * 32 + 4 * fq, rl0 = pc * BM + ai * HALF + wr * 64 + fr;
        const float* gp = gate + (size_t)2 * MODW + col0;
        const f32x4 g0 = *(const f32x4*)(gp), g1 = *(const f32x4*)(gp + 16);
#pragma unroll
        for (int m = 0; m < 4; ++m) { float* rowp = part + ((size_t)sp * 512 + rl0 + m * 16) * D + col0; *(f32x4*)rowp = g0 * a[m][0]; *(f32x4*)(rowp + 16) = g1 * a[m][1]; }
    }
    __device__ __forceinline__ void operator()(const f32x4 (&acc)[2][2][4][2], const Unit& u, int wr, int wc, int fr, int fq) const {
        const int colb = u.pn * BM + wc * 32 + 4 * fq;
        const float* gp = gate + (size_t)panel_group(u.pm) * MODW + colb;
        f32x4 gv[2][2];
#pragma unroll
        for (int bj = 0; bj < 2; ++bj)
#pragma unroll
            for (int n = 0; n < 2; ++n) gv[bj][n] = *(const f32x4*)(gp + bj * HALF + n * 16);
#pragma unroll
        for (int ai = 0; ai < 2; ++ai) {
            float* base = X + (size_t)(u.pm * BM + ai * HALF + wr * 64 + fr) * D + colb;
            const float* sbase = src_row0(u) + (size_t)(ai * HALF + wr * 64 + fr) * D + colb;
            f32x4 xin[4][2][2];
#pragma unroll
            for (int m = 0; m < 4; ++m)
#pragma unroll
                for (int bj = 0; bj < 2; ++bj)
#pragma unroll
                    for (int n = 0; n < 2; ++n) xin[m][bj][n] = *(const f32x4*)(sbase + (size_t)(m * 16) * D + bj * HALF + n * 16);
#pragma unroll
            for (int m = 0; m < 4; ++m)
#pragma unroll
                for (int bj = 0; bj < 2; ++bj)
#pragma unroll
                    for (int n = 0; n < 2; ++n) *(f32x4*)(base + (size_t)(m * 16) * D + bj * HALF + n * 16) = xin[m][bj][n] + gv[bj][n] * acc[ai][bj][m][n];
        }
    }
};
struct SliceOrder {
    int c, s, G;
    __device__ __forceinline__ bool next(int i, Unit& u) const { if (i != 0) return false; const int x = c & 7, r = c >> 3, pl = 8 * x + 4 * s + (r & 3); u.pm = pl + (pl >= 32 ? 1 : 0); u.pn = r >> 2; return true; }
    __device__ __forceinline__ void a_ready(const Unit&) const {}
    __device__ __forceinline__ void done(const Unit&) const {}
};
struct EpiResNorm {
    static constexpr bool PERM = false, AFTER_DRAIN = true;
    float* X; const float* gate;
    const float* ng; const float* nmod;
    bf16_t* XN; float* out;
    float* slots; unsigned* cnt; unsigned* tmo;
    const float* xin; float* part;
    __device__ __forceinline__ void fused(f32x4 (&acc)[2][2][4][2], const Unit& u, int wr, int wc, int fr, int fq, PG8_LAS unsigned char* lds, int wid, int lane) const {
        PG8_LAS float* P = (PG8_LAS float*)lds;
        PG8_LAS float* S = (PG8_LAS float*)(lds + 4096);
        PG8_LAS unsigned char* stg = lds + 8192;
        const int colb = u.pn * BM + wc * 32 + 4 * fq, grp = panel_group(u.pm);
        {   const float* gp = gate + (size_t)grp * MODW + colb;
            f32x4 gv[2][2];
#pragma unroll
            for (int bj = 0; bj < 2; ++bj)
#pragma unroll
                for (int n = 0; n < 2; ++n) gv[bj][n] = *(const f32x4*)(gp + bj * HALF + n * 16);
#pragma unroll
            for (int ai = 0; ai < 2; ++ai) {
                float* base = X + (size_t)(u.pm * BM + ai * HALF + wr * 64 + fr) * D + colb;
                const float* sbase = xin ? xin + ((size_t)(u.pm / 33) * SEQ + (size_t)(u.pm % 33) * BM + ai * HALF + wr * 64 + fr) * D + colb : base;
#pragma unroll
                for (int mh = 0; mh < 2; ++mh) {
                    f32x4 xv[2][2][2];
#pragma unroll
                    for (int mm = 0; mm < 2; ++mm)
#pragma unroll
                        for (int bj = 0; bj < 2; ++bj)
#pragma unroll
                            for (int n = 0; n < 2; ++n) xv[mm][bj][n] = *(const f32x4*)(sbase + (size_t)((2 * mh + mm) * 16) * D + bj * HALF + n * 16);
#pragma unroll
                    for (int mm = 0; mm < 2; ++mm) { const int m = 2 * mh + mm; float q = 0.f;
#pragma unroll
                        for (int bj = 0; bj < 2; ++bj)
#pragma unroll
                            for (int n = 0; n < 2; ++n) { const f32x4 y = xv[mm][bj][n] + gv[bj][n] * acc[ai][bj][m][n]; acc[ai][bj][m][n] = y;
                                q += (y[0] * y[0] + y[1] * y[1]) + (y[2] * y[2] + y[3] * y[3]); }
                        q += __shfl_xor(q, 16); q += __shfl_xor(q, 32);
                        if (fq == 0) P[(ai * HALF + wr * 64 + m * 16 + fr) * 4 + wc] = q; }
                    asm volatile("" ::: "memory"); }
            } }
        f32x4 cgs[2][2], csh[2][2];
        {   const float* mg = nmod ? nmod + (size_t)grp * MODW + colb : nullptr;
#pragma unroll
            for (int bj = 0; bj < 2; ++bj)
#pragma unroll
                for (int n = 0; n < 2; ++n) { const int co = bj * HALF + n * 16; const f32x4 g4 = *(const f32x4*)(ng + colb + co);
                    if (nmod) { cgs[bj][n] = g4 * (*(const f32x4*)(mg + D + co) + 1.0f); csh[bj][n] = *(const f32x4*)(mg + co); } else { cgs[bj][n] = g4; csh[bj][n] = (f32x4){0.f, 0.f, 0.f, 0.f}; } } }
        asm volatile("s_waitcnt lgkmcnt(0)" ::: "memory"); __builtin_amdgcn_s_barrier(); asm volatile("" ::: "memory");
        const int row = wid * 32 + (lane & 31);
        if (lane < 32) { const float t = (P[row * 4 + 0] + P[row * 4 + 1]) + (P[row * 4 + 2] + P[row * 4 + 3]);
            __hip_atomic_store((unsigned*)slots + ((size_t)(u.pm * BM + row) * 8 + u.pn), __float_as_uint(t), __ATOMIC_RELAXED, __HIP_MEMORY_SCOPE_AGENT); }
        asm volatile("s_waitcnt vmcnt(0)" ::: "memory");
        if (lane == 0) __hip_atomic_fetch_add(cnt + 64 * u.pm, 1u, __ATOMIC_RELAXED, __HIP_MEMORY_SCOPE_AGENT);
        if (nmod) {
            int t2 = threadIdx.x; asm volatile("" : "+v"(t2));
            const int w2 = t2 >> 6, l2 = t2 & 63; float* xb2 = X + (size_t)(u.pm * BM + (w2 >> 2) * 64 + (l2 & 15)) * D + u.pn * BM + (w2 & 3) * 32 + 4 * (l2 >> 4);
#pragma unroll
            for (int ai = 0; ai < 2; ++ai) { float* base = xb2 + (size_t)(ai * HALF) * D;
#pragma unroll
                for (int m = 0; m < 4; ++m)
#pragma unroll
                    for (int bj = 0; bj < 2; ++bj)
#pragma unroll
                        for (int n = 0; n < 2; ++n) *(f32x4*)(base + (size_t)(m * 16) * D + bj * HALF + n * 16) = acc[ai][bj][m][n]; } }
        if (wid == 0) { unsigned sp = 0;
            for (;;) { if ((unsigned)__builtin_amdgcn_readfirstlane(__hip_atomic_load(cnt + 64 * u.pm, __ATOMIC_RELAXED, __HIP_MEMORY_SCOPE_AGENT)) >= 64u) break;
                __builtin_amdgcn_s_sleep(2);
                if (++sp > (1u << 22)) { if (lane == 0) __hip_atomic_store(tmo, 1u, __ATOMIC_RELAXED, __HIP_MEMORY_SCOPE_AGENT); break; } }
            __builtin_amdgcn_fence(__ATOMIC_ACQUIRE, "agent"); }
        asm volatile("s_waitcnt vmcnt(0) lgkmcnt(0)" ::: "memory"); __builtin_amdgcn_s_barrier(); asm volatile("" ::: "memory");
        if (lane < 32) { const unsigned* sl = (const unsigned*)slots + (size_t)(u.pm * BM + row) * 8; float t = 0.f;
#pragma unroll
            for (int k = 0; k < 8; ++k) t += __uint_as_float(__hip_atomic_load(sl + k, __ATOMIC_RELAXED, __HIP_MEMORY_SCOPE_AGENT));
            S[row] = rsqrtf(t * (1.0f / D) + EPS); }
        asm volatile("s_waitcnt vmcnt(0) lgkmcnt(0)" ::: "memory"); __builtin_amdgcn_s_barrier(); asm volatile("" ::: "memory");
        if (nmod) {
#pragma unroll
            for (int bj = 0; bj < 2; ++bj)
#pragma unroll
                for (int n = 0; n < 2; ++n) { const int co = bj * HALF + n * 16;
                    const f32x4 gs = cgs[bj][n], sh = csh[bj][n];
#pragma unroll
                    for (int ai = 0; ai < 2; ++ai)
#pragma unroll
                        for (int m = 0; m < 4; ++m) { const int r = ai * HALF + wr * 64 + m * 16 + fr; const float rs = S[r]; const f32x4 y = acc[ai][bj][m][n] * rs * gs + sh;
                            *(PG8_LAS unsigned long long*)(stg + r * 528 + (wc * 32 + 4 * fq + co) * 2) = (unsigned long long)cvt_pk_bf16(y[0], y[1]) | ((unsigned long long)cvt_pk_bf16(y[2], y[3]) << 32); } }
            asm volatile("s_waitcnt lgkmcnt(0)" ::: "memory"); __builtin_amdgcn_s_barrier(); asm volatile("" ::: "memory");
            const int tid = wid * 64 + lane;
#pragma unroll
            for (int it = 0; it < 16; ++it) { const int p = it * 512 + tid, r = p >> 5, ch = p & 31;
                const u32x4 v = *(const PG8_LAS u32x4*)(stg + r * 528 + ch * 16);
                *(u32x4*)(XN + (size_t)(u.pm * BM + r) * D + u.pn * BM + ch * 8) = v; }
            asm volatile("s_waitcnt lgkmcnt(0)" ::: "memory"); __builtin_amdgcn_s_barrier(); asm volatile("" ::: "memory");
        } else {
            const int b = u.pm / 33, p = u.pm % 33;
            float* ob = out + ((size_t)b * SEQ + (size_t)p * BM) * D + colb;
#pragma unroll
            for (int bj = 0; bj < 2; ++bj)
#pragma unroll
                for (int n = 0; n < 2; ++n) { const int co = bj * HALF + n * 16; const f32x4 g4 = cgs[bj][n];
#pragma unroll
                    for (int ai = 0; ai < 2; ++ai)
#pragma unroll
                        for (int m = 0; m < 4; ++m) { const int r = ai * HALF + wr * 64 + m * 16 + fr; *(f32x4*)(ob + (size_t)r * D + co) = acc[ai][bj][m][n] * S[r] * g4; } }
        }
    }
    __device__ __forceinline__ void quad(const f32x4 (&)[4][2], const Unit&, int, int, int, int, int, int) const {}
    __device__ __forceinline__ void quad_part(const f32x4 (&a)[4][2], const Unit& u, int ai, int bj, int sp, int pc, int wr, int wc, int fr, int fq) const {
        const int col0 = u.pn * BM + bj * HALF + wc * 32 + 4 * fq, rl0 = pc * BM + ai * HALF + wr * 64 + fr;
        const float* gp = gate + (size_t)2 * MODW + col0;
        const f32x4 g0 = *(const f32x4*)(gp), g1 = *(const f32x4*)(gp + 16);
#pragma unroll
        for (int m = 0; m < 4; ++m) { float* rowp = part + ((size_t)sp * 512 + rl0 + m * 16) * D + col0; *(f32x4*)rowp = g0 * a[m][0]; *(f32x4*)(rowp + 16) = g1 * a[m][1]; }
    }
};
}

__device__ __forceinline__ int perm_row(int n, int mode) {
    if (mode == 1) { if (n >= 4096) return n; const int dd = n & 63; return (n & ~63) + (dd < 32 ? 2 * dd : 2 * (dd - 32) + 1); }
    if (mode == 2) { const int hd = n % 192; if (hd < 128) return n; const int e = hd - 128, dd = e & 31; return n - (e & 31) + (dd < 16 ? 2 * dd : 2 * (dd - 16) + 1); }
    return n;
}
struct TrJob { const float* src; bf16* dst; int N, Kp, mode, n0; };
__device__ __forceinline__ TrJob tr_job(const float* W, int N, bf16* WT, int Kp, int mode, int item) {
    const int nblk = N / 64, kb = item / nblk, nb = item % nblk;
    TrJob j; j.src = W + (size_t)(64 * kb) * N + 64 * nb; j.dst = WT + 64 * kb; j.N = N; j.Kp = Kp; j.mode = mode; j.n0 = 64 * nb; return j;
}
__device__ __forceinline__ void tr_load(f32x4 (&v)[16], const TrJob& j, int lane) {
    const int c = lane & 15, kq = lane >> 4;
#pragma unroll
    for (int i = 0; i < 16; ++i) v[i] = *(const GAS f32x4*)(j.src + (size_t)(4 * i + kq) * j.N + 4 * c);
}
__device__ __forceinline__ void tr_store(const f32x4 (&v)[16], const TrJob& jb, LAS unsigned char* scr, int lane) {
    const int c = lane & 15, kq = lane >> 4;
#pragma unroll
    for (int i = 0; i < 16; ++i) { LAS unsigned short* p = (LAS unsigned short*)(scr + (4 * c) * 132 + (4 * i + kq) * 2);
        p[0] = (unsigned short)f2bf(v[i].x); p[66] = (unsigned short)f2bf(v[i].y); p[132] = (unsigned short)f2bf(v[i].z); p[198] = (unsigned short)f2bf(v[i].w); }
    LDS_WAIT(); asm volatile("" ::: "memory");
    const int j = lane & 7;
#pragma unroll
    for (int m = 0; m < 8; ++m) { const int n = (lane >> 3) + 8 * m; const LAS unsigned* q = (const LAS unsigned*)(scr + n * 132 + j * 16);
        v4u o; o.x = q[0]; o.y = q[1]; o.z = q[2]; o.w = q[3];
        *(GAS v4u*)(jb.dst + (size_t)perm_row(jb.n0 + n, jb.mode) * jb.Kp + 8 * j) = o; }
    LDS_WAIT(); asm volatile("" ::: "memory");
}
__device__ __forceinline__ float silu_f(float v) { return v / (1.0f + __expf(-v)); }

__device__ __forceinline__ void ph_prologue(const Args& a, const Ctx& C, unsigned* pub = nullptr) {
    LAS unsigned char* scr = C.lds + C.wave * 16384;
    const int gw = C.vcu * 8 + C.wave, NGW = C.G * 8, lane = C.lane;
    bf16* WB = (bf16*)(a.ws + WS_WB);
    constexpr int IT_FF1 = (D / 64) * (DFF / 64), IT_FF2 = (DFF / 64) * (D / 64), IT_AIN = (D / 64) * (4096 / 64), IT_AOUT = (D / 64) * (D / 64), IT_BQKV = (D / 64) * (NQKV / 64),
                  IT_CDQ = (D / 64) * (1024 / 64), IT_CUQ = (MQR / 64) * (3072 / 64), IT_CUKV = (MKVR / 64) * (4096 / 64);
    constexpr int NITEMS = 4 * IT_FF1 + 4 * IT_FF2 + 2 * IT_AIN + 2 * IT_AOUT + IT_BQKV + IT_AOUT + IT_CDQ + IT_CUQ + IT_CUKV + IT_AOUT;
    auto job = [&](int it) -> TrJob {
        int r = it;
        if (r < 4 * IT_FF1) { const int l = r / IT_FF1; return tr_job(a.in[I_WFF1] + (size_t)l * D * DFF, DFF, WB + WB_FF1 + (size_t)l * D * DFF, D, 0, r % IT_FF1); } r -= 4 * IT_FF1;
        if (r < 4 * IT_FF2) { const int l = r / IT_FF2; return tr_job(a.in[I_WFF2] + (size_t)l * D * DFF, D, WB + WB_FF2 + (size_t)l * D * DFF, DFF, 0, r % IT_FF2); } r -= 4 * IT_FF2;
        if (r < 2 * IT_AIN) { const int l = r / IT_AIN; return tr_job(a.in[I_AWIN] + (size_t)l * D * 4096, 4096, WB + WB_AWIN + (size_t)l * D * 4096, D, 0, r % IT_AIN); } r -= 2 * IT_AIN;
        if (r < 2 * IT_AOUT) { const int l = r / IT_AOUT; return tr_job(a.in[I_AWOUT] + (size_t)l * D * D, D, WB + WB_AWOUT + (size_t)l * D * D, D, 0, r % IT_AOUT); } r -= 2 * IT_AOUT;
        if (r < IT_BQKV) return tr_job(a.in[I_BWQKV], NQKV, WB + WB_BQKV, D, 1, r); r -= IT_BQKV;
        if (r < IT_AOUT) return tr_job(a.in[I_BWO], D, WB + WB_BWO, D, 0, r); r -= IT_AOUT;
        if (r < IT_CDQ) return tr_job(a.in[I_CWDQKV], 1024, WB + WB_CDQKV, D, 0, r); r -= IT_CDQ;
        if (r < IT_CUQ) return tr_job(a.in[I_CWUQ], 3072, WB + WB_CUQ, 512, 2, r); r -= IT_CUQ;
        if (r < IT_CUKV) return tr_job(a.in[I_CWUKV], 4096, WB + WB_CUKV, 512, 0, r); r -= IT_CUKV;
        return tr_job(a.in[I_CWO], D, WB + WB_CWO, D, 0, r);
    };
    { int it = gw; TrJob j0, j1; f32x4 va[16], vb[16];
      if (it < NITEMS) { j0 = job(it); tr_load(va, j0, lane); }
      while (it < NITEMS) {
          const int it1 = it + NGW; if (it1 < NITEMS) { j1 = job(it1); tr_load(vb, j1, lane); }
          tr_store(va, j0, scr, lane);
          if (it1 >= NITEMS) break;
          const int it2 = it1 + NGW; if (it2 < NITEMS) { j0 = job(it2); tr_load(va, j0, lane); }
          tr_store(vb, j1, scr, lane);
          it = it2;
      } }
    const int gt = C.vcu * 512 + C.tid, NGT = C.G * 512;
    for (int i = gt; i < 3072 * 8; i += NGT) { const int n = i >> 3, c8 = i & 7; *(GAS v4u*)(WB + WB_CUQ + (size_t)n * 512 + 448 + c8 * 8) = (v4u){0u, 0u, 0u, 0u}; }
    { const float* wsrc = a.in[I_AWS]; for (int i = gt; i < 2 * GG * 128 * 128 / 8; i += NGT) { const f32x4 x0 = *(const GAS f32x4*)(wsrc + (size_t)i * 8), x1 = *(const GAS f32x4*)(wsrc + (size_t)i * 8 + 4);
        v4u o; o.x = pk2(x0.x, x0.y); o.y = pk2(x0.z, x0.w); o.z = pk2(x1.x, x1.y); o.w = pk2(x1.z, x1.w); *(GAS v4u*)(WB + WB_AWS + (size_t)i * 8) = o; } }
    { float* tab = (float*)(a.ws + WS_ROPE);
      for (int i = gt; i < 128 * 32; i += NGT) { const int pos = i / 32, f = i % 32; const float inv = powf(10000.0f, -(float)(2 * f) / 64.0f); const float an = (float)pos * inv; tab[i] = cosf(an); tab[4096 + i] = sinf(an); }
      for (int i = gt; i < 128 * 16; i += NGT) { const int pos = i / 16, f = i % 16; const float inv = powf(10000.0f, -(float)(2 * f) / 32.0f); const float an = (float)pos * inv; tab[8192 + i] = cosf(an); tab[8192 + 2048 + i] = sinf(an); } }
    __syncthreads();
    { LAS float* s = (LAS float*)C.lds; LAS float* red = s + 3 * D;
      const float* c = a.in[I_C]; const float* cctx = a.in[I_CCTX]; const float* wmod = a.in[I_WMOD]; const float* bmod = a.in[I_BMOD]; float* mod = (float*)(a.ws + WS_MOD);
      for (int i = C.tid; i < 3 * D; i += 512) { const int g = i / D, k = i % D; const float v = g < 2 ? c[g * D + k] : cctx[k]; s[i] = silu_f(v); }
      __syncthreads();
      const int cq = lane & 15, kr = lane >> 4, wave = C.wave;
      for (int u = C.vcu; u < DEPTH * (MODW / 192); u += C.G) {
          const int l = u / (MODW / 192), n0 = (u % (MODW / 192)) * 192;
          const float* W = wmod + (size_t)l * D * MODW + n0 + cq * 4;
          f32x4 acc[3][3];
#pragma unroll
          for (int c3 = 0; c3 < 3; ++c3)
#pragma unroll
              for (int g = 0; g < 3; ++g) acc[c3][g] = (f32x4){0.f, 0.f, 0.f, 0.f};
          for (int kk = 0; kk < 256; kk += 32) { f32x4 w[8][3];
#pragma unroll
              for (int q = 0; q < 8; ++q)
#pragma unroll
                  for (int c3 = 0; c3 < 3; ++c3) w[q][c3] = *(const GAS f32x4*)(W + (size_t)(wave * 256 + kr + kk + 4 * q) * MODW + c3 * 64);
#pragma unroll
              for (int q = 0; q < 8; ++q) { const int k = wave * 256 + kr + kk + 4 * q; const float s0 = s[k], s1 = s[D + k], s2 = s[2 * D + k];
#pragma unroll
                  for (int c3 = 0; c3 < 3; ++c3) { acc[c3][0] += s0 * w[q][c3]; acc[c3][1] += s1 * w[q][c3]; acc[c3][2] += s2 * w[q][c3]; } } }
#pragma unroll
          for (int c3 = 0; c3 < 3; ++c3)
#pragma unroll
              for (int g = 0; g < 3; ++g)
#pragma unroll
                  for (int j = 0; j < 4; ++j) { float v = acc[c3][g][j]; v += __shfl_xor(v, 16); v += __shfl_xor(v, 32); acc[c3][g][j] = v; }
          if (kr == 0) {
#pragma unroll
              for (int c3 = 0; c3 < 3; ++c3)
#pragma unroll
                  for (int g = 0; g < 3; ++g)
#pragma unroll
                      for (int j = 0; j < 4; ++j) red[(wave * 3 + g) * 192 + c3 * 64 + cq * 4 + j] = acc[c3][g][j]; }
          __syncthreads();
          for (int i = C.tid; i < 3 * 192; i += 512) { const int g = i / 192, n = i % 192; float v = bmod[(size_t)l * MODW + n0 + n];
#pragma unroll
              for (int w = 0; w < 8; ++w) v += red[(w * 3 + g) * 192 + n];
              if (pub) __hip_atomic_store((unsigned*)(mod + ((size_t)l * 3 + g) * MODW + n0 + n), __float_as_uint(v), __ATOMIC_RELAXED, __HIP_MEMORY_SCOPE_AGENT);
              else mod[((size_t)l * 3 + g) * MODW + n0 + n] = v; }
          __syncthreads();
      } }
    if (pub) { asm volatile("s_waitcnt vmcnt(0)" ::: "memory"); if (C.lane == 0) __hip_atomic_fetch_add(pub, 1u, __ATOMIC_RELAXED, __HIP_MEMORY_SCOPE_AGENT); }
}

__device__ __forceinline__ float wsum(float v) {
#pragma unroll
    for (int o = 1; o < 64; o <<= 1) v += __shfl_xor(v, o);
    return v;
}
__device__ __forceinline__ void ph_norm(const Ctx& C, float* X, const float* g, const float* modl, int which, bf16* XN, int lat_only, const float* xin = nullptr, const float* cin = nullptr, const float* part = nullptr, int nsplit = 0, int g0 = 0, unsigned* pub = nullptr) {
    const int gw = C.vcu * 8 + C.wave, NGW = C.G * 8, lane = C.lane;
    for (int grp = g0; grp < (lat_only ? 2 : 3); ++grp) {
        const float* mg = modl + (size_t)grp * MODW + which * 3 * D;
        f32x4 gs[8], sh[8];
#pragma unroll
        for (int j = 0; j < 8; ++j) { const int c4 = j * 64 + lane; gs[j] = ((const GAS f32x4*)g)[c4] * (((const GAS f32x4*)(mg + D))[c4] + 1.0f); sh[j] = ((const GAS f32x4*)mg)[c4]; }
        const int count = grp < 2 ? SEQ : BATCH * CTXL;
        for (int i = gw; i < count; i += NGW) {
            const bool isc = grp == 2;
            const int b_ = isc ? i / CTXL : grp, t_ = isc ? SEQ + i % CTXL : i, r = b_ * TB + t_;
            const float* srow = isc ? (cin ? cin + (size_t)i * D : X + (size_t)r * D) : (xin ? xin + ((size_t)b_ * SEQ + t_) * D : X + (size_t)r * D);
            const GAS f32x4* xr = (const GAS f32x4*)srow;
            f32x4 v[8]; float ss = 0.f;
#pragma unroll
            for (int j = 0; j < 8; ++j) v[j] = xr[j * 64 + lane];
            if (part && isc) {
                for (int sp = 0; sp < nsplit; ++sp) { const GAS f32x4* pr = (const GAS f32x4*)(part + ((size_t)sp * 512 + i) * D);
#pragma unroll
                    for (int j = 0; j < 8; ++j) v[j] += pr[j * 64 + lane]; }
                GAS f32x4* xw = (GAS f32x4*)(X + (size_t)r * D);
#pragma unroll
                for (int j = 0; j < 8; ++j) xw[j * 64 + lane] = v[j]; }
#pragma unroll
            for (int j = 0; j < 8; ++j) ss += v[j].x * v[j].x + v[j].y * v[j].y + v[j].z * v[j].z + v[j].w * v[j].w;
            const float rstd = rsqrtf(wsum(ss) * (1.0f / D) + EPS);
            GAS unsigned long long* o8 = (GAS unsigned long long*)(XN + (size_t)r * D);
#pragma unroll
            for (int j = 0; j < 8; ++j) { const f32x4 y = v[j] * rstd * gs[j] + sh[j];
                if (pub) { unsigned* o4 = (unsigned*)(XN + (size_t)r * D) + 2 * (j * 64 + lane);
                    __hip_atomic_store(o4, pk2(y.x, y.y), __ATOMIC_RELAXED, __HIP_MEMORY_SCOPE_AGENT); __hip_atomic_store(o4 + 1, pk2(y.z, y.w), __ATOMIC_RELAXED, __HIP_MEMORY_SCOPE_AGENT); }
                else o8[j * 64 + lane] = (unsigned long long)pk2(y.x, y.y) | ((unsigned long long)pk2(y.z, y.w) << 32); }
        }
    }
    if (pub) { asm volatile("s_waitcnt vmcnt(0)" ::: "memory"); if (lane == 0) __hip_atomic_fetch_add(pub, 1u, __ATOMIC_RELAXED, __HIP_MEMORY_SCOPE_AGENT); }
}
__device__ __forceinline__ void ph_final(const Ctx& C, const float* X, const float* g, float* out) {
    const int gw = C.vcu * 8 + C.wave, NGW = C.G * 8, lane = C.lane;
    f32x4 gg[8];
#pragma unroll
    for (int j = 0; j < 8; ++j) gg[j] = ((const GAS f32x4*)g)[j * 64 + lane];
    for (int q = gw; q < BATCH * SEQ; q += NGW) {
        const int b = q / SEQ, t = q % SEQ, r = b * TB + t;
        const GAS f32x4* xr = (const GAS f32x4*)(X + (size_t)r * D);
        f32x4 v[8]; float ss = 0.f;
#pragma unroll
        for (int j = 0; j < 8; ++j) { v[j] = xr[j * 64 + lane]; ss += v[j].x * v[j].x + v[j].y * v[j].y + v[j].z * v[j].z + v[j].w * v[j].w; }
        const float rstd = rsqrtf(wsum(ss) * (1.0f / D) + EPS);
        GAS f32x4* o = (GAS f32x4*)(out + (size_t)q * D);
#pragma unroll
        for (int j = 0; j < 8; ++j) o[j * 64 + lane] = v[j] * rstd * gg[j];
    }
}

namespace pg8 {
__device__ __forceinline__ float gelu_tanh_f(float x) {
    const float t = x * (1.0f + 0.044715f * x * x);
    return x * __builtin_amdgcn_rcpf(1.0f + __builtin_amdgcn_exp2f(-2.3022081987f * t));
}
struct EpiGeluStats {
    static constexpr bool PERM = true, AFTER_DRAIN = false;
    bf16_t* O; PG8_LAS const float* bias; float* st;
    __device__ __forceinline__ void quad(const f32x4 (&a)[4][2], const Unit& u, int ai, int bj, int wr, int wc, int fr, int fq) const {
        const int row0 = u.pm * BM + ai * HALF + wr * 64 + fr, col0 = u.pn * BM + bj * HALF + wc * 32 + 8 * fq;
        const f32x4 b0 = *(PG8_LAS const f32x4*)(bias + col0), b1 = *(PG8_LAS const f32x4*)(bias + col0 + 4);
        const bool vhalf = u.pn >= 8;
#pragma unroll
        for (int m = 0; m < 4; ++m) { const int row = row0 + m * 16; float s = 0.f, q = 0.f;
            f32x4 v0 = a[m][0] + b0, v1 = a[m][1] + b1;
#pragma unroll
            for (int j = 0; j < 4; ++j) { v0[j] = gelu_tanh_f(v0[j]); v1[j] = gelu_tanh_f(v1[j]); s += v0[j] + v1[j]; q += v0[j] * v0[j] + v1[j] * v1[j]; }
            u32x4 w; w.x = cvt_pk_bf16(v0[0], v0[1]); w.y = cvt_pk_bf16(v0[2], v0[3]); w.z = cvt_pk_bf16(v1[0], v1[1]); w.w = cvt_pk_bf16(v1[2], v1[3]);
            *(u32x4*)(O + (size_t)row * 4096 + col0) = w;
            if (vhalf) { s += __shfl_xor(s, 16); s += __shfl_xor(s, 32); q += __shfl_xor(q, 16); q += __shfl_xor(q, 32);
                if (fq == 0) { f32x2 o; o.x = s; o.y = q; *(f32x2*)(st + ((size_t)row * 64 + (u.pn - 8) * 8 + bj * 4 + wc) * 2) = o; } } }
    }
    __device__ __forceinline__ void operator()(const f32x4 (&acc)[2][2][4][2], const Unit& u, int wr, int wc, int fr, int fq) const {
        const bool vhalf = u.pn >= 8;
#pragma unroll
        for (int ai = 0; ai < 2; ++ai) {
            float ss[4] = {0.f, 0.f, 0.f, 0.f}, qq[4] = {0.f, 0.f, 0.f, 0.f};
#pragma unroll
            for (int bj = 0; bj < 2; ++bj) {
                const int row0 = u.pm * BM + ai * HALF + wr * 64 + fr, col0 = u.pn * BM + bj * HALF + wc * 32 + 8 * fq;
                const f32x4 b0 = *(PG8_LAS const f32x4*)(bias + col0), b1 = *(PG8_LAS const f32x4*)(bias + col0 + 4);
#pragma unroll
                for (int m = 0; m < 4; ++m) { const int row = row0 + m * 16;
                    f32x4 v0 = acc[ai][bj][m][0] + b0, v1 = acc[ai][bj][m][1] + b1;
#pragma unroll
                    for (int j = 0; j < 4; ++j) { v0[j] = gelu_tanh_f(v0[j]); v1[j] = gelu_tanh_f(v1[j]); ss[m] += v0[j] + v1[j]; qq[m] += v0[j] * v0[j] + v1[j] * v1[j]; }
                    u32x4 w; w.x = cvt_pk_bf16(v0[0], v0[1]); w.y = cvt_pk_bf16(v0[2], v0[3]); w.z = cvt_pk_bf16(v1[0], v1[1]); w.w = cvt_pk_bf16(v1[2], v1[3]);
                    *(u32x4*)(O + (size_t)row * 4096 + col0) = w; } }
            if (vhalf) {
#pragma unroll
                for (int m = 0; m < 4; ++m) { float s = ss[m], q = qq[m]; s += __shfl_xor(s, 16); s += __shfl_xor(s, 32); q += __shfl_xor(q, 16); q += __shfl_xor(q, 32);
                    if (fq == 0) { f32x2 o; o.x = s; o.y = q; *(f32x2*)(st + ((size_t)(u.pm * BM + ai * HALF + wr * 64 + fr + m * 16) * 64 + (u.pn - 8) * 4 + wc) * 2) = o; } } }
        }
    }
};
}

typedef float f32x2 __attribute__((ext_vector_type(2)));
typedef short s16x4_t __attribute__((ext_vector_type(4)));
__device__ __forceinline__ void ph_gmlp_spatial(const Ctx& C, const bf16* Z, const float* st, const float* lng, const bf16* Wsb, const float* bs, bf16* G, int lat_only) {
    LAS unsigned char* Vs = C.lds;
    LAS float* stat = (LAS float*)(C.lds + 128 * 264);
    const int tid = C.tid, lane = C.lane, w = C.wave, fr = lane & 15, fq = lane >> 4;
    const int nchunk = lat_only ? (BATCH * SEQ / CHUNK) : (NR / CHUNK), nunits = nchunk * GG;
    LAS unsigned char* Wl = C.lds + 40960;
    LAS unsigned char* Ol = C.lds + 77824;
    int gl = -1;
    for (int un = C.vcu; un < nunits; un += C.G) {
        if (un % GG != gl) { gl = un % GG; __syncthreads();
            const bf16* wsrc = Wsb + (size_t)gl * 128 * 128;
#pragma unroll
            for (int it = 0; it < 4; ++it) { const int idx = it * 512 + tid, p = idx >> 4, c8 = idx & 15;
                *(LAS v4u*)(Wl + p * 272 + c8 * 16) = *(const GAS v4u*)(wsrc + (size_t)p * 128 + c8 * 8); } }
        const int g = un % GG, chl = un / GG; const int ch = lat_only ? chl + 2 * (chl / 64) : chl;
        const int r0 = ch * CHUNK;
        const int c8 = tid & 15; v4u raw[4];
#pragma unroll
        for (int it = 0; it < 4; ++it) raw[it] = *(const GAS v4u*)(Z + (size_t)(r0 + it * 32 + (tid >> 4)) * 4096 + GW + g * GC + c8 * 8);
        const bool cx = (r0 % TB) >= SEQ; f32x4 sp0[4], sp1[4];
#pragma unroll
        for (int it = 0; it < 4; ++it) { const GAS f32x4* p = (const GAS f32x4*)(st + (size_t)(r0 + it * 32 + (tid >> 4)) * 128); sp0[it] = p[c8]; sp1[it] = cx ? p[16 + c8] : (f32x4){0.f, 0.f, 0.f, 0.f}; }
        __syncthreads();
        float mean4[4], rstd4[4];
#pragma unroll
        for (int it = 0; it < 4; ++it) { float s = (sp0[it].x + sp0[it].z) + (sp1[it].x + sp1[it].z), q = (sp0[it].y + sp0[it].w) + (sp1[it].y + sp1[it].w);
#pragma unroll
            for (int o = 1; o < 16; o <<= 1) { s += __shfl_xor(s, o); q += __shfl_xor(q, o); }
            const float mean = s * (1.0f / GW), var = q * (1.0f / GW) - mean * mean; mean4[it] = mean; rstd4[it] = rsqrtf(fmaxf(var, 0.f) + EPS); }
        {   const f32x4 g0 = *(const GAS f32x4*)(lng + g * GC + c8 * 8), g1 = *(const GAS f32x4*)(lng + g * GC + c8 * 8 + 4);
#pragma unroll
            for (int it = 0; it < 4; ++it) { const int q = it * 32 + (tid >> 4);
                const float mean = mean4[it], rstd = rstd4[it];
                float x[8];
#pragma unroll
                for (int j = 0; j < 4; ++j) { x[2 * j] = __builtin_bit_cast(float, raw[it][j] << 16); x[2 * j + 1] = __builtin_bit_cast(float, raw[it][j] & 0xffff0000u); }
                unsigned o0 = pk2((x[0] - mean) * rstd * g0.x, (x[1] - mean) * rstd * g0.y), o1 = pk2((x[2] - mean) * rstd * g0.z, (x[3] - mean) * rstd * g0.w);
                unsigned o2 = pk2((x[4] - mean) * rstd * g1.x, (x[5] - mean) * rstd * g1.y), o3 = pk2((x[6] - mean) * rstd * g1.z, (x[7] - mean) * rstd * g1.w);
                LAS unsigned long long* d = (LAS unsigned long long*)(Vs + q * 264 + c8 * 16);
                d[0] = (unsigned long long)o0 | ((unsigned long long)o1 << 32); d[1] = (unsigned long long)o2 | ((unsigned long long)o3 << 32); } }
        v4u uraw[4];
#pragma unroll
        for (int it = 0; it < 4; ++it) uraw[it] = *(const GAS v4u*)(Z + (size_t)(r0 + it * 32 + (tid >> 4)) * 4096 + g * GC + c8 * 8);
        float bv[4];
#pragma unroll
        for (int it = 0; it < 4; ++it) bv[it] = *(const GAS float*)(bs + g * CHUNK + it * 32 + (tid >> 4));
        __syncthreads();
        bf16x8 af[4];
        {   const int ab = (int)(unsigned)(size_t)Vs + (8 * fq + (fr >> 2)) * 264 + 32 * w + 8 * (fr & 3);
            s16x4_t tl[4], th[4];
#pragma unroll
            for (int ks = 0; ks < 4; ++ks) { asm volatile("ds_read_b64_tr_b16 %0, %1" : "=&v"(tl[ks]) : "v"(ab + ks * 32 * 264) : "memory");
                                             asm volatile("ds_read_b64_tr_b16 %0, %1" : "=&v"(th[ks]) : "v"(ab + ks * 32 * 264 + 4 * 264) : "memory"); }
            asm volatile("s_waitcnt lgkmcnt(0)" ::: "memory");
#pragma unroll
            for (int ks = 0; ks < 4; ++ks) af[ks] = (bf16x8){tl[ks][0], tl[ks][1], tl[ks][2], tl[ks][3], th[ks][0], th[ks][1], th[ks][2], th[ks][3]}; }
#pragma unroll
        for (int pt = 0; pt < 8; ++pt) {
            f32x4 acc = {0.f, 0.f, 0.f, 0.f};
#pragma unroll
            for (int ks = 0; ks < 4; ++ks) { const bf16x8 bfrag = *(const LAS bf16x8*)(Wl + (16 * pt + fr) * 272 + 64 * ks + 16 * fq);
                acc = __builtin_amdgcn_mfma_f32_16x16x32_bf16(af[ks], bfrag, acc, 0, 0, 0); }
            *(LAS f32x4*)(Ol + (16 * pt + fr) * 528 + (16 * w + 4 * fq) * 4) = acc;
        }
        __syncthreads();
#pragma unroll
        for (int it = 0; it < 4; ++it) { const int p = it * 32 + (tid >> 4);
            const f32x4 s0 = *(const LAS f32x4*)(Ol + p * 528 + c8 * 32), s1 = *(const LAS f32x4*)(Ol + p * 528 + c8 * 32 + 16);
            const float b = bv[it];
            float u[8];
#pragma unroll
            for (int j = 0; j < 4; ++j) { u[2 * j] = __builtin_bit_cast(float, uraw[it][j] << 16); u[2 * j + 1] = __builtin_bit_cast(float, uraw[it][j] & 0xffff0000u); }
            v4u o; o.x = pk2(u[0] * (s0.x + b), u[1] * (s0.y + b)); o.y = pk2(u[2] * (s0.z + b), u[3] * (s0.w + b)); o.z = pk2(u[4] * (s1.x + b), u[5] * (s1.y + b)); o.w = pk2(u[6] * (s1.z + b), u[7] * (s1.w + b));
            *(GAS v4u*)(G + (size_t)(r0 + p) * GW + g * GC + c8 * 8) = o; }
    }
    __syncthreads();
}

namespace att {
using bf16x8 = __attribute__((ext_vector_type(8))) short;
using s16x4  = __attribute__((ext_vector_type(4))) short;
using f32x16 = __attribute__((ext_vector_type(16))) float;
using u32x4  = __attribute__((ext_vector_type(4))) unsigned;
typedef unsigned short bf16;
constexpr int KVBLK = 64, QBLK = 32, NW = 8;
constexpr float THR = 8.f;
#define ATT_KSWZ(row, colB) ((row) * 256 + ((colB) ^ (((row) & 7) << 4)))
#define ATT_SBAR() __builtin_amdgcn_sched_barrier(0)
__device__ __forceinline__ int crow(int r, int hi) { return (r & 3) + 8 * (r >> 2) + 4 * hi; }
__device__ __forceinline__ unsigned cvtpk(float lo, float hi) { unsigned r; asm volatile("v_cvt_pk_bf16_f32 %0, %1, %2" : "=v"(r) : "v"(lo), "v"(hi)); return r; }

__device__ __forceinline__ void partialSM(f32x16& p0, f32x16& p1, float& m_reg, float& mn, float& alpha, float Cs, float thr) {
  float pmax = p0[0];
#pragma unroll
  for (int r = 1; r < 16; ++r) pmax = fmaxf(pmax, p0[r]);
#pragma unroll
  for (int r = 0; r < 16; ++r) pmax = fmaxf(pmax, p1[r]);
  { auto rr = __builtin_amdgcn_permlane32_swap(__float_as_uint(pmax), __float_as_uint(pmax), false, false);
    pmax = fmaxf(__uint_as_float(rr[0]), __uint_as_float(rr[1])); }
  if (__builtin_expect(__all(pmax - m_reg <= thr), 1)) { mn = m_reg; alpha = 1.f; }
  else { mn = fmaxf(m_reg, pmax); alpha = __builtin_amdgcn_exp2f((m_reg - mn) * Cs); m_reg = mn; }
  float mnC = -mn * Cs;
#pragma unroll
  for (int r = 0; r < 16; ++r) p0[r] = fmaf(p0[r], Cs, mnC);
#pragma unroll
  for (int r = 0; r < 16; ++r) p1[r] = fmaf(p1[r], Cs, mnC);
#pragma unroll
  for (int r = 0; r < 16; ++r) p0[r] = __builtin_amdgcn_exp2f(p0[r]);
}
__device__ __forceinline__ void finishSM(f32x16& p0, f32x16& p1, float alpha, float& l_reg, bf16x8& pa0, bf16x8& pa1, bf16x8& pa2, bf16x8& pa3) {
#pragma unroll
  for (int r = 0; r < 16; ++r) p1[r] = __builtin_amdgcn_exp2f(p1[r]);
  float ps = 0;
#pragma unroll
  for (int r = 0; r < 16; ++r) ps += p0[r];
#pragma unroll
  for (int r = 0; r < 16; ++r) ps += p1[r];
  { auto rr = __builtin_amdgcn_permlane32_swap(__float_as_uint(ps), __float_as_uint(ps), false, false);
    ps = __uint_as_float(rr[0]) + __uint_as_float(rr[1]); }
  l_reg = l_reg * alpha + ps;
#define ATT_PK4(P, BASE, OUT) do { unsigned a0 = cvtpk(P[BASE + 0], P[BASE + 1]), a1 = cvtpk(P[BASE + 2], P[BASE + 3]);   \
    unsigned b0 = cvtpk(P[BASE + 4], P[BASE + 5]), b1 = cvtpk(P[BASE + 6], P[BASE + 7]);                              \
    auto r0 = __builtin_amdgcn_permlane32_swap(a0, b0, false, false); auto r1 = __builtin_amdgcn_permlane32_swap(a1, b1, false, false); \
    u32x4 w = {r0[0], r1[0], r0[1], r1[1]}; OUT = *reinterpret_cast<bf16x8*>(&w); } while (0)
  ATT_PK4(p0, 0, pa0); ATT_PK4(p0, 8, pa1); ATT_PK4(p1, 0, pa2); ATT_PK4(p1, 8, pa3);
#undef ATT_PK4
}
__device__ __forceinline__ int v_st(int k, int c) { const int kk = (k & ~0xC) | ((k & 4) << 1) | ((k & 8) >> 1); return ((kk >> 3) * 4 + (c >> 5)) * 512 + ((kk & 7) * 32 + (c & 31)) * 2; }
__device__ __forceinline__ int v_rd_base(int lane) { return ((lane & 3) << 3) | (((lane >> 2) & 3) << 6) | (((lane >> 4) & 1) << 5) | (((lane >> 5) & 1) << 8); }
constexpr int v_rd_off(int d0, int ks, int half) { return d0 * 512 + ks * 4096 + half * 2048; }
template <int OFF> __device__ __forceinline__ s16x4 tr_read(int vb) {
  s16x4 r; asm volatile("ds_read_b64_tr_b16 %0, %1 offset:%2" : "=&v"(r) : "v"(vb), "i"(OFF) : "memory"); return r;
}
template <int D0> __device__ __forceinline__ void pv_one(f32x16& od, int vb, bf16x8 pa0, bf16x8 pa1, bf16x8 pa2, bf16x8 pa3) {
  const s16x4 l0 = tr_read<v_rd_off(D0, 0, 0)>(vb), h0 = tr_read<v_rd_off(D0, 0, 1)>(vb), l1 = tr_read<v_rd_off(D0, 1, 0)>(vb), h1 = tr_read<v_rd_off(D0, 1, 1)>(vb);
  const s16x4 l2 = tr_read<v_rd_off(D0, 2, 0)>(vb), h2 = tr_read<v_rd_off(D0, 2, 1)>(vb), l3 = tr_read<v_rd_off(D0, 3, 0)>(vb), h3 = tr_read<v_rd_off(D0, 3, 1)>(vb);
  asm volatile("s_waitcnt lgkmcnt(0)" ::: "memory"); ATT_SBAR();
#define ATT_PK(L, H) (bf16x8){L[0], L[1], L[2], L[3], H[0], H[1], H[2], H[3]}
  od = __builtin_amdgcn_mfma_f32_32x32x16_bf16(pa0, ATT_PK(l0, h0), od, 0, 0, 0);
  od = __builtin_amdgcn_mfma_f32_32x32x16_bf16(pa1, ATT_PK(l1, h1), od, 0, 0, 0);
  od = __builtin_amdgcn_mfma_f32_32x32x16_bf16(pa2, ATT_PK(l2, h2), od, 0, 0, 0);
  od = __builtin_amdgcn_mfma_f32_32x32x16_bf16(pa3, ATT_PK(l3, h3), od, 0, 0, 0);
#undef ATT_PK
}
__device__ __forceinline__ void pv_d0(f32x16* o, int vb, bf16x8 pa0, bf16x8 pa1, bf16x8 pa2, bf16x8 pa3) {
  pv_one<0>(o[0], vb, pa0, pa1, pa2, pa3); pv_one<1>(o[1], vb, pa0, pa1, pa2, pa3); pv_one<2>(o[2], vb, pa0, pa1, pa2, pa3); pv_one<3>(o[3], vb, pa0, pa1, pa2, pa3);
}
constexpr size_t SHM_V = KVBLK * 128 * 2, SHM_K = KVBLK * 128 * 2, SHM_ATTN = 2 * SHM_V + 2 * SHM_K + NW * 64 * 4;

}

namespace pg8 {
struct EpiQkvRope {
    static constexpr bool PERM = true, AFTER_DRAIN = false;
    bf16_t* O; const float* tab; PG8_LAS const _Float16* tl;
    __device__ __forceinline__ void quad(const f32x4 (&a)[4][2], const Unit& u, int ai, int bj, int wr, int wc, int fr, int fq) const {
        const int row0 = u.pm * BM + ai * HALF + wr * 64 + fr, col0 = u.pn * BM + bj * HALF + wc * 32 + 8 * fq;
        const bool rope = (u.pn < 16) && ((u.pm % 33) != 32);
        const int half = wc >> 1, f0 = 16 * (wc & 1) + 4 * fq;
#pragma unroll
        for (int m = 0; m < 4; ++m) { const int row = row0 + m * 16;
            f32x4 cs = {1.f, 1.f, 1.f, 1.f}, sn = {0.f, 0.f, 0.f, 0.f};
            if (rope) { const int t = row % TB, pos = half ? (t % GRID_W) : (t / GRID_W);
                typedef _Float16 h16x4 __attribute__((ext_vector_type(4)));
                const h16x4 ch = *(PG8_LAS const h16x4*)(tl + pos * 32 + f0), sh = *(PG8_LAS const h16x4*)(tl + 4096 + pos * 32 + f0);
                cs = (f32x4){(float)ch[0], (float)ch[1], (float)ch[2], (float)ch[3]}; sn = (f32x4){(float)sh[0], (float)sh[1], (float)sh[2], (float)sh[3]}; }
            const f32x4 v0 = a[m][0], v1 = a[m][1];
            const float a0 = v0[0] * cs[0] - v0[1] * sn[0], b0 = v0[1] * cs[0] + v0[0] * sn[0], a1 = v0[2] * cs[1] - v0[3] * sn[1], b1 = v0[3] * cs[1] + v0[2] * sn[1];
            const float a2 = v1[0] * cs[2] - v1[1] * sn[2], b2 = v1[1] * cs[2] + v1[0] * sn[2], a3 = v1[2] * cs[3] - v1[3] * sn[3], b3 = v1[3] * cs[3] + v1[2] * sn[3];
            u32x4 w; w.x = cvt_pk_bf16(a0, b0); w.y = cvt_pk_bf16(a1, b1); w.z = cvt_pk_bf16(a2, b2); w.w = cvt_pk_bf16(a3, b3);
            *(u32x4*)(O + (size_t)row * 6144 + col0) = w; }
    }
    __device__ __forceinline__ void operator()(const f32x4 (&acc)[2][2][4][2], const Unit& u, int wr, int wc, int fr, int fq) const {
#pragma unroll
        for (int ai = 0; ai < 2; ++ai)
#pragma unroll
            for (int bj = 0; bj < 2; ++bj) quad(acc[ai][bj], u, ai, bj, wr, wc, fr, fq);
    }
};
}

__device__ __forceinline__ void ph_diff_combine(const Ctx& C, const bf16* O, const float* lq1, const float* lk1, const float* lq2, const float* lk2, const float* subg, float lambda_init, bf16* ON) {
    const int gw = C.vcu * 8 + C.wave, NGW = C.G * 8, lane = C.lane, l32 = lane & 31;
    float d1 = lq1[lane] * lk1[lane] + lq1[lane + 64] * lk1[lane + 64], d2 = lq2[lane] * lk2[lane] + lq2[lane + 64] * lk2[lane + 64];
    d1 = wsum(d1); d2 = wsum(d2);
    const float lam = expf(d1) - expf(d2) + lambda_init;
    const f32x4 g0 = *(const GAS f32x4*)(subg + l32 * 8), g1 = *(const GAS f32x4*)(subg + l32 * 8 + 4);
    for (int r = gw; r < NR; r += NGW) {
        v4u raw[DH];
#pragma unroll
        for (int h = 0; h < DH; ++h) raw[h] = *(const GAS v4u*)(O + (size_t)r * 4096 + h * 512 + lane * 8);
#pragma unroll
        for (int h = 0; h < DH; ++h) {
            float v[8]; float ss = 0.f;
#pragma unroll
            for (int j = 0; j < 4; ++j) { const unsigned mine = raw[h][j], other = (unsigned)__shfl((int)mine, l32 + 32);
                const float a0 = __builtin_bit_cast(float, mine << 16), a1 = __builtin_bit_cast(float, mine & 0xffff0000u), b0 = __builtin_bit_cast(float, other << 16), b1 = __builtin_bit_cast(float, other & 0xffff0000u);
                v[2 * j] = a0 - lam * b0; v[2 * j + 1] = a1 - lam * b1; ss += v[2 * j] * v[2 * j] + v[2 * j + 1] * v[2 * j + 1]; }
#pragma unroll
            for (int o = 1; o < 32; o <<= 1) ss += __shfl_xor(ss, o);
            const float k = rsqrtf(ss * (1.0f / 256) + EPS) * (1.0f - lambda_init);
            v4u ow; ow.x = pk2(v[0] * k * g0.x, v[1] * k * g0.y); ow.y = pk2(v[2] * k * g0.z, v[3] * k * g0.w); ow.z = pk2(v[4] * k * g1.x, v[5] * k * g1.y); ow.w = pk2(v[6] * k * g1.z, v[7] * k * g1.w);
            if (lane < 32) *(GAS v4u*)(ON + (size_t)r * 2048 + h * 256 + l32 * 8) = ow;
        }
    }
}

namespace att {
constexpr int NQR2 = 4;
constexpr int D2_K = 0, D2_V = 2 * 16384, D2_Q = D2_V + 2 * 32768, D2_WS = D2_Q + NW * (8 - NQR2) * 1024, SHM_D2 = D2_WS + NW * 64 * 4;
constexpr int v_rd_off2(int d0, int ks, int half) { return d0 * 512 + ks * 8192 + half * 4096; }
template <int D0, int SLOT> __device__ __forceinline__ void pv_one2(f32x16& od, int vb, bf16x8 pa0, bf16x8 pa1, bf16x8 pa2, bf16x8 pa3) {
  constexpr int B = SLOT * 32768;
  const s16x4 l0 = tr_read<B + v_rd_off2(D0, 0, 0)>(vb), h0 = tr_read<B + v_rd_off2(D0, 0, 1)>(vb), l1 = tr_read<B + v_rd_off2(D0, 1, 0)>(vb), h1 = tr_read<B + v_rd_off2(D0, 1, 1)>(vb);
  const s16x4 l2 = tr_read<B + v_rd_off2(D0, 2, 0)>(vb), h2 = tr_read<B + v_rd_off2(D0, 2, 1)>(vb), l3 = tr_read<B + v_rd_off2(D0, 3, 0)>(vb), h3 = tr_read<B + v_rd_off2(D0, 3, 1)>(vb);
  asm volatile("s_waitcnt lgkmcnt(0)" ::: "memory"); ATT_SBAR();
#define ATT_PK(L, H) (bf16x8){L[0], L[1], L[2], L[3], H[0], H[1], H[2], H[3]}
  od = __builtin_amdgcn_mfma_f32_32x32x16_bf16(pa0, ATT_PK(l0, h0), od, 0, 0, 0);
  od = __builtin_amdgcn_mfma_f32_32x32x16_bf16(pa1, ATT_PK(l1, h1), od, 0, 0, 0);
  od = __builtin_amdgcn_mfma_f32_32x32x16_bf16(pa2, ATT_PK(l2, h2), od, 0, 0, 0);
  od = __builtin_amdgcn_mfma_f32_32x32x16_bf16(pa3, ATT_PK(l3, h3), od, 0, 0, 0);
#undef ATT_PK
}
__device__ __forceinline__ void qkt2(f32x16& p0, f32x16& p1, const char* Ks, const int (&kb)[4], const bf16x8* qr, const char* qrl) {
  p0 = f32x16{}; p1 = f32x16{};
#pragma unroll
  for (int d0 = 0; d0 < 8; ++d0) {
    bf16x8 b0 = *reinterpret_cast<const bf16x8*>(Ks + kb[d0 & 3] + (d0 >> 2) * 128);
    bf16x8 b1 = *reinterpret_cast<const bf16x8*>(Ks + kb[d0 & 3] + (d0 >> 2) * 128 + 8192);
    bf16x8 q; if (d0 < NQR2) q = qr[d0]; else q = *reinterpret_cast<const bf16x8*>(qrl + (d0 - NQR2) * 1024);
    p0 = __builtin_amdgcn_mfma_f32_32x32x16_bf16(b0, q, p0, 0, 0, 0);
    p1 = __builtin_amdgcn_mfma_f32_32x32x16_bf16(b1, q, p1, 0, 0, 0); }
}
template <int LDQ, int LDK, int LDV, int LDO, int MODE>
__device__ __forceinline__ void attn_dv256_body(const bf16* __restrict__ Qb, const bf16* __restrict__ Kh, const bf16* __restrict__ Vh, bf16* __restrict__ Ob, float* __restrict__ S1, float lam, const float* __restrict__ subg, float osc,
                                                int seq, char* lds, LAS unsigned char* ldsL, float scale, const bf16* nK = nullptr, const bf16* nV = nullptr, bool have0 = false) {
  const float Cs = scale * 1.4426950408889634f, thr = THR / scale;
  const int tid = threadIdx.x, wid = __builtin_amdgcn_readfirstlane(tid >> 6), lane = tid & 63, r32 = lane & 31, hi = lane >> 5;
  float* ws = (float*)(lds + D2_WS) + wid * 64; float* li_l = ws; float* al_l = ws + 32;
  const char* qrl = lds + D2_Q + wid * (8 - NQR2) * 1024 + lane * 16;
  float m_reg = -1e30f, l_reg = 0; f32x16 o[8] = {}; bf16x8 qr[NQR2 > 0 ? NQR2 : 1];
  { int t1 = threadIdx.x; asm volatile("" : "+v"(t1));
    const int w1 = t1 >> 6, l1 = t1 & 63;
    const bf16* Qw = Qb + (long)(w1 * QBLK + (l1 & 31)) * LDQ + (l1 >> 5) * 8;
    char* ql1 = lds + D2_Q + w1 * (8 - NQR2) * 1024 + l1 * 16;
#pragma unroll
    for (int d0 = 0; d0 < NQR2; ++d0) qr[d0] = *reinterpret_cast<const bf16x8*>(Qw + d0 * 16);
#pragma unroll
    for (int d0 = NQR2; d0 < 8; ++d0) *reinterpret_cast<bf16x8*>(ql1 + (d0 - NQR2) * 1024) = *reinterpret_cast<const bf16x8*>(Qw + d0 * 16); }
  unsigned ko[2], vo[4];
#pragma unroll
  for (int i = 0; i < 2; ++i) { const int ch = (wid * 2 + i) * 64 + lane, row = ch >> 4, cpos = ch & 15; ko[i] = (unsigned)(row * LDK + ((cpos ^ (row & 7)) * 8)) * 2u; }
#pragma unroll
  for (int i = 0; i < 4; ++i) { const int ch = (wid * 4 + i) * 64 + lane, st = ch >> 5, w16 = ch & 31, kk = ((st >> 3) << 3) | (w16 >> 2), k = (kk & ~0xC) | ((kk & 4) << 1) | ((kk & 8) >> 1), col = (st & 7) * 32 + (w16 & 3) * 8;
    vo[i] = (unsigned)(k * LDV + col) * 2u; }
  int kb[4];
#pragma unroll
  for (int k = 0; k < 4; ++k) kb[k] = r32 * 256 + (((hi << 4) ^ ((r32 & 7) << 4)) ^ (k << 5));
  const int vb0 = (int)(uintptr_t)(lds + D2_V) + v_rd_base(lane);
#define D2_DMA(slot, k0) do { const char* kt_ = (const char*)Kh + (size_t)(k0) * (LDK * 2); const char* vt_ = (const char*)Vh + (size_t)(k0) * (LDV * 2); \
    _Pragma("unroll") for (int i_ = 0; i_ < 2; ++i_) __builtin_amdgcn_global_load_lds((const unsigned*)(kt_ + ko[i_]), (LAS unsigned*)(ldsL + D2_K + (slot) * 16384 + (wid * 2 + i_) * 1024), 16, 0, 0); \
    _Pragma("unroll") for (int i_ = 0; i_ < 4; ++i_) __builtin_amdgcn_global_load_lds((const unsigned*)(vt_ + vo[i_]), (LAS unsigned*)(ldsL + D2_V + (slot) * 32768 + (wid * 4 + i_) * 1024), 16, 0, 0); } while (0)
#define D2_DMAN() do { const char* kt_ = (const char*)nKu; const char* vt_ = (const char*)nVu; \
    _Pragma("unroll") for (int i_ = 0; i_ < 2; ++i_) __builtin_amdgcn_global_load_lds((const unsigned*)(kt_ + ko[i_]), (LAS unsigned*)(ldsL + D2_K + (wid * 2 + i_) * 1024), 16, 0, 0); \
    _Pragma("unroll") for (int i_ = 0; i_ < 4; ++i_) __builtin_amdgcn_global_load_lds((const unsigned*)(vt_ + vo[i_]), (LAS unsigned*)(ldsL + D2_V + (wid * 4 + i_) * 1024), 16, 0, 0); } while (0)
#define D2_RESC(a) do { if (__any((a) < 1.f)) { if (hi == 0) al_l[r32] = (a); asm volatile("s_waitcnt lgkmcnt(0)" ::: "memory"); \
    _Pragma("unroll") for (int d = 0; d < 8; ++d) _Pragma("unroll") for (int r = 0; r < 16; ++r) o[d][r] *= al_l[crow(r, hi)]; } } while (0)
#define D2_TILE(slot, jj) do { \
    asm volatile("s_waitcnt vmcnt(0)" ::: "memory"); __builtin_amdgcn_s_barrier(); asm volatile("" ::: "memory");        \
    if ((jj) + 1 < NT) D2_DMA(1 - (slot), ((jj) + 1) * KVBLK); else if ((slot) == 1 && nKu) D2_DMAN(); \
    f32x16 p0, p1; float mn, al; bf16x8 pa0, pa1, pa2, pa3; \
    ATT_SBAR(); qkt2(p0, p1, lds + D2_K + (slot) * 16384, kb, qr, qrl); \
    partialSM(p0, p1, m_reg, mn, al, Cs, thr); D2_RESC(al); \
    finishSM(p0, p1, al, l_reg, pa0, pa1, pa2, pa3); ATT_SBAR(); \
    pv_one2<0, slot>(o[0], vb0, pa0, pa1, pa2, pa3); pv_one2<1, slot>(o[1], vb0, pa0, pa1, pa2, pa3); pv_one2<2, slot>(o[2], vb0, pa0, pa1, pa2, pa3); pv_one2<3, slot>(o[3], vb0, pa0, pa1, pa2, pa3); \
    pv_one2<4, slot>(o[4], vb0, pa0, pa1, pa2, pa3); pv_one2<5, slot>(o[5], vb0, pa0, pa1, pa2, pa3); pv_one2<6, slot>(o[6], vb0, pa0, pa1, pa2, pa3); pv_one2<7, slot>(o[7], vb0, pa0, pa1, pa2, pa3); } while (0)
  const int NT = seq / KVBLK;
  const unsigned long long nKi = (unsigned long long)nK, nVi = (unsigned long long)nV;
  const bf16* nKu = (const bf16*)(((unsigned long long)(unsigned)__builtin_amdgcn_readfirstlane((int)(nKi >> 32)) << 32) | (unsigned)__builtin_amdgcn_readfirstlane((int)nKi));
  const bf16* nVu = (const bf16*)(((unsigned long long)(unsigned)__builtin_amdgcn_readfirstlane((int)(nVi >> 32)) << 32) | (unsigned)__builtin_amdgcn_readfirstlane((int)nVi));
  if (!have0) D2_DMA(0, 0);
  for (int j = 0; j < NT; j += 2) { D2_TILE(0, j); D2_TILE(1, j + 1); }
  if (hi == 0) li_l[r32] = l_reg; asm volatile("s_waitcnt lgkmcnt(0)" ::: "memory");
  { int t2 = threadIdx.x; asm volatile("" : "+v"(t2));
    const int w2 = t2 >> 6, l2 = t2 & 63, r2 = l2 & 31, h2 = l2 >> 5;
    const float* li2 = (const float*)(lds + D2_WS) + w2 * 64;
    float* Sw = S1 + (w2 * QBLK) * 256 + r2;
    if constexpr (MODE == 0) {
#pragma unroll
      for (int r = 0; r < 16; ++r) { const int orow = crow(r, h2); const float rl = __builtin_amdgcn_rcpf(li2[orow]);
#pragma unroll
        for (int d0 = 0; d0 < 8; ++d0) Sw[orow * 256 + d0 * 32] = o[d0][r] * rl; }
    } else {
      bf16* Ow = Ob + (long)(w2 * QBLK) * LDO + r2;
      float sg[8];
#pragma unroll
      for (int d0 = 0; d0 < 8; ++d0) sg[d0] = subg[d0 * 32 + r2] * osc;
#pragma unroll
      for (int r = 0; r < 16; ++r) { const int orow = crow(r, h2); const float rl = __builtin_amdgcn_rcpf(li2[orow]) * lam;
        float dv[8]; float ss = 0.f;
#pragma unroll
        for (int d0 = 0; d0 < 8; ++d0) { dv[d0] = Sw[orow * 256 + d0 * 32] - o[d0][r] * rl; ss += dv[d0] * dv[d0]; }
#pragma unroll
        for (int sh = 1; sh < 32; sh <<= 1) ss += __shfl_xor(ss, sh);
        const float kk = rsqrtf(ss * (1.0f / 256) + EPS);
#pragma unroll
        for (int d0 = 0; d0 < 8; ++d0) Ow[(long)orow * LDO + d0 * 32] = (bf16)::f2bf(dv[d0] * kk * sg[d0]); } } }
  asm volatile("s_waitcnt vmcnt(0) lgkmcnt(0)" ::: "memory"); __builtin_amdgcn_s_barrier(); asm volatile("" ::: "memory");
#undef D2_DMA
#undef D2_DMAN
#undef D2_RESC
#undef D2_TILE
}
}

__device__ __forceinline__ void ph_diff_attn3(const Ctx& C, const bf16* QKV, float* S1g, const float* lq1, const float* lk1, const float* lq2, const float* lk2, const float* subg, float lambda_init, bf16* ON) {
    const float scale = 0.08838834764831845f;
    const int lane = C.lane;
    float d1 = lq1[lane] * lk1[lane] + lq1[lane + 64] * lk1[lane + 64], d2 = lq2[lane] * lk2[lane] + lq2[lane + 64] * lk2[lane + 64];
    d1 = wsum(d1); d2 = wsum(d2);
    const float lam = expf(d1) - expf(d2) + lambda_init, osc = 1.0f - lambda_init;
    float* S1 = S1g + (size_t)C.vcu * 256 * 256;
    constexpr int NLAT = BATCH * DH * (SEQ / 256), NUN = NLAT + BATCH * DH;
    for (int u = C.vcu; u < NUN; u += C.G) {
        const bool isctx = u >= NLAT; const int combo = isctx ? (u - NLAT) : (u >> 5), qb = isctx ? 32 : (u & 31);
        const int h = combo & (DH - 1), b = combo / DH;
        const size_t qrow = (size_t)b * TB + (size_t)qb * 256, krow = (size_t)b * TB + (isctx ? SEQ : 0);
        const att::bf16* Qp = (const att::bf16*)QKV + qrow * NQKV + h * 256; const att::bf16* Kp = (const att::bf16*)QKV + krow * NQKV + 2048 + h * 256; const att::bf16* Vp = (const att::bf16*)QKV + krow * NQKV + 4096 + h * 256;
        const int un = u + C.G; const bool hasn = un < NUN; const bool nctx = un >= NLAT; const int ncombo = nctx ? (un - NLAT) : (un >> 5), nh = ncombo & (DH - 1), nb = ncombo / DH;
        const size_t nkrow = (size_t)nb * TB + (nctx ? SEQ : 0);
        const att::bf16* nKp = hasn ? (const att::bf16*)QKV + nkrow * NQKV + 2048 + nh * 256 : nullptr; const att::bf16* nVp = hasn ? (const att::bf16*)QKV + nkrow * NQKV + 4096 + nh * 256 : nullptr;
        att::attn_dv256_body<NQKV, NQKV, NQKV, 2048, 0>(Qp, Kp, Vp, nullptr, S1, lam, subg, osc, isctx ? CTXL : TB, (char*)C.lds, C.lds, scale, Kp + 128, Vp, u != C.vcu);
        att::attn_dv256_body<NQKV, NQKV, NQKV, 2048, 1>(Qp + 128, Kp + 128, Vp, (att::bf16*)ON + qrow * 2048 + h * 256, S1, lam, subg, osc, isctx ? CTXL : TB, (char*)C.lds, C.lds, scale, nKp, nVp, true);
    }
}

namespace att {
constexpr size_t SHM_K2 = KVBLK * 192 * 2;
constexpr size_t MLA_OFF_K = 2 * SHM_V, MLA_OFF_WS = MLA_OFF_K + 2 * SHM_K2, MLA_OFF_QR = MLA_OFF_WS + NW * 64 * 4, SHM_MLA = MLA_OFF_QR + NW * 4 * 1024;
#define ATT_KSWZ2(row, colB) ((row) * 384 + ((colB) ^ (((row) & 7) << 4)))
constexpr int NQREG = 8;
__device__ __forceinline__ void qkt192(f32x16& p0, f32x16& p1, const char* Ks, const int (&kb)[4], const bf16x8* qr, const char* qrl) {
  p0 = f32x16{}; p1 = f32x16{};
#pragma unroll
  for (int d0 = 0; d0 < 12; ++d0) {
    bf16x8 b0 = *reinterpret_cast<const bf16x8*>(Ks + kb[d0 & 3] + (d0 >> 2) * 128);
    bf16x8 b1 = *reinterpret_cast<const bf16x8*>(Ks + kb[d0 & 3] + (d0 >> 2) * 128 + 32 * 384);
    bf16x8 q; if (d0 < NQREG) q = qr[d0]; else q = *reinterpret_cast<const bf16x8*>(qrl + (d0 - NQREG) * 1024);
    p0 = __builtin_amdgcn_mfma_f32_32x32x16_bf16(b0, q, p0, 0, 0, 0);
    p1 = __builtin_amdgcn_mfma_f32_32x32x16_bf16(b1, q, p1, 0, 0, 0); }
}
template <int LDQ, int LDKN, int LDKR, int LDO>
__device__ __forceinline__ void attn_mla_body(const bf16* __restrict__ Qb, const bf16* __restrict__ Kn, const bf16* __restrict__ Kr, bf16* __restrict__ Ob, int seq, char* lds, float scale) {
  const float Cs = scale * 1.4426950408889634f, thr = THR / scale;
  const int tid = threadIdx.x, wid = tid >> 6, lane = tid & 63, r32 = lane & 31, hi = lane >> 5;
  bf16* V_lds = (bf16*)lds; bf16* K_lds = (bf16*)(lds + MLA_OFF_K);
  float* ws = (float*)(lds + MLA_OFF_WS) + wid * 64; float* li_l = ws; float* al_l = ws + 32;
  char* qrl = lds + MLA_OFF_QR + wid * (12 - NQREG) * 1024 + lane * 16;
  float m_reg = -1e30f, l_reg = 0; f32x16 o[4] = {}; bf16x8 qr[NQREG > 0 ? NQREG : 1];
  { int t1 = threadIdx.x; asm volatile("" : "+v"(t1));
    const int w1 = t1 >> 6, l1 = t1 & 63;
    const bf16* Qw = Qb + (long)(w1 * QBLK + (l1 & 31)) * LDQ + (l1 >> 5) * 8;
    char* ql1 = lds + MLA_OFF_QR + w1 * (12 - NQREG) * 1024 + l1 * 16;
#pragma unroll
    for (int d0 = 0; d0 < NQREG; ++d0) qr[d0] = *reinterpret_cast<const bf16x8*>(Qw + d0 * 16);
#pragma unroll
    for (int d0 = NQREG; d0 < 12; ++d0) *reinterpret_cast<bf16x8*>(ql1 + (d0 - NQREG) * 1024) = *reinterpret_cast<const bf16x8*>(Qw + d0 * 16); }
  const int sr = tid >> 4, sc = (tid & 15) * 8, vst0 = v_st(sr, sc), vst1 = v_st(32 + sr, sc);
  const int r3 = tid >> 3, c3 = (tid & 7) * 8;
  const int vb0 = (int)(uintptr_t)V_lds + v_rd_base(lane);
  struct { bf16x8 vs0, vs1, ks0, ks1, kr; } sr_[2];
  const unsigned oK = (unsigned)(sr * LDKN + sc) * 2u, oR = (unsigned)(r3 * LDKR + c3) * 2u;
  int kb[4];
#pragma unroll
  for (int k = 0; k < 4; ++k) kb[k] = r32 * 384 + (((hi << 4) ^ ((r32 & 7) << 4)) ^ (k << 5));
#define SLOAD(i, k0) do { const char* kt_ = (const char*)Kn + (size_t)(k0) * (LDKN * 2); const char* rt_ = (const char*)Kr + (size_t)(k0) * (LDKR * 2); \
    sr_[i].vs0 = *reinterpret_cast<const bf16x8*>(kt_ + oK + 256); sr_[i].vs1 = *reinterpret_cast<const bf16x8*>(kt_ + (size_t)32 * LDKN * 2 + oK + 256); \
    sr_[i].ks0 = *reinterpret_cast<const bf16x8*>(kt_ + oK); sr_[i].ks1 = *reinterpret_cast<const bf16x8*>(kt_ + (size_t)32 * LDKN * 2 + oK); \
    sr_[i].kr = *reinterpret_cast<const bf16x8*>(rt_ + oR); } while (0)
#define SWRITE(b, i) do { *(bf16x8*)((char*)V_lds + (b) * SHM_V + vst0) = sr_[i].vs0;          \
    *(bf16x8*)((char*)V_lds + (b) * SHM_V + vst1) = sr_[i].vs1; int kc = sc * 2;               \
    *(bf16x8*)((char*)K_lds + (b) * SHM_K2 + ATT_KSWZ2(sr, kc)) = sr_[i].ks0;                       \
    *(bf16x8*)((char*)K_lds + (b) * SHM_K2 + ATT_KSWZ2(32 + sr, kc)) = sr_[i].ks1;                  \
    *(bf16x8*)((char*)K_lds + (b) * SHM_K2 + ATT_KSWZ2(r3, 256 + c3 * 2)) = sr_[i].kr; } while (0)
#define SWAIT() asm volatile("s_waitcnt vmcnt(5)" ::: "memory")
#define RESC(a) do { if (__any((a) < 1.f)) { if (hi == 0) al_l[r32] = (a); asm volatile("s_waitcnt lgkmcnt(0)" ::: "memory"); \
    _Pragma("unroll") for (int d = 0; d < 4; ++d) _Pragma("unroll") for (int r = 0; r < 16; ++r) o[d][r] *= al_l[crow(r, hi)]; } } while (0)
  f32x16 pA0, pA1, pB0, pB1; float mnA, mnB, alA, alB; bf16x8 pa0, pa1, pa2, pa3; const int NT = seq / KVBLK;
  constexpr int SE = 0, SO = 1;
  SLOAD(SE, 0); asm volatile("s_waitcnt vmcnt(0)" ::: "memory"); SWRITE(0, SE); __syncthreads();
  qkt192(pA0, pA1, (const char*)K_lds, kb, qr, qrl); partialSM(pA0, pA1, m_reg, mnA, alA, Cs, thr);
  SLOAD(SO, KVBLK); if (2 < NT) SLOAD(SE, 2 * KVBLK);
  SWAIT(); SWRITE(1, SO); __syncthreads();
  for (int j = 1; j + 1 < NT; j += 2) {
    ATT_SBAR(); qkt192(pB0, pB1, (const char*)K_lds + SHM_K2, kb, qr, qrl);
    finishSM(pA0, pA1, alA, l_reg, pa0, pa1, pa2, pa3); ATT_SBAR();
    SLOAD(SO, (j + 2) * KVBLK); ATT_SBAR();
    pv_d0(o, vb0, pa0, pa1, pa2, pa3); partialSM(pB0, pB1, m_reg, mnB, alB, Cs, thr);
    __syncthreads(); SWAIT(); SWRITE(0, SE);
    RESC(alB); __syncthreads();
    ATT_SBAR(); qkt192(pA0, pA1, (const char*)K_lds, kb, qr, qrl);
    finishSM(pB0, pB1, alB, l_reg, pa0, pa1, pa2, pa3); ATT_SBAR();
    if (j + 3 < NT) SLOAD(SE, (j + 3) * KVBLK); ATT_SBAR();
    pv_d0(o, vb0 + (int)SHM_V, pa0, pa1, pa2, pa3); partialSM(pA0, pA1, m_reg, mnA, alA, Cs, thr);
    __syncthreads(); SWAIT(); SWRITE(1, SO);
    RESC(alA); __syncthreads();
  }
  ATT_SBAR(); qkt192(pB0, pB1, (const char*)K_lds + SHM_K2, kb, qr, qrl);
  finishSM(pA0, pA1, alA, l_reg, pa0, pa1, pa2, pa3); ATT_SBAR();
  pv_d0(o, vb0, pa0, pa1, pa2, pa3); partialSM(pB0, pB1, m_reg, mnB, alB, Cs, thr);
  __syncthreads(); RESC(alB);
  finishSM(pB0, pB1, alB, l_reg, pa0, pa1, pa2, pa3); ATT_SBAR();
  pv_d0(o, vb0 + (int)SHM_V, pa0, pa1, pa2, pa3);
  if (hi == 0) li_l[r32] = l_reg; asm volatile("s_waitcnt lgkmcnt(0)" ::: "memory");
  {
    int t2 = threadIdx.x; asm volatile("" : "+v"(t2));
    const int w2 = t2 >> 6, l2 = t2 & 63, r2 = l2 & 31, h2 = l2 >> 5;
    const float* li2 = (const float*)(lds + MLA_OFF_WS) + w2 * 64;
    bf16* Ow = Ob + (long)(w2 * QBLK) * LDO + r2;
#pragma unroll
    for (int r = 0; r < 16; ++r) { const int orow = crow(r, h2); const float rl = __builtin_amdgcn_rcpf(li2[orow]);
#pragma unroll
      for (int d0 = 0; d0 < 4; ++d0) Ow[(long)orow * LDO + d0 * 32] = (bf16)::f2bf(o[d0][r] * rl); } }
  asm volatile("s_waitcnt vmcnt(0) lgkmcnt(0)" ::: "memory"); __syncthreads();
#undef SLOAD
#undef SWRITE
#undef SWAIT
#undef RESC
}
}

namespace pg8 {
struct EpiF32Store {
    static constexpr bool PERM = false, AFTER_DRAIN = false;
    float* Cc; int ldc; float* part;
    __device__ __forceinline__ void quad(const f32x4 (&a)[4][2], const Unit& u, int ai, int bj, int wr, int wc, int fr, int fq) const {
        const int row0 = u.pm * BM + ai * HALF + wr * 64 + fr, col0 = u.pn * BM + bj * HALF + wc * 32 + 4 * fq;
#pragma unroll
        for (int m = 0; m < 4; ++m) { float* rowp = Cc + (size_t)(row0 + m * 16) * ldc + col0; *(f32x4*)rowp = a[m][0]; *(f32x4*)(rowp + 16) = a[m][1]; }
    }
    __device__ __forceinline__ void quad_part(const f32x4 (&a)[4][2], const Unit& u, int ai, int bj, int sp, int pc, int wr, int wc, int fr, int fq) const {
        const int col0 = u.pn * BM + bj * HALF + wc * 32 + 4 * fq, rl0 = pc * BM + ai * HALF + wr * 64 + fr;
#pragma unroll
        for (int m = 0; m < 4; ++m) { float* rowp = part + ((size_t)sp * 512 + rl0 + m * 16) * ldc + col0; *(f32x4*)rowp = a[m][0]; *(f32x4*)(rowp + 16) = a[m][1]; }
    }
    __device__ __forceinline__ void operator()(const f32x4 (&acc)[2][2][4][2], const Unit& u, int wr, int wc, int fr, int fq) const {
#pragma unroll
        for (int ai = 0; ai < 2; ++ai)
#pragma unroll
            for (int bj = 0; bj < 2; ++bj) quad(acc[ai][bj], u, ai, bj, wr, wc, fr, fq);
    }
};
struct EpiMlaDown {
    static constexpr bool PERM = false, AFTER_DRAIN = true;
    float* part; const float* gq; const float* gkv; const float* tab; bf16_t* CQn; bf16_t* CKVn; bf16_t* KR; float* slots; unsigned* cnt; unsigned* tmo;
    __device__ __forceinline__ void fused(f32x4 (&acc)[2][2][4][2], const Unit& u, int wr, int wc, int fr, int fq, PG8_LAS unsigned char* lds, int wid, int lane) const {
        PG8_LAS float* P = (PG8_LAS float*)lds;
        PG8_LAS float* S = (PG8_LAS float*)(lds + 8192);
        PG8_LAS unsigned char* stg = lds + 12288;
#pragma unroll
        for (int ai = 0; ai < 2; ++ai)
#pragma unroll
            for (int m = 0; m < 4; ++m)
#pragma unroll
                for (int bj = 0; bj < 2; ++bj) { const f32x4 a0 = acc[ai][bj][m][0], a1 = acc[ai][bj][m][1];
                    float q = (a0[0] * a0[0] + a0[1] * a0[1]) + (a0[2] * a0[2] + a0[3] * a0[3]) + (a1[0] * a1[0] + a1[1] * a1[1]) + (a1[2] * a1[2] + a1[3] * a1[3]);
                    q += __shfl_xor(q, 16); q += __shfl_xor(q, 32);
                    if (fq == 0) P[(ai * HALF + wr * 64 + m * 16 + fr) * 8 + bj * 4 + wc] = q; }
        asm volatile("s_waitcnt lgkmcnt(0)" ::: "memory"); __builtin_amdgcn_s_barrier(); asm volatile("" ::: "memory");
        const int row = wid * 32 + (lane & 31);
        if (lane < 32) { float tq = 0.f, tkv = 0.f;
#pragma unroll
            for (int s8 = 0; s8 < 8; ++s8) { const int ci = u.pn * 8 + s8; const float v = P[row * 8 + s8]; if (ci < 14) tq += v; else if (ci < 30) tkv += v; }
            unsigned* sl = (unsigned*)slots + ((size_t)(u.pm * BM + row) * 8 + u.pn * 2);
            __hip_atomic_store(sl, __float_as_uint(tq), __ATOMIC_RELAXED, __HIP_MEMORY_SCOPE_AGENT); __hip_atomic_store(sl + 1, __float_as_uint(tkv), __ATOMIC_RELAXED, __HIP_MEMORY_SCOPE_AGENT); }
        asm volatile("s_waitcnt vmcnt(0)" ::: "memory");
        if (lane == 0) __hip_atomic_fetch_add(cnt + 64 * u.pm, 1u, __ATOMIC_RELAXED, __HIP_MEMORY_SCOPE_AGENT);
        if (wid == 0) { unsigned sp = 0;
            for (;;) { if ((unsigned)__builtin_amdgcn_readfirstlane(__hip_atomic_load(cnt + 64 * u.pm, __ATOMIC_RELAXED, __HIP_MEMORY_SCOPE_AGENT)) >= 32u) break;
                __builtin_amdgcn_s_sleep(2);
                if (++sp > (1u << 18)) { if (lane == 0) __hip_atomic_store(tmo, 1u, __ATOMIC_RELAXED, __HIP_MEMORY_SCOPE_AGENT); break; } }
            __builtin_amdgcn_fence(__ATOMIC_ACQUIRE, "agent"); }
        asm volatile("s_waitcnt vmcnt(0) lgkmcnt(0)" ::: "memory"); __builtin_amdgcn_s_barrier(); asm volatile("" ::: "memory");
        if (lane < 32) { const unsigned* sl = (const unsigned*)slots + (size_t)(u.pm * BM + row) * 8; float tq = 0.f, tkv = 0.f;
#pragma unroll
            for (int k = 0; k < 4; ++k) { tq += __uint_as_float(__hip_atomic_load(sl + 2 * k, __ATOMIC_RELAXED, __HIP_MEMORY_SCOPE_AGENT)); tkv += __uint_as_float(__hip_atomic_load(sl + 2 * k + 1, __ATOMIC_RELAXED, __HIP_MEMORY_SCOPE_AGENT)); }
            S[row * 2] = rsqrtf(tq * (1.0f / MQR) + EPS); S[row * 2 + 1] = rsqrtf(tkv * (1.0f / MKVR) + EPS); }
        asm volatile("s_waitcnt vmcnt(0) lgkmcnt(0)" ::: "memory"); __builtin_amdgcn_s_barrier(); asm volatile("" ::: "memory");
#pragma unroll
        for (int bj = 0; bj < 2; ++bj) { const int ci = u.pn * 8 + bj * 4 + wc, cg = ci * 32 + 4 * fq;
            if (ci < 30) { const bool isq = ci < 14; const float* gp = isq ? gq + cg : gkv + (cg - MQR);
                const f32x4 g0 = *(const f32x4*)gp, g1 = *(const f32x4*)(gp + 16);
#pragma unroll
                for (int ai = 0; ai < 2; ++ai)
#pragma unroll
                    for (int m = 0; m < 4; ++m) { const int r = ai * HALF + wr * 64 + m * 16 + fr; const float rs = S[r * 2 + (isq ? 0 : 1)];
                        const f32x4 y0 = acc[ai][bj][m][0] * rs * g0, y1 = acc[ai][bj][m][1] * rs * g1;
                        PG8_LAS unsigned char* d = stg + r * 528 + (bj * HALF + wc * 32 + 4 * fq) * 2;
                        *(PG8_LAS unsigned long long*)d = (unsigned long long)cvt_pk_bf16(y0[0], y0[1]) | ((unsigned long long)cvt_pk_bf16(y0[2], y0[3]) << 32);
                        *(PG8_LAS unsigned long long*)(d + 32) = (unsigned long long)cvt_pk_bf16(y1[0], y1[1]) | ((unsigned long long)cvt_pk_bf16(y1[2], y1[3]) << 32); }
            } else { const int half = ci - 30;
#pragma unroll
                for (int ai = 0; ai < 2; ++ai)
#pragma unroll
                    for (int m = 0; m < 4; ++m) { const int r = ai * HALF + wr * 64 + m * 16 + fr, t = (u.pm * BM + r) % TB, pos = half ? (t % GRID_W) : (t / GRID_W);
                        const f32x4 cs = *(const f32x4*)(tab + 8192 + pos * 16 + 4 * fq), sn = *(const f32x4*)(tab + 8192 + 2048 + pos * 16 + 4 * fq);
                        const f32x4 lo = acc[ai][bj][m][0], hi = acc[ai][bj][m][1]; const f32x4 ylo = lo * cs - hi * sn, yhi = hi * cs + lo * sn;
                        u32x4 w; w.x = cvt_pk_bf16(ylo[0], yhi[0]); w.y = cvt_pk_bf16(ylo[1], yhi[1]); w.z = cvt_pk_bf16(ylo[2], yhi[2]); w.w = cvt_pk_bf16(ylo[3], yhi[3]);
                        *(PG8_LAS u32x4*)(stg + r * 528 + (bj * HALF + wc * 32 + 8 * fq) * 2) = w; }
            } }
        asm volatile("s_waitcnt lgkmcnt(0)" ::: "memory"); __builtin_amdgcn_s_barrier(); asm volatile("" ::: "memory");
        const int tid = wid * 64 + lane;
#pragma unroll
        for (int it = 0; it < 16; ++it) { const int p = it * 512 + tid, r = p >> 5, ch = p & 31, c = u.pn * BM + ch * 8; const size_t grow = (size_t)(u.pm * BM + r);
            const u32x4 v = *(const PG8_LAS u32x4*)(stg + r * 528 + ch * 16);
            if (c < MQR) *(u32x4*)(CQn + grow * 512 + c) = v;
            else if (c < MQR + MKVR) { *(u32x4*)(CKVn + grow * 512 + (c - MQR)) = v; if (c < 512) *(u32x4*)(CQn + grow * 512 + c) = (u32x4){0u, 0u, 0u, 0u}; }
            else *(u32x4*)(KR + grow * 64 + (c - MQR - MKVR)) = v; }
        asm volatile("s_waitcnt lgkmcnt(0)" ::: "memory"); __builtin_amdgcn_s_barrier(); asm volatile("" ::: "memory");
    }
    __device__ __forceinline__ void quad(const f32x4 (&)[4][2], const Unit&, int, int, int, int, int, int) const {}
    __device__ __forceinline__ void quad_part(const f32x4 (&a)[4][2], const Unit& u, int ai, int bj, int sp, int pc, int wr, int wc, int fr, int fq) const {
        const int col0 = u.pn * BM + bj * HALF + wc * 32 + 4 * fq, rl0 = pc * BM + ai * HALF + wr * 64 + fr;
#pragma unroll
        for (int m = 0; m < 4; ++m) { float* rowp = part + ((size_t)sp * 512 + rl0 + m * 16) * 1024 + col0; *(f32x4*)rowp = a[m][0]; *(f32x4*)(rowp + 16) = a[m][1]; }
    }
};
struct EpiMlaQ {
    static constexpr bool PERM = true, AFTER_DRAIN = false;
    bf16_t* O; PG8_LAS const float* tl;
    __device__ __forceinline__ void quad(const f32x4 (&a)[4][2], const Unit& u, int ai, int bj, int wr, int wc, int fr, int fq) const {
        const int row0 = u.pm * BM + ai * HALF + wr * 64 + fr, col0 = u.pn * BM + bj * HALF + wc * 32 + 8 * fq;
        const int hd = col0 % 192, e0 = hd - 128; const bool rope = hd >= 128; const int half = (e0 >> 5) & 1, f0 = (e0 & 31) >> 1;
#pragma unroll
        for (int m = 0; m < 4; ++m) { const int row = row0 + m * 16, t = row % TB; const f32x4 v0 = a[m][0], v1 = a[m][1];
            f32x4 cs = {1.f, 1.f, 1.f, 1.f}, sn = {0.f, 0.f, 0.f, 0.f};
            if (rope) { const int pos = half ? (t % GRID_W) : (t / GRID_W); cs = *(PG8_LAS const f32x4*)(tl + pos * 16 + f0); sn = *(PG8_LAS const f32x4*)(tl + 2048 + pos * 16 + f0); }
            const float a0 = v0[0] * cs[0] - v0[1] * sn[0], b0 = v0[1] * cs[0] + v0[0] * sn[0], a1 = v0[2] * cs[1] - v0[3] * sn[1], b1 = v0[3] * cs[1] + v0[2] * sn[1];
            const float a2 = v1[0] * cs[2] - v1[1] * sn[2], b2 = v1[1] * cs[2] + v1[0] * sn[2], a3 = v1[2] * cs[3] - v1[3] * sn[3], b3 = v1[3] * cs[3] + v1[2] * sn[3];
            u32x4 w; w.x = cvt_pk_bf16(a0, b0); w.y = cvt_pk_bf16(a1, b1); w.z = cvt_pk_bf16(a2, b2); w.w = cvt_pk_bf16(a3, b3);
            *(u32x4*)(O + (size_t)row * 3072 + col0) = w; }
    }
    __device__ __forceinline__ void operator()(const f32x4 (&acc)[2][2][4][2], const Unit& u, int wr, int wc, int fr, int fq) const {
#pragma unroll
        for (int ai = 0; ai < 2; ++ai)
#pragma unroll
            for (int bj = 0; bj < 2; ++bj) quad(acc[ai][bj], u, ai, bj, wr, wc, fr, fq);
    }
};
}

__device__ __forceinline__ void ph_mla_mid(const Ctx& C, const float* Cf, const float* part, const float* qg, const float* kvg, const float* tab, bf16* CQn, bf16* CKVn, bf16* KR, int ctx_only = 0, unsigned* pub = nullptr) {
    const int gw = C.vcu * 8 + C.wave, NGW = C.G * 8, lane = C.lane;
    float qgr[7], kvgr[8];
#pragma unroll
    for (int j = 0; j < 7; ++j) qgr[j] = qg[j * 64 + lane];
#pragma unroll
    for (int j = 0; j < 8; ++j) kvgr[j] = kvg[j * 64 + lane];
    for (int i = gw; i < (ctx_only ? BATCH * CTXL : NR); i += NGW) {
        const int r = ctx_only ? (i / CTXL) * TB + SEQ + i % CTXL : i;
        const int tt = r % TB; const bool isctx = tt >= SEQ;
        const float* cr = isctx ? part + ((size_t)(r / TB) * CTXL + (tt - SEQ)) * 1024 : Cf + (size_t)r * 1024;
        float q[7], kv[8]; float sq = 0.f, sk = 0.f; float x;
        if (isctx) {
#pragma unroll
            for (int j = 0; j < 7; ++j) q[j] = (cr[j * 64 + lane] + cr[512 * 1024 + j * 64 + lane]) + (cr[2 * 512 * 1024 + j * 64 + lane] + cr[3 * 512 * 1024 + j * 64 + lane]);
#pragma unroll
            for (int j = 0; j < 8; ++j) kv[j] = (cr[448 + j * 64 + lane] + cr[512 * 1024 + 448 + j * 64 + lane]) + (cr[2 * 512 * 1024 + 448 + j * 64 + lane] + cr[3 * 512 * 1024 + 448 + j * 64 + lane]);
            x = (cr[960 + lane] + cr[512 * 1024 + 960 + lane]) + (cr[2 * 512 * 1024 + 960 + lane] + cr[3 * 512 * 1024 + 960 + lane]);
        } else {
#pragma unroll
            for (int j = 0; j < 7; ++j) q[j] = cr[j * 64 + lane];
#pragma unroll
            for (int j = 0; j < 8; ++j) kv[j] = cr[448 + j * 64 + lane];
            x = cr[960 + lane];
        }
#pragma unroll
        for (int j = 0; j < 7; ++j) sq += q[j] * q[j];
#pragma unroll
        for (int j = 0; j < 8; ++j) sk += kv[j] * kv[j];
        const float rq = rsqrtf(wsum(sq) * (1.0f / 448) + EPS), rk = rsqrtf(wsum(sk) * (1.0f / 512) + EPS);
#pragma unroll
        for (int j = 0; j < 7; ++j) CQn[(size_t)r * 512 + j * 64 + lane] = (bf16)f2bf(q[j] * rq * qgr[j]);
        CQn[(size_t)r * 512 + 448 + lane] = (bf16)0;
#pragma unroll
        for (int j = 0; j < 8; ++j) { const unsigned me = f2bf(kv[j] * rk * kvgr[j]);
            if (pub) { const unsigned nb = (unsigned)__shfl_xor((int)me, 1); if ((lane & 1) == 0) __hip_atomic_store((unsigned*)(CKVn + (size_t)r * 512 + j * 64 + lane), me | (nb << 16), __ATOMIC_RELAXED, __HIP_MEMORY_SCOPE_AGENT); }
            else CKVn[(size_t)r * 512 + j * 64 + lane] = (bf16)me; }
        const int t = r % TB, half = lane >> 5, dd = lane & 31, f = dd & 15;
        const float xp = __shfl_xor(x, 16);
        float y = x;
        if (t < SEQ) { const int pos = half ? (t % GRID_W) : (t / GRID_W); const float cs = tab[8192 + pos * 16 + f], sn = tab[8192 + 2048 + pos * 16 + f];
            y = (dd < 16) ? (x * cs - xp * sn) : (x * cs + xp * sn); }
        const int np = (dd < 16) ? 2 * dd : 2 * (dd - 16) + 1;
        KR[(size_t)r * 64 + half * 32 + np] = (bf16)f2bf(y);
    }
    if (pub) { asm volatile("s_waitcnt vmcnt(0)" ::: "memory"); if (lane == 0) __hip_atomic_fetch_add(pub, 1u, __ATOMIC_RELAXED, __HIP_MEMORY_SCOPE_AGENT); }
}
__device__ __forceinline__ void ph_mla_attn(const Ctx& C, const bf16* Qm, const bf16* KVm, const bf16* KRm, bf16* OM) {
    const float scale = 0.07216878364870323f;
    constexpr int NUN = BATCH * MH * (SEQ / 256);
    for (int u = C.vcu; u < NUN; u += C.G) {
        const int combo = u >> 5, qb = u & 31, h = combo & 15, b = combo >> 4;
        const size_t qrow = (size_t)b * TB + (size_t)qb * 256, krow = (size_t)b * TB;
        att::attn_mla_body<3072, 4096, 64, 2048>((const att::bf16*)Qm + qrow * 3072 + h * 192, (const att::bf16*)KVm + krow * 4096 + h * 256, (const att::bf16*)KRm + krow * 64,
            (att::bf16*)OM + qrow * 2048 + h * 128, TB, (char*)C.lds, scale);
    }
}
static_assert(att::SHM_D2 <= RING_BYTES && att::SHM_MLA <= (size_t)RING_BYTES && att::SHM_ATTN <= (size_t)RING_BYTES, "attention LDS images fit below the control words");

#define PH(l, s) (1 + 10 * (l) + (s))
#ifndef GEMM_ALIGN
#define GEMM_ALIGN false
#define GEMM_SP2 true
#endif
constexpr int PH_FINAL = 41, PH_END = 42;

__global__ void __launch_bounds__(512, 2) mega(Args args) {
    extern __shared__ __attribute__((aligned(16))) unsigned char lds_raw[];
    Ctx C; C.lds = (LAS unsigned char*)lds_raw; C.tid = threadIdx.x; C.lane = C.tid & 63; C.wave = __builtin_amdgcn_readfirstlane(C.tid >> 6);
    C.G = gridDim.x; { const int bx = blockIdx.x; C.vcu = (C.G % 8 == 0) ? (bx % 8) * (C.G / 8) + bx / 8 : bx; }
    volatile LAS unsigned* MISC = (volatile LAS unsigned*)(C.lds + MISC_OFF);
    for (int u = C.tid; u < (LDS_BYTES - LDSCTL_OFF) / 4; u += 512) ((LAS unsigned*)(C.lds + LDSCTL_OFF))[u] = 0u;
    __syncthreads();
    unsigned char* ws = args.ws;
    XcdBarrier bar = xcd_barrier_post((unsigned*)(ws + WS_CTL) + CW_BAR + args.li * XCD_BAR_WORDS, MISC + 8);
    const int lo = args.ph_lo, hi = args.ph_hi; bool started = false;
#define PHASE_BEGIN(k) if (lo <= (k) && (k) < hi) { if (started) xcd_barrier(bar); started = true;
#define PHASE_END }
    float* X = (float*)(ws + WS_X); const float* mod = (const float*)(ws + WS_MOD);
    const pg8::bf16_t* WB = (const pg8::bf16_t*)(ws + WS_WB);
    bf16* XNb = (bf16*)(ws + FA_XN); bf16* Hb = (bf16*)(ws + FA_H);
    float* PARTf = (float*)(ws + FA_B + 136 * MiB);
    float* SLOTf = (float*)(ws + FA_B + 120 * MiB); unsigned* CNTw = (unsigned*)(ws + WS_CTL) + 131072; unsigned* TMOw = CNTw - 64;
    const bool fuse = (C.G == 256);
    unsigned* CTXC = CNTw + 9 * 66 * 64;
#define FUSED_RES(Aop, Wop, Kdim, gatep, ngp, nmodp, gid, xinp, CTX) { pg8::Gemm g{Aop, Wop, NR, D, Kdim}; \
        pg8::EpiResNorm E{X, gatep, ngp, nmodp, (pg8::bf16_t*)XNb, args.out, SLOTf, CNTw + (gid) * 66 * 64, TMOw, xinp, PARTf}; \
        pg8::SliceOrder S0{(int)blockIdx.x, 0, C.G}; pg8::gemm_phase<pg8::EpiResNorm, pg8::SliceOrder, GEMM_ALIGN, GEMM_SP2>(C.lds, g, S0, E); __syncthreads(); \
        pg8::SliceOrder S1{(int)blockIdx.x, 1, C.G}; pg8::gemm_phase<pg8::EpiResNorm, pg8::SliceOrder, GEMM_ALIGN, GEMM_SP2, (CTX), ((CTX) ? 4 : 1)>(C.lds, g, S1, E); }

    PHASE_BEGIN(0) ph_prologue(args, C, fuse ? CTXC + 6 * 64 : (unsigned*)nullptr);
        if (fuse) { if (C.wave == 0) { unsigned sp_ = 0; const unsigned want_ = (unsigned)C.G * 8u;
                for (;;) { if ((unsigned)__builtin_amdgcn_readfirstlane(__hip_atomic_load(CTXC + 6 * 64, __ATOMIC_RELAXED, __HIP_MEMORY_SCOPE_AGENT)) >= want_) break; __builtin_amdgcn_s_sleep(2); if (++sp_ > (1u << 20)) break; }
                __builtin_amdgcn_fence(__ATOMIC_ACQUIRE, "agent"); asm volatile("s_waitcnt vmcnt(0)" ::: "memory"); }
            __syncthreads();
            ph_norm(C, X, args.in[I_N1G], mod, 0, XNb, 0, args.in[I_X], args.in[I_CTX]); }
    PHASE_END

#define FFN_PHASES(l) \
    if (!fuse) { PHASE_BEGIN(PH(l, 6)) ph_norm(C, X, args.in[I_N2G] + (size_t)(l) * D, mod + (size_t)(l) * 3 * MODW, 1, XNb, (l) >= 2, nullptr, (l) == 0 ? args.in[I_CTX] : nullptr, (l) < 2 ? PARTf : nullptr, 4, 0); PHASE_END } \
    PHASE_BEGIN(PH(l, 7)) { pg8::Gemm g{XNb, WB + WB_FF1 + (size_t)(l) * D * DFF, NR, DFF, D}; \
        if (fuse && (l) < 2) { ph_norm(C, X, args.in[I_N2G] + (size_t)(l) * D, mod + (size_t)(l) * 3 * MODW, 1, XNb, 0, nullptr, (l) == 0 ? args.in[I_CTX] : nullptr, PARTf, 4, 2, CTXC + (l) * 64); g.ctxcnt = CTXC + (l) * 64; g.ctxwant = (unsigned)C.G * 8u; }     \
        pg8::StaticOrder S; S.init(BATCH * SEQ, DFF, C.G, (int)blockIdx.x, 1); \
        pg8::EpiAct<2> E{Hb, DFF}; pg8::gemm_phase<pg8::EpiAct<2>, pg8::StaticOrder, GEMM_ALIGN, GEMM_SP2, ((l) < 2)>(C.lds, g, S, E); } PHASE_END \
    PHASE_BEGIN(PH(l, 8)) if (fuse) FUSED_RES(Hb, WB + WB_FF2 + (size_t)(l) * D * DFF, DFF, mod + (size_t)(l) * 3 * MODW + 5 * D, (l) == 3 ? args.in[I_FING] : args.in[I_N1G] + (size_t)((l) + 1) * D, (l) == 3 ? (const float*)nullptr : mod + (size_t)((l) + 1) * 3 * MODW, 4 + (l), (const float*)nullptr, ((l) < 2)) \
        else { pg8::Gemm g{Hb, WB + WB_FF2 + (size_t)(l) * D * DFF, NR, D, DFF}; pg8::StaticOrder S; S.init(BATCH * SEQ, D, C.G, (int)blockIdx.x, 1); \
        pg8::EpiRes E{X, mod + (size_t)(l) * 3 * MODW + 5 * D, nullptr, nullptr, PARTf};  pg8::gemm_phase<pg8::EpiRes, pg8::StaticOrder, GEMM_ALIGN, GEMM_SP2, ((l) < 2), 4>(C.lds, g, S, E); } PHASE_END

    bf16* Zb = (bf16*)(ws + FA_H); bf16* Gb = XNb; float* STf = (float*)(ws + FA_B);
#define GMLP_PHASES(l, idx) \
    if (!fuse) { PHASE_BEGIN(PH(l, 0)) ph_norm(C, X, args.in[I_N1G] + (size_t)(l) * D, mod + (size_t)(l) * 3 * MODW, 0, XNb, (l) == 3, (l) == 0 ? args.in[I_X] : nullptr, (l) == 0 ? args.in[I_CTX] : nullptr); PHASE_END } \
    PHASE_BEGIN(PH(l, 1)) { pg8::Gemm g{XNb, WB + WB_AWIN + (size_t)(idx) * D * 4096, NR, 4096, D}; pg8::StaticOrder S; S.init(BATCH * SEQ, 4096, C.G, (int)blockIdx.x, 1); \
        { LAS float* bl_ = (LAS float*)(C.lds + 131072); const float* bs_ = args.in[I_ABIN] + (size_t)(idx) * 4096; for (int i_ = C.tid; i_ < 4096; i_ += 512) bl_[i_] = bs_[i_]; } __syncthreads();     \
        pg8::EpiGeluStats E{Zb, (LAS const float*)(C.lds + 131072), STf}; pg8::gemm_phase<pg8::EpiGeluStats, pg8::StaticOrder, GEMM_ALIGN, GEMM_SP2, ((l) != 3)>(C.lds, g, S, E); } PHASE_END \
    PHASE_BEGIN(PH(l, 2)) ph_gmlp_spatial(C, Zb, STf, args.in[I_ALNG] + (size_t)(idx) * GW, (const bf16*)WB + WB_AWS + (size_t)(idx) * GG * 128 * 128, args.in[I_ABS] + (size_t)(idx) * GG * CHUNK, Gb, (l) == 3); PHASE_END \
    PHASE_BEGIN(PH(l, 3)) if (fuse) FUSED_RES(Gb, WB + WB_AWOUT + (size_t)(idx) * D * D, GW, mod + (size_t)(l) * 3 * MODW + 2 * D, args.in[I_N2G] + (size_t)(l) * D, mod + (size_t)(l) * 3 * MODW + 3 * D, (l), (l) == 0 ? args.in[I_X] : (const float*)nullptr, ((l) != 3)) \
        else { pg8::Gemm g{Gb, WB + WB_AWOUT + (size_t)(idx) * D * D, NR, D, GW}; pg8::StaticOrder S; S.init(BATCH * SEQ, D, C.G, (int)blockIdx.x, 1); \
        pg8::EpiRes E{X, mod + (size_t)(l) * 3 * MODW + 2 * D, (l) == 0 ? args.in[I_X] : nullptr, (l) == 0 ? args.in[I_CTX] : nullptr, PARTf};  pg8::gemm_phase<pg8::EpiRes, pg8::StaticOrder, GEMM_ALIGN, GEMM_SP2, ((l) != 3), 4>(C.lds, g, S, E); } PHASE_END

    bf16* QKVb = (bf16*)(ws + FA_H); bf16* Of = (bf16*)(ws + FA_B); const float* tab = (const float*)(ws + WS_ROPE);
#define DIFF_PHASES(l, idx) \
    if (!fuse) { PHASE_BEGIN(PH(l, 0)) ph_norm(C, X, args.in[I_N1G] + (size_t)(l) * D, mod + (size_t)(l) * 3 * MODW, 0, XNb, 0, nullptr, nullptr, PARTf, 4, 0); PHASE_END } \
    PHASE_BEGIN(PH(l, 1)) { pg8::Gemm g{XNb, WB + WB_BQKV, NR, NQKV, D}; \
        if (fuse) { ph_norm(C, X, args.in[I_N1G] + (size_t)(l) * D, mod + (size_t)(l) * 3 * MODW, 0, XNb, 0, nullptr, nullptr, PARTf, 4, 2, CTXC + (2 + (l)) * 64); g.ctxcnt = CTXC + (2 + (l)) * 64; g.ctxwant = (unsigned)C.G * 8u; } \
        pg8::StaticOrder S; S.init(BATCH * SEQ, NQKV, C.G, (int)blockIdx.x, 1); \
        { LAS _Float16* tl_ = (LAS _Float16*)(C.lds + 131072); for (int i_ = C.tid; i_ < 8192; i_ += 512) tl_[i_] = (_Float16)tab[i_]; } __syncthreads();     \
        pg8::EpiQkvRope E{QKVb, tab, (LAS const _Float16*)(C.lds + 131072)}; pg8::gemm_phase<pg8::EpiQkvRope, pg8::StaticOrder, GEMM_ALIGN, GEMM_SP2, true>(C.lds, g, S, E); } PHASE_END \
    PHASE_BEGIN(PH(l, 2)) ph_diff_attn3(C, QKVb, (float*)Of, args.in[I_BLQ1], args.in[I_BLK1], args.in[I_BLQ2], args.in[I_BLK2], args.in[I_BSUBG], 0.35550906759097f, XNb); PHASE_END \
    PHASE_BEGIN(PH(l, 4)) if (fuse) FUSED_RES(XNb, WB + WB_BWO, 2048, mod + (size_t)(l) * 3 * MODW + 2 * D, args.in[I_N2G] + (size_t)(l) * D, mod + (size_t)(l) * 3 * MODW + 3 * D, (l), (const float*)nullptr, true) \
        else { pg8::Gemm g{XNb, WB + WB_BWO, NR, D, 2048}; pg8::StaticOrder S; S.init(BATCH * SEQ, D, C.G, (int)blockIdx.x, 1); \
        pg8::EpiRes E{X, mod + (size_t)(l) * 3 * MODW + 2 * D, nullptr, nullptr, PARTf};  pg8::gemm_phase<pg8::EpiRes, pg8::StaticOrder, GEMM_ALIGN, GEMM_SP2, true, 4>(C.lds, g, S, E); } PHASE_END

    GMLP_PHASES(0, 0)
    FFN_PHASES(0)
    DIFF_PHASES(1, 0)
    FFN_PHASES(1)
    float* Cf = (float*)(ws + FA_B); bf16* CQn = (bf16*)(ws + FA_B + 66 * MiB); bf16* CKVn = (bf16*)(ws + FA_B + 83 * MiB); bf16* KRb = (bf16*)(ws + FA_B + 100 * MiB);
    bf16* Qmb = (bf16*)(ws + FA_H); bf16* KVmb = (bf16*)(ws + FA_H + 99 * MiB);
#define MLA_PHASES(l) \
    if (!fuse) { PHASE_BEGIN(PH(l, 0)) ph_norm(C, X, args.in[I_N1G] + (size_t)(l) * D, mod + (size_t)(l) * 3 * MODW, 0, XNb, 0, nullptr, nullptr, PARTf, 4, 0); PHASE_END } \
    PHASE_BEGIN(PH(l, 1)) { pg8::Gemm g{XNb, WB + WB_CDQKV, NR, 1024, D}; \
        if (fuse) { ph_norm(C, X, args.in[I_N1G] + (size_t)(l) * D, mod + (size_t)(l) * 3 * MODW, 0, XNb, 0, nullptr, nullptr, PARTf, 4, 2, CTXC + (2 + (l)) * 64); g.ctxcnt = CTXC + (2 + (l)) * 64; g.ctxwant = (unsigned)C.G * 8u; } \
        pg8::StaticOrder S; S.init(BATCH * SEQ, 1024, C.G, (int)blockIdx.x, 1); \
        if (fuse) { pg8::EpiMlaDown E{PARTf, args.in[I_CQNG], args.in[I_CKVNG], tab, (pg8::bf16_t*)CQn, (pg8::bf16_t*)CKVn, (pg8::bf16_t*)KRb, SLOTf, CNTw + 8 * 66 * 64, TMOw}; \
            pg8::gemm_phase<pg8::EpiMlaDown, pg8::StaticOrder, GEMM_ALIGN, GEMM_SP2, true, 4>(C.lds, g, S, E); } \
        else { pg8::EpiF32Store E{Cf, 1024, PARTf}; pg8::gemm_phase<pg8::EpiF32Store, pg8::StaticOrder, GEMM_ALIGN, GEMM_SP2, true, 4>(C.lds, g, S, E); } } PHASE_END \
    if (!fuse) { PHASE_BEGIN(PH(l, 2)) ph_mla_mid(C, Cf, PARTf, args.in[I_CQNG], args.in[I_CKVNG], tab, CQn, CKVn, KRb, 0); PHASE_END } \
    PHASE_BEGIN(PH(l, 3)) { if (fuse) ph_mla_mid(C, Cf, PARTf, args.in[I_CQNG], args.in[I_CKVNG], tab, CQn, CKVn, KRb, 1, CTXC + 5 * 64);     \
        { pg8::Gemm g{CQn, WB + WB_CUQ, NR, 3072, 512}; pg8::StaticOrder S; S.init(BATCH * SEQ, 3072, C.G, (int)blockIdx.x, 1); \
        { LAS float* tl_ = (LAS float*)(C.lds + 131072); for (int i_ = C.tid; i_ < 4096; i_ += 512) tl_[i_] = tab[8192 + i_]; } __syncthreads();     \
        pg8::EpiMlaQ E{Qmb, (LAS const float*)(C.lds + 131072)}; pg8::gemm_phase<pg8::EpiMlaQ, pg8::StaticOrder, GEMM_ALIGN, GEMM_SP2>(C.lds, g, S, E); } \
        { pg8::Gemm g{CKVn, WB + WB_CUKV, NR, 4096, 512}; if (fuse) { g.ctxcnt = CTXC + 5 * 64; g.ctxwant = (unsigned)C.G * 8u; } pg8::StaticOrder S; S.init(BATCH * SEQ, 4096, C.G, (int)blockIdx.x, 1); \
        pg8::EpiAct<0> E{KVmb, 4096}; pg8::gemm_phase<pg8::EpiAct<0>, pg8::StaticOrder, GEMM_ALIGN, GEMM_SP2, true>(C.lds, g, S, E); } } PHASE_END \
    PHASE_BEGIN(PH(l, 4)) ph_mla_attn(C, Qmb, KVmb, KRb, XNb); PHASE_END \
    PHASE_BEGIN(PH(l, 5)) if (fuse) FUSED_RES(XNb, WB + WB_CWO, 2048, mod + (size_t)(l) * 3 * MODW + 2 * D, args.in[I_N2G] + (size_t)(l) * D, mod + (size_t)(l) * 3 * MODW + 3 * D, (l), (const float*)nullptr, false) \
        else { pg8::Gemm g{XNb, WB + WB_CWO, NR, D, 2048}; pg8::StaticOrder S; S.init(BATCH * SEQ, D, C.G, (int)blockIdx.x, 1); \
        pg8::EpiRes E{X, mod + (size_t)(l) * 3 * MODW + 2 * D, nullptr, nullptr, nullptr};  pg8::gemm_phase<pg8::EpiRes, pg8::StaticOrder, GEMM_ALIGN, GEMM_SP2>(C.lds, g, S, E); } PHASE_END
    MLA_PHASES(2)
    FFN_PHASES(2)
    GMLP_PHASES(3, 1)
    FFN_PHASES(3)

    if (!fuse) { PHASE_BEGIN(PH_FINAL) ph_final(C, X, args.in[I_FING], args.out); PHASE_END }
#undef PHASE_BEGIN
#undef PHASE_END
}

extern "C" void kernel_launch(void* const* d_in, const int* in_sizes, int n_in, void* d_out, int out_size, void* d_ws, size_t ws_size, hipStream_t stream) {
    if (n_in != N_IN || in_sizes[I_X] != BATCH * SEQ * D || out_size != BATCH * SEQ * D || ws_size < WS_NEED) {
        fprintf(stderr, "kernel_launch: unexpected shapes (n_in %d, x %d, out %d, ws %zu; need ws %zu); nothing launched\n", n_in, n_in > 0 ? in_sizes[0] : -1, out_size, ws_size, (size_t)WS_NEED);
        return;
    }
    static int grid = 0;
    if (grid == 0) {
        int dev = 0, cus = 0, per_cu = 0;
        if (hipGetDevice(&dev) != hipSuccess || hipDeviceGetAttribute(&cus, hipDeviceAttributeMultiprocessorCount, dev) != hipSuccess) { grid = -1; return; }
        if (hipFuncSetAttribute((const void*)mega, hipFuncAttributeMaxDynamicSharedMemorySize, LDS_BYTES) != hipSuccess) { fprintf(stderr, "kernel_launch: cannot get %d B of LDS\n", LDS_BYTES); grid = -1; return; }
        if (hipOccupancyMaxActiveBlocksPerMultiprocessor(&per_cu, (const void*)mega, 512, LDS_BYTES) != hipSuccess || per_cu < 1) fprintf(stderr, "kernel_launch: occupancy query says %d blocks per CU\n", per_cu);
        (void)hipGetLastError();
        grid = cus;
    }
    if (grid < 0) return;
    unsigned char* ws = (unsigned char*)d_ws;
    (void)hipMemsetAsync(ws + WS_CTL, 0, 1 * MiB, stream);
    Args a{}; for (int i = 0; i < N_IN; ++i) a.in[i] = (const float*)d_in[i]; a.out = (float*)d_out; a.ws = ws;
    a.ph_lo = 0; a.ph_hi = PH_END; a.li = 0; a.pad = 0;
    hipLaunchKernelGGL(mega, dim3(grid), dim3(512), LDS_BYTES, stream, a);
    const hipError_t le = hipPeekAtLastError();
    if (le != hipSuccess) fprintf(stderr, "kernel_launch: launch failed: %s\n", hipGetErrorName(le));
}
```

```cpp
#include <hip/hip_runtime.h>
#include <cstdio>
#include <cstdint>
#include <cmath>

constexpr int D = 2048, BATCH = 2, SEQ = 8192, DEPTH = 4, GRID_W = 64, CTXL = 256;
constexpr int DFF = 8192, NMOD = 6;
constexpr int TB = SEQ + CTXL;
constexpr int NR = BATCH * TB;
constexpr float EPS = 1e-6f;
constexpr int GW = 2048, GG = 16, GC = 128, CHUNK = 128;
constexpr int DH = 8, DHD = 128, DVD = 256, NQKV = 6144;
constexpr int MH = 16, MQR = 448, MKVR = 512, MNOPE = 128, MROPE = 64, MV = 128, MQK = 192;
constexpr int MODW = NMOD * D;

enum { I_X = 0, I_C, I_CTX, I_CCTX, I_WMOD, I_BMOD, I_N1G, I_N2G, I_WFF1, I_WFF2, I_AWIN, I_ABIN, I_ALNG, I_AWS, I_ABS, I_AWOUT,
       I_BWQKV, I_BLQ1, I_BLK1, I_BLQ2, I_BLK2, I_BSUBG, I_BWO, I_CWDQKV, I_CQNG, I_CWUQ, I_CKVNG, I_CWUKV, I_CWO, I_FING, N_IN };

constexpr size_t MiB = 1u << 20;
constexpr size_t WS_CTL = 0;
constexpr size_t WS_MOD = 1 * MiB;
constexpr size_t WS_ROPE = 2 * MiB;
constexpr size_t WS_X = 4 * MiB;
constexpr size_t WS_WB = 136 * MiB;
constexpr size_t WB_FF1 = 0, WB_FF2 = WB_FF1 + (size_t)4 * D * DFF, WB_AWIN = WB_FF2 + (size_t)4 * D * DFF, WB_AWOUT = WB_AWIN + (size_t)2 * D * 4096,
                 WB_BQKV = WB_AWOUT + (size_t)2 * D * D, WB_BWO = WB_BQKV + (size_t)D * NQKV, WB_CDQKV = WB_BWO + (size_t)D * D, WB_CUQ = WB_CDQKV + (size_t)D * 1024,
                 WB_CUKV = WB_CUQ + (size_t)512 * 3072, WB_CWO = WB_CUKV + (size_t)512 * 4096, WB_AWS = WB_CWO + (size_t)D * D, WB_END = WB_AWS + (size_t)2 * GG * 128 * 128;
static_assert(WB_END * 2 <= 360 * MiB, "weights region");
constexpr size_t WS_S0 = 496 * MiB;
constexpr size_t SL_XN = WS_S0;
constexpr size_t SL_BIG = SL_XN + 132 * MiB;
constexpr size_t SL_B2 = SL_BIG + 528 * MiB;
constexpr size_t SL_ST = SL_B2 + 264 * MiB;
constexpr size_t FA_XN = WS_S0;
constexpr size_t FA_H = FA_XN + 66 * MiB;
constexpr size_t FA_B = FA_H + 264 * MiB;
constexpr size_t FA_END = FA_B + 152 * MiB;
constexpr size_t WS_NEED = FA_END;
static_assert(WS_NEED <= 1536 * MiB && SL_ST + 1 * MiB <= 1536 * MiB, "workspace");

__device__ __forceinline__ int row_group(int r) { return (r % TB) >= SEQ ? 2 : r / TB; }
namespace pg8 {
#define PG8_LAS __attribute__((address_space(3)))
typedef unsigned short bf16_t;
typedef short bf16x8 __attribute__((ext_vector_type(8)));
typedef float f32x4 __attribute__((ext_vector_type(4)));
typedef unsigned u32x4 __attribute__((ext_vector_type(4)));
constexpr int BM = 256, BK = 64, HALF = 128, HTB = HALF * BK * 2  , STAGE_BYTES = 8 * HTB, NXCD = 8, WGM = 8;

__host__ __device__ __forceinline__ int lds_byte(int r, int c) { const int st = (r >> 4) * 2 + (c >> 5), rr = r & 15, cc = c & 31, ob = rr * 64 + cc * 2; return st * 1024 + (ob ^ (((ob >> 9) & 1) << 5)); }
__host__ __device__ __forceinline__ void stage_rc(int b, int& R, int& C) { const int st = b / 1024, sb = b % 1024, swz = sb ^ (((sb >> 9) & 1) << 5); R = (st >> 1) * 16 + swz / 64; C = (st & 1) * 32 + (swz % 64) / 2; }
__host__ __device__ __forceinline__ int perm32(int rho) { const int n = rho >> 4, i = rho & 15; return 8 * (i >> 2) + 4 * n + (i & 3); }

struct Unit { int pm, pn; };
struct Gemm { const bf16_t* A; const bf16_t* Bt; int M, N, K; unsigned* ctxcnt = nullptr; unsigned ctxwant = 0; };

struct StaticOrder {
    int nM, nN, nwg, G, c, lat;
    __host__ __device__ void init(int M, int N, int G_, int c_, int lat_ = 0) { nM = M / BM; nN = N / BM; nwg = nM * nN; G = G_; c = c_; lat = lat_; }
    __host__ __device__ bool next(int i, Unit& u) const {
        const long L = (long)i * G + c; if (L >= nwg) return false;
        int wgid = (int)L; { const int q = nwg / NXCD, r = nwg % NXCD, xcd = wgid % NXCD, off = wgid / NXCD; wgid = (xcd < r ? xcd * (q + 1) : r * (q + 1) + (xcd - r) * q) + off; }
        const int nig = WGM * nN, gid = wgid / nig, fm = gid * WGM, gsz = (nM - fm) < WGM ? (nM - fm) : WGM;
        u.pm = fm + ((wgid % nig) % gsz); u.pn = (wgid % nig) / gsz; if (lat) u.pm += (u.pm >= 32) ? 1 : 0; return true;
    }
    __device__ __forceinline__ void a_ready(const Unit&) const {}
    __device__ __forceinline__ void done(const Unit&) const {}
};

__device__ __forceinline__ unsigned cvt_pk_bf16(float lo, float hi) { unsigned r; asm volatile("v_cvt_pk_bf16_f32 %0, %1, %2" : "=v"(r) : "v"(lo), "v"(hi)); return r; }
typedef float f32x2 __attribute__((ext_vector_type(2)));
__device__ __forceinline__ f32x2 gelu_pk(f32x2 v) {
    const f32x2 av = __builtin_elementwise_abs(v), d = av * 0.2316418882f + 1.0f;
    f32x2 t; t.x = __builtin_amdgcn_rcpf(d.x); t.y = __builtin_amdgcn_rcpf(d.y);
    f32x2 q = t * 0.5307027145f + (-0.7265760135f); q = q * t + 0.7107068705f; q = q * t + (-0.142248368f); q = q * t + 0.127414796f; q = q * t;
    const f32x2 s = (v * v) * (-0.72134752044f);
    f32x2 e; e.x = __builtin_amdgcn_exp2f(s.x); e.y = __builtin_amdgcn_exp2f(s.y);
    const f32x2 m = v * (q * e), r = v - m;
    f32x2 o; o.x = v.x < 0.f ? m.x : r.x; o.y = v.y < 0.f ? m.y : r.y; return o;
}

template <class Epi, class Sched, bool ALIGN_EPI = false, bool SP2 = false, bool CTXMINI = false, int KSPLIT = 1>
__device__ __forceinline__ void gemm_phase(PG8_LAS unsigned char* lds, const Gemm g, const Sched& S, const Epi& E) {
    const int tid = threadIdx.x, wid = __builtin_amdgcn_readfirstlane(tid >> 6), lane = tid & 63, wr = wid >> 2, wc = wid & 3, fr = lane & 15, fq = lane >> 4;
    const int K = g.K, nt = K / BK;
    unsigned voffA[2], voffB[2];
#pragma unroll
    for (int i = 0; i < 2; ++i) { int R, C; stage_rc(tid * 16 + i * 8192, R, C); const int Rb = Epi::PERM ? ((R & ~31) + perm32(R & 31)) : R;
        voffA[i] = (unsigned)(R * K + C) * 2u; voffB[i] = (unsigned)(Rb * K + C) * 2u; }
    const size_t kstep = (size_t)(BK * 2);
    const size_t hstep = (size_t)HALF * K * 2;
    const size_t tstep = 2 * hstep;
    const unsigned ldsw = (unsigned)wid * 1024u;
    const int aoff = lds_byte(wr * 64 + fr, fq * 8), boff = lds_byte(wc * 32 + fr, fq * 8);
#define PG8_SA(b, h) (((b) * 2 + (h)) * HTB)
#define PG8_SB(b, h) ((4 + (b) * 2 + (h)) * HTB)
#define PG8_STAGE(bufoff, gbase, voff) do { _Pragma("unroll") for (int _i = 0; _i < 2; ++_i) \
        __builtin_amdgcn_global_load_lds((const unsigned*)((const char*)(gbase) + (voff)[_i]), (PG8_LAS unsigned*)(lds + (bufoff) + ldsw + _i * 8192), 16, 0, 0); } while (0)
#define PG8_LDA(dst, b, h) do { _Pragma("unroll") for (int m = 0; m < 4; ++m) _Pragma("unroll") for (int k = 0; k < 2; ++k) dst[m][k] = *(const PG8_LAS bf16x8*)(lds + PG8_SA(b, h) + aoff + m * 2048 + k * 1024); } while (0)
#define PG8_LDB(dst, b, h) do { _Pragma("unroll") for (int n = 0; n < 2; ++n) _Pragma("unroll") for (int k = 0; k < 2; ++k) dst[n][k] = *(const PG8_LAS bf16x8*)(lds + PG8_SB(b, h) + boff + n * 2048 + k * 1024); } while (0)
#define PG8_MMA(ai, bj, At, Bt) do { __builtin_amdgcn_s_setprio(1); _Pragma("unroll") for (int m = 0; m < 4; ++m) _Pragma("unroll") for (int n = 0; n < 2; ++n) _Pragma("unroll") for (int k = 0; k < 2; ++k) \
        acc[ai][bj][m][n] = __builtin_amdgcn_mfma_f32_16x16x32_bf16(Bt[n][k], At[m][k], acc[ai][bj][m][n], 0, 0, 0); __builtin_amdgcn_s_setprio(0); } while (0)
#define PG8_WAIT_V(n) asm volatile("s_waitcnt vmcnt(" #n ")" ::: "memory")
#define PG8_WAIT_L(n) asm volatile("s_waitcnt lgkmcnt(" #n ")" ::: "memory")
#define PG8_BAR __builtin_amdgcn_s_barrier()
#define PG8_SCHED __builtin_amdgcn_sched_barrier(0)
    Unit cur, nxt; int ui = 0;
    if (!S.next(0, cur)) return;
    f32x4 acc[2][2][4][2];
#pragma unroll
    for (int a = 0; a < 2; ++a)
#pragma unroll
        for (int b = 0; b < 2; ++b)
#pragma unroll
            for (int m = 0; m < 4; ++m)
#pragma unroll
                for (int n = 0; n < 2; ++n) acc[a][b][m][n] = (f32x4){0.f, 0.f, 0.f, 0.f};
    bf16x8 At[4][2], B0[2][2], B1[2][2];
    const char* cA = (const char*)g.A + (size_t)cur.pm * tstep; const char* cB = (const char*)g.Bt + (size_t)cur.pn * tstep;
    S.a_ready(cur);
    if constexpr (SP2) {
        PG8_STAGE(PG8_SB(0, 0), cB, voffB); PG8_STAGE(PG8_SB(0, 1), cB + hstep, voffB); PG8_STAGE(PG8_SA(0, 0), cA, voffA); PG8_STAGE(PG8_SA(0, 1), cA + hstep, voffA);
        if (wr == 1) PG8_BAR;
        PG8_WAIT_V(2); PG8_BAR;
        PG8_STAGE(PG8_SB(1, 0), cB + kstep, voffB); PG8_STAGE(PG8_SA(1, 0), cA + kstep, voffA); PG8_STAGE(PG8_SB(1, 1), cB + hstep + kstep, voffB);
        PG8_WAIT_V(6); PG8_BAR;
    } else {
        PG8_STAGE(PG8_SB(0, 0), cB, voffB); PG8_STAGE(PG8_SA(0, 0), cA, voffA); PG8_STAGE(PG8_SB(0, 1), cB + hstep, voffB); PG8_STAGE(PG8_SA(0, 1), cA + hstep, voffA);
        if (wr == 1) PG8_BAR;
        PG8_WAIT_V(4); PG8_BAR;
        PG8_STAGE(PG8_SB(1, 0), cB + kstep, voffB); PG8_STAGE(PG8_SA(1, 0), cA + kstep, voffA); PG8_STAGE(PG8_SB(1, 1), cB + hstep + kstep, voffB);
        PG8_WAIT_V(6); PG8_BAR;
    }
    for (;;) {
        const bool has_next = S.next(ui + 1, nxt);
        const char* nA = has_next ? (const char*)g.A + (size_t)nxt.pm * tstep : cA; const char* nB = has_next ? (const char*)g.Bt + (size_t)nxt.pn * tstep : cB;
        for (int t = 0; t < nt; t += 2) {
            const bool last = (t == nt - 2);
            const char* a1 = cA + (size_t)(t + 1) * kstep;
            const char* a2 = last ? nA : cA + (size_t)(t + 2) * kstep; const char* b2 = last ? nB : cB + (size_t)(t + 2) * kstep;
            const char* a3 = a2 + kstep; const char* b3 = b2 + kstep;
            if (last && has_next) S.a_ready(nxt);
            if constexpr (SP2) {
            PG8_LDB(B0, 0, 0); PG8_LDB(B1, 0, 1); PG8_SCHED; PG8_LDA(At, 0, 0); PG8_STAGE(PG8_SA(1, 1), a1 + hstep, voffA);
            PG8_WAIT_V(8); PG8_WAIT_L(0); PG8_BAR; PG8_MMA(0, 0, At, B0); PG8_MMA(0, 1, At, B1); PG8_BAR; PG8_SCHED;
            PG8_LDA(At, 0, 1); PG8_STAGE(PG8_SB(0, 0), b2, voffB); PG8_STAGE(PG8_SB(0, 1), b2 + hstep, voffB); PG8_STAGE(PG8_SA(0, 0), a2, voffA);
            PG8_WAIT_V(8); PG8_WAIT_L(0); PG8_BAR; PG8_MMA(1, 0, At, B0); PG8_MMA(1, 1, At, B1); PG8_BAR; PG8_SCHED;
            PG8_LDB(B0, 1, 0); PG8_LDB(B1, 1, 1); PG8_SCHED; PG8_LDA(At, 1, 0); PG8_STAGE(PG8_SA(0, 1), a2 + hstep, voffA);
            PG8_WAIT_V(8); PG8_WAIT_L(0); PG8_BAR; PG8_MMA(0, 0, At, B0); PG8_MMA(0, 1, At, B1); PG8_BAR; PG8_SCHED;
            PG8_LDA(At, 1, 1); PG8_STAGE(PG8_SB(1, 0), b3, voffB); PG8_STAGE(PG8_SB(1, 1), b3 + hstep, voffB); PG8_STAGE(PG8_SA(1, 0), a3, voffA);
            PG8_WAIT_V(8); PG8_WAIT_L(0); PG8_BAR; PG8_MMA(1, 0, At, B0); PG8_MMA(1, 1, At, B1); PG8_BAR; PG8_SCHED;
            } else {
            PG8_LDB(B0, 0, 0); PG8_SCHED; PG8_LDA(At, 0, 0); PG8_STAGE(PG8_SA(1, 1), a1 + hstep, voffA);
            PG8_WAIT_L(8); PG8_BAR; PG8_WAIT_L(0); PG8_MMA(0, 0, At, B0); PG8_BAR; PG8_SCHED;
            PG8_LDB(B1, 0, 1); PG8_STAGE(PG8_SB(0, 0), b2, voffB);
            PG8_BAR; PG8_WAIT_L(0); PG8_MMA(0, 1, At, B1); PG8_BAR;
            PG8_LDA(At, 0, 1); PG8_STAGE(PG8_SA(0, 0), a2, voffA);
            PG8_BAR; PG8_WAIT_L(0); PG8_MMA(1, 0, At, B0); PG8_BAR; PG8_SCHED;
            PG8_STAGE(PG8_SB(0, 1), b2 + hstep, voffB);
            PG8_WAIT_V(6); PG8_BAR; PG8_MMA(1, 1, At, B1); PG8_BAR;
            PG8_LDB(B0, 1, 0); PG8_SCHED; PG8_LDA(At, 1, 0); PG8_STAGE(PG8_SA(0, 1), a2 + hstep, voffA);
            PG8_WAIT_L(8); PG8_BAR; PG8_WAIT_L(0); PG8_MMA(0, 0, At, B0); PG8_BAR; PG8_SCHED;
            PG8_LDB(B1, 1, 1); PG8_STAGE(PG8_SB(1, 0), b3, voffB);
            PG8_BAR; PG8_WAIT_L(0); PG8_MMA(0, 1, At, B1); PG8_BAR;
            PG8_LDA(At, 1, 1); PG8_STAGE(PG8_SA(1, 0), a3, voffA);
            PG8_BAR; PG8_WAIT_L(0); PG8_MMA(1, 0, At, B0); PG8_BAR; PG8_SCHED;
            PG8_STAGE(PG8_SB(1, 1), b3 + hstep, voffB);
            PG8_WAIT_V(6); PG8_BAR; PG8_MMA(1, 1, At, B1); PG8_BAR;
            }
        }
        if constexpr (ALIGN_EPI) { if (wr == 0) PG8_BAR; }
        if constexpr (!Epi::AFTER_DRAIN) { E(acc, cur, wr, wc, fr, fq); S.done(cur); }
        if (!has_next) break;
#pragma unroll
        for (int a = 0; a < 2; ++a)
#pragma unroll
            for (int b = 0; b < 2; ++b)
#pragma unroll
                for (int m = 0; m < 4; ++m)
#pragma unroll
                    for (int n = 0; n < 2; ++n) acc[a][b][m][n] = (f32x4){0.f, 0.f, 0.f, 0.f};
        cur = nxt; cA = nA; cB = nB; ++ui;
        if constexpr (ALIGN_EPI) { if (wr == 1) PG8_BAR; }
    }
    PG8_WAIT_V(0);
    if constexpr (!ALIGN_EPI) { if (wr == 0) PG8_BAR; }
    PG8_BAR;
    if constexpr (Epi::AFTER_DRAIN) { E.fused(acc, cur, wr, wc, fr, fq, lds, wid, lane); S.done(cur); }
    if constexpr (CTXMINI) {
        if (g.ctxcnt) {
            if (wid == 0) { unsigned sp = 0;
                for (;;) { if ((unsigned)__builtin_amdgcn_readfirstlane(__hip_atomic_load(g.ctxcnt, __ATOMIC_RELAXED, __HIP_MEMORY_SCOPE_AGENT)) >= g.ctxwant) break;
                    __builtin_amdgcn_s_sleep(2); if (++sp > (1u << 20)) break; }
                __builtin_amdgcn_fence(__ATOMIC_ACQUIRE, "agent"); asm volatile("s_waitcnt vmcnt(0)" ::: "memory"); }
            PG8_BAR; }
#define PG8_MMAQ(Q_, At, Bt) do { __builtin_amdgcn_s_setprio(1); _Pragma("unroll") for (int m = 0; m < 4; ++m) _Pragma("unroll") for (int n = 0; n < 2; ++n) _Pragma("unroll") for (int k = 0; k < 2; ++k) \
        Q_[m][n] = __builtin_amdgcn_mfma_f32_16x16x32_bf16(Bt[n][k], At[m][k], Q_[m][n], 0, 0, 0); __builtin_amdgcn_s_setprio(0); } while (0)
        const int nNm = g.N / BM, nmini = 8 * nNm * KSPLIT, ntm = nt / KSPLIT;
        for (int mi = S.c; mi < nmini; mi += S.G) {
            const int sp = mi % KSPLIT, mq = mi / KSPLIT, bj = mq & 1, pn = (mq >> 1) % nNm, r2 = (mq >> 1) / nNm, ai = r2 & 1, pc = r2 >> 1;
            Unit u; u.pm = 32 + 33 * pc; u.pn = pn;
            const char* mA = (const char*)g.A + (size_t)u.pm * tstep + (size_t)ai * hstep + (size_t)sp * ntm * kstep;
            const char* mB = (const char*)g.Bt + (size_t)pn * tstep + (size_t)bj * hstep + (size_t)sp * ntm * kstep;
            f32x4 aq[4][2];
#pragma unroll
            for (int m = 0; m < 4; ++m)
#pragma unroll
                for (int n = 0; n < 2; ++n) aq[m][n] = (f32x4){0.f, 0.f, 0.f, 0.f};
#define PG8_MINI_STEP(s_, tt_) do { const int t_ = (tt_); \
                if (t_ + 2 < ntm) { PG8_WAIT_V(8); } else if (t_ + 1 < ntm) { PG8_WAIT_V(4); } else { PG8_WAIT_V(0); } \
                PG8_BAR; \
                if (t_ + 3 < ntm) { PG8_STAGE(PG8_SA((((s_) + 3) & 3) >> 1, ((s_) + 3) & 1), mA + (size_t)(t_ + 3) * kstep, voffA); PG8_STAGE(PG8_SB((((s_) + 3) & 3) >> 1, ((s_) + 3) & 1), mB + (size_t)(t_ + 3) * kstep, voffB); } \
                PG8_LDB(B0, (s_) >> 1, (s_) & 1); PG8_LDA(At, (s_) >> 1, (s_) & 1); PG8_WAIT_L(0); PG8_SCHED; \
                PG8_MMAQ(aq, At, B0); PG8_SCHED; } while (0)
            PG8_STAGE(PG8_SA(0, 0), mA, voffA); PG8_STAGE(PG8_SB(0, 0), mB, voffB);
            PG8_STAGE(PG8_SA(0, 1), mA + kstep, voffA); PG8_STAGE(PG8_SB(0, 1), mB + kstep, voffB);
            PG8_STAGE(PG8_SA(1, 0), mA + 2 * kstep, voffA); PG8_STAGE(PG8_SB(1, 0), mB + 2 * kstep, voffB);
            for (int t = 0; t < ntm; t += 4) { PG8_MINI_STEP(0, t); PG8_MINI_STEP(1, t + 1); PG8_MINI_STEP(2, t + 2); PG8_MINI_STEP(3, t + 3); }
#undef PG8_MINI_STEP
            if constexpr (KSPLIT > 1) E.quad_part(aq, u, ai, bj, sp, pc, wr, wc, fr, fq); else E.quad(aq, u, ai, bj, wr, wc, fr, fq);
            PG8_WAIT_V(0);
        }
#undef PG8_MMAQ
    }
#undef PG8_SA
#undef PG8_SB
#undef PG8_STAGE
#undef PG8_LDA
#undef PG8_LDB
#undef PG8_MMA
#undef PG8_WAIT_V
#undef PG8_WAIT_L
#undef PG8_BAR
#undef PG8_SCHED
}
}
#define GAS __attribute__((address_space(1)))
#define LAS __attribute__((address_space(3)))
typedef unsigned short bf16;
typedef unsigned v4u __attribute__((ext_vector_type(4)));
typedef float f32x4 __attribute__((ext_vector_type(4)));
typedef short bf16x8 __attribute__((ext_vector_type(8)));
typedef GAS unsigned gu32;
typedef GAS unsigned long long gu64;
#define RLX_AGENT __ATOMIC_RELAXED, __HIP_MEMORY_SCOPE_AGENT
#define LDS_WAIT() asm volatile("s_waitcnt lgkmcnt(0)" ::: "memory")
#define VM_WAIT() asm volatile("s_waitcnt vmcnt(0)" ::: "memory")
__device__ __forceinline__ unsigned long long rt() { return __builtin_amdgcn_s_memrealtime(); }
__device__ __forceinline__ unsigned f2bf(float f) { unsigned u = __builtin_bit_cast(unsigned, f); return (u + 0x7fffu + ((u >> 16) & 1u)) >> 16; }
__device__ __forceinline__ unsigned pk2(float lo, float hi) { return f2bf(lo) | (f2bf(hi) << 16); }

#define XB_TMO      128
#define XB_XCNT(j)  (256  + 64 * (j))
#define XB_XSUB(j)  (1280 + 64 * (j))
#define XB_XGEN(j)  (2304 + 64 * (j))
#define XB_TOP      3328
#define XB_TOPGEN   3392
#define XCD_BAR_WORDS 3456
#define XB_SPIN_CAP (1u << 18)

__device__ __forceinline__ unsigned xb_ld(unsigned* p)              { return __hip_atomic_load(p, __ATOMIC_RELAXED, __HIP_MEMORY_SCOPE_AGENT); }
__device__ __forceinline__ unsigned xb_add(unsigned* p, unsigned v) { return __hip_atomic_fetch_add(p, v, __ATOMIC_RELAXED, __HIP_MEMORY_SCOPE_AGENT); }
__device__ __forceinline__ unsigned xb_xcc_id() { return (unsigned)__builtin_amdgcn_s_getreg((3 << 11) | 20) & 0xFu; }
#define XB_SPIN(cond, bar) do { unsigned _sp = 0; while (cond) { __builtin_amdgcn_s_sleep(1); \
    if ((++_sp & 255u) == 0u) { if (xb_ld(&(bar)[XB_TMO])) break; if (_sp > XB_SPIN_CAP) { atomicAdd(&(bar)[XB_TMO], 1u); break; } } } } while (0)

struct XcdBarrier {
    unsigned* bar; unsigned x;
    volatile LAS unsigned* st;
};

__device__ __forceinline__ XcdBarrier xcd_barrier_post(unsigned* bar, volatile LAS unsigned* st) {
    XcdBarrier b; b.bar = bar; b.x = xb_xcc_id(); b.st = st;
    if (threadIdx.x == 0) (void)xb_add(&bar[XB_XCNT(b.x)], 1u);
    return b;
}
__device__ __forceinline__ void xcd_barrier_complete(unsigned* bar, unsigned x, unsigned& nloc, unsigned& nx) {
    const unsigned G = gridDim.x * gridDim.y * gridDim.z;
    unsigned sum, cnt, mine, sp = 0u;
    for (;;) {
        sum = 0u; cnt = 0u; mine = 0u;
#pragma unroll
        for (unsigned j = 0; j < 16; ++j) { const unsigned c = xb_ld(&bar[XB_XCNT(j)]); sum += c; cnt += (c > 0u) ? 1u : 0u; mine = (j == x) ? c : mine; }
        if (sum == G) break;
        __builtin_amdgcn_s_sleep(1);
        if ((++sp & 255u) == 0u) { if (xb_ld(&bar[XB_TMO])) break; if (sp > XB_SPIN_CAP) { atomicAdd(&bar[XB_TMO], 1u); break; } }
    }
    nloc = mine > 0u ? mine : 1u; nx = cnt > 0u ? cnt : 1u;
}

__device__ __forceinline__ void xcd_barrier(const XcdBarrier& b) {
    asm volatile("s_waitcnt vmcnt(0)" ::: "memory");
    __syncthreads();
    if (threadIdx.x == 0) {
        unsigned* bar = b.bar;
        __builtin_amdgcn_s_waitcnt(0);
        unsigned nloc = b.st[0], nx = b.st[1];
        if (nloc == 0u) { xcd_barrier_complete(bar, b.x, nloc, nx); b.st[0] = nloc; b.st[1] = nx; }
        const unsigned old = xb_add(&bar[XB_XSUB(b.x)], 1u);
        const unsigned gen = old / nloc;
        if (old + 1u == (gen + 1u) * nloc) {
            __builtin_amdgcn_fence(__ATOMIC_RELEASE, "agent");
            asm volatile("s_waitcnt vmcnt(0)" ::: "memory");
            const unsigned og = xb_add(&bar[XB_TOP], 1u);
            const unsigned tg = og / nx;
            if (og + 1u == (tg + 1u) * nx) xb_add(&bar[XB_TOPGEN], 1u);
            else XB_SPIN(xb_ld(&bar[XB_TOPGEN]) == tg, bar);
            __builtin_amdgcn_fence(__ATOMIC_ACQUIRE, "agent");
            xb_add(&bar[XB_XGEN(b.x)], 1u);
            asm volatile("s_waitcnt vmcnt(0)" ::: "memory");
        } else {
            XB_SPIN(xb_ld(&bar[XB_XGEN(b.x)]) == gen, bar);
            __builtin_amdgcn_fence(__ATOMIC_ACQUIRE, "agent");
            asm volatile("s_waitcnt vmcnt(0)" ::: "memory");
        }
    }
    __syncthreads();
}


constexpr int CW_BAR = 4096;
constexpr int MAX_LAUNCH = 24;
static_assert((CW_BAR + MAX_LAUNCH * XCD_BAR_WORDS) * 4 <= (int)(1 * MiB), "barrier regions inside the zeroed control MiB");
constexpr int RING_BYTES = 155648, LDSCTL_OFF = RING_BYTES, MISC_OFF = LDSCTL_OFF + 320, LDS_BYTES = 159744;

struct Args { const float* in[N_IN]; float* out; unsigned char* ws; int ph_lo, ph_hi, li, pad; };
struct Ctx { LAS unsigned char* lds; int tid, lane, wave, vcu, G; };

__device__ __forceinline__ int panel_group(int pm) { return (pm % 33) == 32 ? 2 : pm / 33; }

namespace pg8 {
template <int ACT> struct EpiAct {
    static constexpr bool PERM = true, AFTER_DRAIN = false;
    bf16_t* O; int ldc;
    __device__ __forceinline__ void quad(const f32x4 (&a)[4][2], const Unit& u, int ai, int bj, int wr, int wc, int fr, int fq) const {
        const int row0 = u.pm * BM + ai * HALF + wr * 64 + fr, col0 = u.pn * BM + bj * HALF + wc * 32 + 8 * fq;
#pragma unroll
        for (int m = 0; m < 4; ++m) { f32x4 v0 = a[m][0], v1 = a[m][1];
            if (ACT == 2) {
#pragma unroll
                for (int j = 0; j < 4; ++j) { const float x = fmaxf(v0[j], 0.f), y = fmaxf(v1[j], 0.f); v0[j] = x * x; v1[j] = y * y; } }
            u32x4 w; w.x = cvt_pk_bf16(v0[0], v0[1]); w.y = cvt_pk_bf16(v0[2], v0[3]); w.z = cvt_pk_bf16(v1[0], v1[1]); w.w = cvt_pk_bf16(v1[2], v1[3]);
            *(u32x4*)(O + (size_t)(row0 + m * 16) * ldc + col0) = w; }
    }
    __device__ __forceinline__ void operator()(const f32x4 (&acc)[2][2][4][2], const Unit& u, int wr, int wc, int fr, int fq) const {
#pragma unroll
        for (int ai = 0; ai < 2; ++ai)
#pragma unroll
            for (int bj = 0; bj < 2; ++bj) quad(acc[ai][bj], u, ai, bj, wr, wc, fr, fq);
    }
};
struct EpiRes {
    static constexpr bool PERM = false, AFTER_DRAIN = false;
    float* X; const float* gate; const float* xin; const float* cin; float* part;
    __device__ __forceinline__ const float* src_row0(const Unit& u) const {
        if (!xin) return X + (size_t)u.pm * BM * D;
        const int b = u.pm / 33, p = u.pm % 33;
        return p < 32 ? xin + ((size_t)b * SEQ + (size_t)p * BM) * D : cin + (size_t)b * CTXL * D;
    }
    __device__ __forceinline__ void quad(const f32x4 (&a)[4][2], const Unit& u, int ai, int bj, int wr, int wc, int fr, int fq) const {
        const int row0 = u.pm * BM + ai * HALF + wr * 64 + fr, col0 = u.pn * BM + bj * HALF + wc * 32 + 4 * fq;
        const float* gp = gate + (size_t)panel_group(u.pm) * MODW + col0;
        const f32x4 g0 = *(const f32x4*)(gp), g1 = *(const f32x4*)(gp + 16);
        const float* sp = src_row0(u) + (size_t)(ai * HALF + wr * 64 + fr) * D + col0;
#pragma unroll
        for (int m = 0; m < 4; ++m) { float* rowp = X + (size_t)(row0 + m * 16) * D + col0; const float* sr = sp + (size_t)(m * 16) * D;
            const f32x4 x0 = *(const f32x4*)sr, x1 = *(const f32x4*)(sr + 16); *(f32x4*)rowp = x0 + g0 * a[m][0]; *(f32x4*)(rowp + 16) = x1 + g1 * a[m][1]; }
    }
    __device__ __forceinline__ void quad_part(const f32x4 (&a)[4][2], const Unit& u, int ai, int bj, int sp, int pc, int wr, int wc, int fr, int fq) const {
        const int col0 = u.pn * BM + bj * HALF + wc * 32 + 4 * fq, rl0 = pc * BM + ai * HALF + wr * 64 + fr;
        const float* gp = gate + (size_t)2 * MODW + col0;
        const f32x4 g0 = *(const f32x4*)(gp), g1 = *(const f32x4*)(gp + 16);
#pragma unroll
        for (int m = 0; m < 4; ++m) { float* rowp = part + ((size_t)sp * 512 + rl0 + m * 16) * D + col0; *(f32x4*)rowp = g0 * a[m][0]; *(f32x4*)(rowp + 16) = g1 * a[m][1]; }
    }
    __device__ __forceinline__ void operator()(const f32x4 (&acc)[2][2][4][2], const Unit& u, int wr, int wc, int fr, int fq) const {
        const int colb = u.pn * BM + wc * 32 + 4 * fq;
        const float* gp = gate + (size_t)panel_group(u.pm) * MODW + colb;
        f32x4 gv[2][2];
#pragma unroll
        for (int bj = 0; bj < 2; ++bj)
#pragma unroll
            for (int n = 0; n < 2; ++n) gv[bj][n] = *(const f32x4*)(gp + bj * HALF + n * 16);
#pragma unroll
        for (int ai = 0; ai < 2; ++ai) {
            float* base = X + (size_t)(u.pm * BM + ai * HALF + wr * 64 + fr) * D + colb;
            const float* sbase = src_row0(u) + (size_t)(ai * HALF + wr * 64 + fr) * D + colb;
            f32x4 xin[4][2][2];
#pragma unroll
            for (int m = 0; m < 4; ++m)
#pragma unroll
                for (int bj = 0; bj < 2; ++bj)
#pragma unroll
                    for (int n = 0; n < 2; ++n) xin[m][bj][n] = *(const f32x4*)(sbase + (size_t)(m * 16) * D + bj * HALF + n * 16);
#pragma unroll
            for (int m = 0; m < 4; ++m)
#pragma unroll
                for (int bj = 0; bj < 2; ++bj)
#pragma unroll
                    for (int n = 0; n < 2; ++n) *(f32x4*)(base + (size_t)(m * 16) * D + bj * HALF + n * 16) = xin[m][bj][n] + gv[bj][n] * acc[ai][bj][m][n];
        }
    }
};
struct SliceOrder {
    int c, s, G;
    __device__ __forceinline__ bool next(int i, Unit& u) const { if (i != 0) return false; const int x = c & 7, r = c >> 3, pl = 8 * x + 4 * s + (r & 3); u.pm = pl + (pl >= 32 ? 1 : 0); u.pn = r >> 2; return true; }
    __device__ __forceinline__ void a_ready(const Unit&) const {}
    __device__ __forceinline__ void done(const Unit&) const {}
};
struct EpiResNorm {
    static constexpr bool PERM = false, AFTER_DRAIN = true;
    float* X; const float* gate;
    const float* ng; const float* nmod;
    bf16_t* XN; float* out;
    float* slots; unsigned* cnt; unsigned* tmo;
    const float* xin; float* part;
    __device__ __forceinline__ void fused(f32x4 (&acc)[2][2][4][2], const Unit& u, int wr, int wc, int fr, int fq, PG8_LAS unsigned char* lds, int wid, int lane) const {
        PG8_LAS float* P = (PG8_LAS float*)lds;
        PG8_LAS float* S = (PG8_LAS float*)(lds + 4096);
        PG8_LAS unsigned char* stg = lds + 8192;
        const int colb = u.pn * BM + wc * 32 + 4 * fq, grp = panel_group(u.pm);
        {   const float* gp = gate + (size_t)grp * MODW + colb;
            f32x4 gv[2][2];
#pragma unroll
            for (int bj = 0; bj < 2; ++bj)
#pragma unroll
                for (int n = 0; n < 2; ++n) gv[bj][n] = *(const f32x4*)(gp + bj * HALF + n * 16);
#pragma unroll
            for (int ai = 0; ai < 2; ++ai) {
                float* base = X + (size_t)(u.pm * BM + ai * HALF + wr * 64 + fr) * D + colb;
                const float* sbase = xin ? xin + ((size_t)(u.pm / 33) * SEQ + (size_t)(u.pm % 33) * BM + ai * HALF + wr * 64 + fr) * D + colb : base;
#pragma unroll
                for (int mh = 0; mh < 2; ++mh) {
                    f32x4 xv[2][2][2];
#pragma unroll
                    for (int mm = 0; mm < 2; ++mm)
#pragma unroll
                        for (int bj = 0; bj < 2; ++bj)
#pragma unroll
                            for (int n = 0; n < 2; ++n) xv[mm][bj][n] = *(const f32x4*)(sbase + (size_t)((2 * mh + mm) * 16) * D + bj * HALF + n * 16);
#pragma unroll
                    for (int mm = 0; mm < 2; ++mm) { const int m = 2 * mh + mm; float q = 0.f;
#pragma unroll
                        for (int bj = 0; bj < 2; ++bj)
#pragma unroll
                            for (int n = 0; n < 2; ++n) { const f32x4 y = xv[mm][bj][n] + gv[bj][n] * acc[ai][bj][m][n]; acc[ai][bj][m][n] = y;
                                q += (y[0] * y[0] + y[1] * y[1]) + (y[2] * y[2] + y[3] * y[3]); }
                        q += __shfl_xor(q, 16); q += __shfl_xor(q, 32);
                        if (fq == 0) P[(ai * HALF + wr * 64 + m * 16 + fr) * 4 + wc] = q; }
                    asm volatile("" ::: "memory"); }
            } }
        f32x4 cgs[2][2], csh[2][2];
        {   const float* mg = nmod ? nmod + (size_t)grp * MODW + colb : nullptr;
#pragma unroll
            for (int bj = 0; bj < 2; ++bj)
#pragma unroll
                for (int n = 0; n < 2; ++n) { const int co = bj * HALF + n * 16; const f32x4 g4 = *(const f32x4*)(ng + colb + co);
                    if (nmod) { cgs[bj][n] = g4 * (*(const f32x4*)(mg + D + co) + 1.0f); csh[bj][n] = *(const f32x4*)(mg + co); } else { cgs[bj][n] = g4; csh[bj][n] = (f32x4){0.f, 0.f, 0.f, 0.f}; } } }
        asm volatile("s_waitcnt lgkmcnt(0)" ::: "memory"); __builtin_amdgcn_s_barrier(); asm volatile("" ::: "memory");
        const int row = wid * 32 + (lane & 31);
        if (lane < 32) { const float t = (P[row * 4 + 0] + P[row * 4 + 1]) + (P[row * 4 + 2] + P[row * 4 + 3]);
            __hip_atomic_store((unsigned*)slots + ((size_t)(u.pm * BM + row) * 8 + u.pn), __float_as_uint(t), __ATOMIC_RELAXED, __HIP_MEMORY_SCOPE_AGENT); }
        asm volatile("s_waitcnt vmcnt(0)" ::: "memory");
        if (lane == 0) __hip_atomic_fetch_add(cnt + 64 * u.pm, 1u, __ATOMIC_RELAXED, __HIP_MEMORY_SCOPE_AGENT);
        if (nmod) {
            int t2 = threadIdx.x; asm volatile("" : "+v"(t2));
            const int w2 = t2 >> 6, l2 = t2 & 63; float* xb2 = X + (size_t)(u.pm * BM + (w2 >> 2) * 64 + (l2 & 15)) * D + u.pn * BM + (w2 & 3) * 32 + 4 * (l2 >> 4);
#pragma unroll
            for (int ai = 0; ai < 2; ++ai) { float* base = xb2 + (size_t)(ai * HALF) * D;
#pragma unroll
                for (int m = 0; m < 4; ++m)
#pragma unroll
                    for (int bj = 0; bj < 2; ++bj)
#pragma unroll
                        for (int n = 0; n < 2; ++n) *(f32x4*)(base + (size_t)(m * 16) * D + bj * HALF + n * 16) = acc[ai][bj][m][n]; } }
        if (wid == 0) { unsigned sp = 0;
            for (;;) { if ((unsigned)__builtin_amdgcn_readfirstlane(__hip_atomic_load(cnt + 64 * u.pm, __ATOMIC_RELAXED, __HIP_MEMORY_SCOPE_AGENT)) >= 64u) break;
                __builtin_amdgcn_s_sleep(2);
                if (++sp > (1u << 22)) { if (lane == 0) __hip_atomic_store(tmo, 1u, __ATOMIC_RELAXED, __HIP_MEMORY_SCOPE_AGENT); break; } }
            __builtin_amdgcn_fence(__ATOMIC_ACQUIRE, "agent"); }
        asm volatile("s_waitcnt vmcnt(0) lgkmcnt(0)" ::: "memory"); __builtin_amdgcn_s_barrier(); asm volatile("" ::: "memory");
        if (lane < 32) { const unsigned* sl = (const unsigned*)slots + (size_t)(u.pm * BM + row) * 8; float t = 0.f;
#pragma unroll
            for (int k = 0; k < 8; ++k) t += __uint_as_float(__hip_atomic_load(sl + k, __ATOMIC_RELAXED, __HIP_MEMORY_SCOPE_AGENT));
            S[row] = rsqrtf(t * (1.0f / D) + EPS); }
        asm volatile("s_waitcnt vmcnt(0) lgkmcnt(0)" ::: "memory"); __builtin_amdgcn_s_barrier(); asm volatile("" ::: "memory");
        if (nmod) {
#pragma unroll
            for (int bj = 0; bj < 2; ++bj)
#pragma unroll
                for (int n = 0; n < 2; ++n) { const int co = bj * HALF + n * 16;
                    const f32x4 gs = cgs[bj][n], sh = csh[bj][n];
#pragma unroll
                    for (int ai = 0; ai < 2; ++ai)
#pragma unroll
                        for (int m = 0; m < 4; ++m) { const int r = ai * HALF + wr * 64 + m * 16 + fr; const float rs = S[r]; const f32x4 y = acc[ai][bj][m][n] * rs * gs + sh;
                            *(PG8_LAS unsigned long long*)(stg + r * 528 + (wc * 32 + 4 * fq + co) * 2) = (unsigned long long)cvt_pk_bf16(y[0], y[1]) | ((unsigned long long)cvt_pk_bf16(y[2], y[3]) << 32); } }
            asm volatile("s_waitcnt lgkmcnt(0)" ::: "memory"); __builtin_amdgcn_s_barrier(); asm volatile("" ::: "memory");
            const int tid = wid * 64 + lane;
#pragma unroll
            for (int it = 0; it < 16; ++it) { const int p = it * 512 + tid, r = p >> 5, ch = p & 31;
                const u32x4 v = *(const PG8_LAS u32x4*)(stg + r * 528 + ch * 16);
                *(u32x4*)(XN + (size_t)(u.pm * BM + r) * D + u.pn * BM + ch * 8) = v; }
            asm volatile("s_waitcnt lgkmcnt(0)" ::: "memory"); __builtin_amdgcn_s_barrier(); asm volatile("" ::: "memory");
        } else {
            const int b = u.pm / 33, p = u.pm % 33;
            float* ob = out + ((size_t)b * SEQ + (size_t)p * BM) * D + colb;
#pragma unroll
            for (int bj = 0; bj < 2; ++bj)
#pragma unroll
                for (int n = 0; n < 2; ++n) { const int co = bj * HALF + n * 16; const f32x4 g4 = cgs[bj][n];
#pragma unroll
                    for (int ai = 0; ai < 2; ++ai)
#pragma unroll
                        for (int m = 0; m < 4; ++m) { const int r = ai * HALF + wr * 64 + m * 16 + fr; *(f32x4*)(ob + (size_t)r * D + co) = acc[ai][bj][m][n] * S[r] * g4; } }
        }
    }
    __device__ __forceinline__ void quad(const f32x4 (&)[4][2], const Unit&, int, int, int, int, int, int) const {}
    __device__ __forceinline__ void quad_part(const f32x4 (&a)[4][2], const Unit& u, int ai, int bj, int sp, int pc, int wr, int wc, int fr, int fq) const {
        const int col0 = u.pn * BM + bj * HALF + wc * 32 + 4 * fq, rl0 = pc * BM + ai * HALF + wr * 64 + fr;
        const float* gp = gate + (size_t)2 * MODW + col0;
        const f32x4 g0 = *(const f32x4*)(gp), g1 = *(const f32x4*)(gp + 16);
#pragma unroll
        for (int m = 0; m < 4; ++m) { float* rowp = part + ((size_t)sp * 512 + rl0 + m * 16) * D + col0; *(f32x4*)rowp = g0 * a[m][0]; *(f32x4*)(rowp + 16) = g1 * a[m][1]; }
    }
};
}

__device__ __forceinline__ int perm_row(int n, int mode) {
    if (mode == 1) { if (n >= 4096) return n; const int dd = n & 63; return (n & ~63) + (dd < 32 ? 2 * dd : 2 * (dd - 32) + 1); }
    if (mode == 2) { const int hd = n % 192; if (hd < 128) return n; const int e = hd - 128, dd = e & 31; return n - (e & 31) + (dd < 16 ? 2 * dd : 2 * (dd - 16) + 1); }
    return n;
}
struct TrJob { const float* src; bf16* dst; int N, Kp, mode, n0; };
__device__ __forceinline__ TrJob tr_job(const float* W, int N, bf16* WT, int Kp, int mode, int item) {
    const int nblk = N / 64, kb = item / nblk, nb = item % nblk;
    TrJob j; j.src = W + (size_t)(64 * kb) * N + 64 * nb; j.dst = WT + 64 * kb; j.N = N; j.Kp = Kp; j.mode = mode; j.n0 = 64 * nb; return j;
}
__device__ __forceinline__ void tr_load(f32x4 (&v)[16], const TrJob& j, int lane) {
    const int c = lane & 15, kq = lane >> 4;
#pragma unroll
    for (int i = 0; i < 16; ++i) v[i] = *(const GAS f32x4*)(j.src + (size_t)(4 * i + kq) * j.N + 4 * c);
}
__device__ __forceinline__ void tr_store(const f32x4 (&v)[16], const TrJob& jb, LAS unsigned char* scr, int lane) {
    const int c = lane & 15, kq = lane >> 4;
#pragma unroll
    for (int i = 0; i < 16; ++i) { LAS unsigned short* p = (LAS unsigned short*)(scr + (4 * c) * 132 + (4 * i + kq) * 2);
        p[0] = (unsigned short)f2bf(v[i].x); p[66] = (unsigned short)f2bf(v[i].y); p[132] = (unsigned short)f2bf(v[i].z); p[198] = (unsigned short)f2bf(v[i].w); }
    LDS_WAIT(); asm volatile("" ::: "memory");
    const int j = lane & 7;
#pragma unroll
    for (int m = 0; m < 8; ++m) { const int n = (lane >> 3) + 8 * m; const LAS unsigned* q = (const LAS unsigned*)(scr + n * 132 + j * 16);
        v4u o; o.x = q[0]; o.y = q[1]; o.z = q[2]; o.w = q[3];
        *(GAS v4u*)(jb.dst + (size_t)perm_row(jb.n0 + n, jb.mode) * jb.Kp + 8 * j) = o; }
    LDS_WAIT(); asm volatile("" ::: "memory");
}
__device__ __forceinline__ float silu_f(float v) { return v / (1.0f + __expf(-v)); }

__device__ __forceinline__ void ph_prologue(const Args& a, const Ctx& C, unsigned* pub = nullptr) {
    LAS unsigned char* scr = C.lds + C.wave * 16384;
    const int gw = C.vcu * 8 + C.wave, NGW = C.G * 8, lane = C.lane;
    bf16* WB = (bf16*)(a.ws + WS_WB);
    constexpr int IT_FF1 = (D / 64) * (DFF / 64), IT_FF2 = (DFF / 64) * (D / 64), IT_AIN = (D / 64) * (4096 / 64), IT_AOUT = (D / 64) * (D / 64), IT_BQKV = (D / 64) * (NQKV / 64),
                  IT_CDQ = (D / 64) * (1024 / 64), IT_CUQ = (MQR / 64) * (3072 / 64), IT_CUKV = (MKVR / 64) * (4096 / 64);
    constexpr int NITEMS = 4 * IT_FF1 + 4 * IT_FF2 + 2 * IT_AIN + 2 * IT_AOUT + IT_BQKV + IT_AOUT + IT_CDQ + IT_CUQ + IT_CUKV + IT_AOUT;
    auto job = [&](int it) -> TrJob {
        int r = it;
        if (r < 4 * IT_FF1) { const int l = r / IT_FF1; return tr_job(a.in[I_WFF1] + (size_t)l * D * DFF, DFF, WB + WB_FF1 + (size_t)l * D * DFF, D, 0, r % IT_FF1); } r -= 4 * IT_FF1;
        if (r < 4 * IT_FF2) { const int l = r / IT_FF2; return tr_job(a.in[I_WFF2] + (size_t)l * D * DFF, D, WB + WB_FF2 + (size_t)l * D * DFF, DFF, 0, r % IT_FF2); } r -= 4 * IT_FF2;
        if (r < 2 * IT_AIN) { const int l = r / IT_AIN; return tr_job(a.in[I_AWIN] + (size_t)l * D * 4096, 4096, WB + WB_AWIN + (size_t)l * D * 4096, D, 0, r % IT_AIN); } r -= 2 * IT_AIN;
        if (r < 2 * IT_AOUT) { const int l = r / IT_AOUT; return tr_job(a.in[I_AWOUT] + (size_t)l * D * D, D, WB + WB_AWOUT + (size_t)l * D * D, D, 0, r % IT_AOUT); } r -= 2 * IT_AOUT;
        if (r < IT_BQKV) return tr_job(a.in[I_BWQKV], NQKV, WB + WB_BQKV, D, 1, r); r -= IT_BQKV;
        if (r < IT_AOUT) return tr_job(a.in[I_BWO], D, WB + WB_BWO, D, 0, r); r -= IT_AOUT;
        if (r < IT_CDQ) return tr_job(a.in[I_CWDQKV], 1024, WB + WB_CDQKV, D, 0, r); r -= IT_CDQ;
        if (r < IT_CUQ) return tr_job(a.in[I_CWUQ], 3072, WB + WB_CUQ, 512, 2, r); r -= IT_CUQ;
        if (r < IT_CUKV) return tr_job(a.in[I_CWUKV], 4096, WB + WB_CUKV, 512, 0, r); r -= IT_CUKV;
        return tr_job(a.in[I_CWO], D, WB + WB_CWO, D, 0, r);
    };
    { int it = gw; TrJob j0, j1; f32x4 va[16], vb[16];
      if (it < NITEMS) { j0 = job(it); tr_load(va, j0, lane); }
      while (it < NITEMS) {
          const int it1 = it + NGW; if (it1 < NITEMS) { j1 = job(it1); tr_load(vb, j1, lane); }
          tr_store(va, j0, scr, lane);
          if (it1 >= NITEMS) break;
          const int it2 = it1 + NGW; if (it2 < NITEMS) { j0 = job(it2); tr_load(va, j0, lane); }
          tr_store(vb, j1, scr, lane);
          it = it2;
      } }
    const int gt = C.vcu * 512 + C.tid, NGT = C.G * 512;
    for (int i = gt; i < 3072 * 8; i += NGT) { const int n = i >> 3, c8 = i & 7; *(GAS v4u*)(WB + WB_CUQ + (size_t)n * 512 + 448 + c8 * 8) = (v4u){0u, 0u, 0u, 0u}; }
    { const float* wsrc = a.in[I_AWS]; for (int i = gt; i < 2 * GG * 128 * 128 / 8; i += NGT) { const f32x4 x0 = *(const GAS f32x4*)(wsrc + (size_t)i * 8), x1 = *(const GAS f32x4*)(wsrc + (size_t)i * 8 + 4);
        v4u o; o.x = pk2(x0.x, x0.y); o.y = pk2(x0.z, x0.w); o.z = pk2(x1.x, x1.y); o.w = pk2(x1.z, x1.w); *(GAS v4u*)(WB + WB_AWS + (size_t)i * 8) = o; } }
    { float* tab = (float*)(a.ws + WS_ROPE);
      for (int i = gt; i < 128 * 32; i += NGT) { const int pos = i / 32, f = i % 32; const float inv = powf(10000.0f, -(float)(2 * f) / 64.0f); const float an = (float)pos * inv; tab[i] = cosf(an); tab[4096 + i] = sinf(an); }
      for (int i = gt; i < 128 * 16; i += NGT) { const int pos = i / 16, f = i % 16; const float inv = powf(10000.0f, -(float)(2 * f) / 32.0f); const float an = (float)pos * inv; tab[8192 + i] = cosf(an); tab[8192 + 2048 + i] = sinf(an); } }
    __syncthreads();
    { LAS float* s = (LAS float*)C.lds; LAS float* red = s + 3 * D;
      const float* c = a.in[I_C]; const float* cctx = a.in[I_CCTX]; const float* wmod = a.in[I_WMOD]; const float* bmod = a.in[I_BMOD]; float* mod = (float*)(a.ws + WS_MOD);
      for (int i = C.tid; i < 3 * D; i += 512) { const int g = i / D, k = i % D; const float v = g < 2 ? c[g * D + k] : cctx[k]; s[i] = silu_f(v); }
      __syncthreads();
      const int cq = lane & 15, kr = lane >> 4, wave = C.wave;
      for (int u = C.vcu; u < DEPTH * (MODW / 192); u += C.G) {
          const int l = u / (MODW / 192), n0 = (u % (MODW / 192)) * 192;
          const float* W = wmod + (size_t)l * D * MODW + n0 + cq * 4;
          f32x4 acc[3][3];
#pragma unroll
          for (int c3 = 0; c3 < 3; ++c3)
#pragma unroll
              for (int g = 0; g < 3; ++g) acc[c3][g] = (f32x4){0.f, 0.f, 0.f, 0.f};
          for (int kk = 0; kk < 256; kk += 32) { f32x4 w[8][3];
#pragma unroll
              for (int q = 0; q < 8; ++q)
#pragma unroll
                  for (int c3 = 0; c3 < 3; ++c3) w[q][c3] = *(const GAS f32x4*)(W + (size_t)(wave * 256 + kr + kk + 4 * q) * MODW + c3 * 64);
#pragma unroll
              for (int q = 0; q < 8; ++q) { const int k = wave * 256 + kr + kk + 4 * q; const float s0 = s[k], s1 = s[D + k], s2 = s[2 * D + k];
#pragma unroll
                  for (int c3 = 0; c3 < 3; ++c3) { acc[c3][0] += s0 * w[q][c3]; acc[c3][1] += s1 * w[q][c3]; acc[c3][2] += s2 * w[q][c3]; } } }
#pragma unroll
          for (int c3 = 0; c3 < 3; ++c3)
#pragma unroll
              for (int g = 0; g < 3; ++g)
#pragma unroll
                  for (int j = 0; j < 4; ++j) { float v = acc[c3][g][j]; v += __shfl_xor(v, 16); v += __shfl_xor(v, 32); acc[c3][g][j] = v; }
          if (kr == 0) {
#pragma unroll
              for (int c3 = 0; c3 < 3; ++c3)
#pragma unroll
                  for (int g = 0; g < 3; ++g)
#pragma unroll
                      for (int j = 0; j < 4; ++j) red[(wave * 3 + g) * 192 + c3 * 64 + cq * 4 + j] = acc[c3][g][j]; }
          __syncthreads();
          for (int i = C.tid; i < 3 * 192; i += 512) { const int g = i / 192, n = i % 192; float v = bmod[(size_t)l * MODW + n0 + n];
#pragma unroll
              for (int w = 0; w < 8; ++w) v += red[(w * 3 + g) * 192 + n];
              if (pub) __hip_atomic_store((unsigned*)(mod + ((size_t)l * 3 + g) * MODW + n0 + n), __float_as_uint(v), __ATOMIC_RELAXED, __HIP_MEMORY_SCOPE_AGENT);
              else mod[((size_t)l * 3 + g) * MODW + n0 + n] = v; }
          __syncthreads();
      } }
    if (pub) { asm volatile("s_waitcnt vmcnt(0)" ::: "memory"); if (C.lane == 0) __hip_atomic_fetch_add(pub, 1u, __ATOMIC_RELAXED, __HIP_MEMORY_SCOPE_AGENT); }
}

__device__ __forceinline__ float wsum(float v) {
#pragma unroll
    for (int o = 1; o < 64; o <<= 1) v += __shfl_xor(v, o);
    return v;
}
__device__ __forceinline__ void ph_norm(const Ctx& C, float* X, const float* g, const float* modl, int which, bf16* XN, int lat_only, const float* xin = nullptr, const float* cin = nullptr, const float* part = nullptr, int nsplit = 0, int g0 = 0, unsigned* pub = nullptr) {
    const int gw = C.vcu * 8 + C.wave, NGW = C.G * 8, lane = C.lane;
    for (int grp = g0; grp < (lat_only ? 2 : 3); ++grp) {
        const float* mg = modl + (size_t)grp * MODW + which * 3 * D;
        f32x4 gs[8], sh[8];
#pragma unroll
        for (int j = 0; j < 8; ++j) { const int c4 = j * 64 + lane; gs[j] = ((const GAS f32x4*)g)[c4] * (((const GAS f32x4*)(mg + D))[c4] + 1.0f); sh[j] = ((const GAS f32x4*)mg)[c4]; }
        const int count = grp < 2 ? SEQ : BATCH * CTXL;
        for (int i = gw; i < count; i += NGW) {
            const bool isc = grp == 2;
            const int b_ = isc ? i / CTXL : grp, t_ = isc ? SEQ + i % CTXL : i, r = b_ * TB + t_;
            const float* srow = isc ? (cin ? cin + (size_t)i * D : X + (size_t)r * D) : (xin ? xin + ((size_t)b_ * SEQ + t_) * D : X + (size_t)r * D);
            const GAS f32x4* xr = (const GAS f32x4*)srow;
            f32x4 v[8]; float ss = 0.f;
#pragma unroll
            for (int j = 0; j < 8; ++j) v[j] = xr[j * 64 + lane];
            if (part && isc) {
                for (int sp = 0; sp < nsplit; ++sp) { const GAS f32x4* pr = (const GAS f32x4*)(part + ((size_t)sp * 512 + i) * D);
#pragma unroll
                    for (int j = 0; j < 8; ++j) v[j] += pr[j * 64 + lane]; }
                GAS f32x4* xw = (GAS f32x4*)(X + (size_t)r * D);
#pragma unroll
                for (int j = 0; j < 8; ++j) xw[j * 64 + lane] = v[j]; }
#pragma unroll
            for (int j = 0; j < 8; ++j) ss += v[j].x * v[j].x + v[j].y * v[j].y + v[j].z * v[j].z + v[j].w * v[j].w;
            const float rstd = rsqrtf(wsum(ss) * (1.0f / D) + EPS);
            GAS unsigned long long* o8 = (GAS unsigned long long*)(XN + (size_t)r * D);
#pragma unroll
            for (int j = 0; j < 8; ++j) { const f32x4 y = v[j] * rstd * gs[j] + sh[j];
                if (pub) { unsigned* o4 = (unsigned*)(XN + (size_t)r * D) + 2 * (j * 64 + lane);
                    __hip_atomic_store(o4, pk2(y.x, y.y), __ATOMIC_RELAXED, __HIP_MEMORY_SCOPE_AGENT); __hip_atomic_store(o4 + 1, pk2(y.z, y.w), __ATOMIC_RELAXED, __HIP_MEMORY_SCOPE_AGENT); }
                else o8[j * 64 + lane] = (unsigned long long)pk2(y.x, y.y) | ((unsigned long long)pk2(y.z, y.w) << 32); }
        }
    }
    if (pub) { asm volatile("s_waitcnt vmcnt(0)" ::: "memory"); if (lane == 0) __hip_atomic_fetch_add(pub, 1u, __ATOMIC_RELAXED, __HIP_MEMORY_SCOPE_AGENT); }
}
__device__ __forceinline__ void ph_final(const Ctx& C, const float* X, const float* g, float* out) {
    const int gw = C.vcu * 8 + C.wave, NGW = C.G * 8, lane = C.lane;
    f32x4 gg[8];
#pragma unroll
    for (int j = 0; j < 8; ++j) gg[j] = ((const GAS f32x4*)g)[j * 64 + lane];
    for (int q = gw; q < BATCH * SEQ; q += NGW) {
        const int b = q / SEQ, t = q % SEQ, r = b * TB + t;
        const GAS f32x4* xr = (const GAS f32x4*)(X + (size_t)r * D);
        f32x4 v[8]; float ss = 0.f;
#pragma unroll
        for (int j = 0; j < 8; ++j) { v[j] = xr[j * 64 + lane]; ss += v[j].x * v[j].x + v[j].y * v[j].y + v[j].z * v[j].z + v[j].w * v[j].w; }
        const float rstd = rsqrtf(wsum(ss) * (1.0f / D) + EPS);
        GAS f32x4* o = (GAS f32x4*)(out + (size_t)q * D);
#pragma unroll
        for (int j = 0; j < 8; ++j) o[j * 64 + lane] = v[j] * rstd * gg[j];
    }
}

namespace pg8 {
__device__ __forceinline__ float gelu_tanh_f(float x) {
    const float t = x * (1.0f + 0.044715f * x * x);
    return x * __builtin_amdgcn_rcpf(1.0f + __builtin_amdgcn_exp2f(-2.3022081987f * t));
}
struct EpiGeluStats {
    static constexpr bool PERM = true, AFTER_DRAIN = false;
    bf16_t* O; PG8_LAS const float* bias; float* st;
    __device__ __forceinline__ void quad(const f32x4 (&a)[4][2], const Unit& u, int ai, int bj, int wr, int wc, int fr, int fq) const {
        const int row0 = u.pm * BM + ai * HALF + wr * 64 + fr, col0 = u.pn * BM + bj * HALF + wc * 32 + 8 * fq;
        const f32x4 b0 = *(PG8_LAS const f32x4*)(bias + col0), b1 = *(PG8_LAS const f32x4*)(bias + col0 + 4);
        const bool vhalf = u.pn >= 8;
#pragma unroll
        for (int m = 0; m < 4; ++m) { const int row = row0 + m * 16; float s = 0.f, q = 0.f;
            f32x4 v0 = a[m][0] + b0, v1 = a[m][1] + b1;
#pragma unroll
            for (int j = 0; j < 4; ++j) { v0[j] = gelu_tanh_f(v0[j]); v1[j] = gelu_tanh_f(v1[j]); s += v0[j] + v1[j]; q += v0[j] * v0[j] + v1[j] * v1[j]; }
            u32x4 w; w.x = cvt_pk_bf16(v0[0], v0[1]); w.y = cvt_pk_bf16(v0[2], v0[3]); w.z = cvt_pk_bf16(v1[0], v1[1]); w.w = cvt_pk_bf16(v1[2], v1[3]);
            *(u32x4*)(O + (size_t)row * 4096 + col0) = w;
            if (vhalf) { s += __shfl_xor(s, 16); s += __shfl_xor(s, 32); q += __shfl_xor(q, 16); q += __shfl_xor(q, 32);
                if (fq == 0) { f32x2 o; o.x = s; o.y = q; *(f32x2*)(st + ((size_t)row * 64 + (u.pn - 8) * 8 + bj * 4 + wc) * 2) = o; } } }
    }
    __device__ __forceinline__ void operator()(const f32x4 (&acc)[2][2][4][2], const Unit& u, int wr, int wc, int fr, int fq) const {
        const bool vhalf = u.pn >= 8;
#pragma unroll
        for (int ai = 0; ai < 2; ++ai) {
            float ss[4] = {0.f, 0.f, 0.f, 0.f}, qq[4] = {0.f, 0.f, 0.f, 0.f};
#pragma unroll
            for (int bj = 0; bj < 2; ++bj) {
                const int row0 = u.pm * BM + ai * HALF + wr * 64 + fr, col0 = u.pn * BM + bj * HALF + wc * 32 + 8 * fq;
                const f32x4 b0 = *(PG8_LAS const f32x4*)(bias + col0), b1 = *(PG8_LAS const f32x4*)(bias + col0 + 4);
#pragma unroll
                for (int m = 0; m < 4; ++m) { const int row = row0 + m * 16;
                    f32x4 v0 = acc[ai][bj][m][0] + b0, v1 = acc[ai][bj][m][1] + b1;
#pragma unroll
                    for (int j = 0; j < 4; ++j) { v0[j] = gelu_tanh_f(v0[j]); v1[j] = gelu_tanh_f(v1[j]); ss[m] += v0[j] + v1[j]; qq[m] += v0[j] * v0[j] + v1[j] * v1[j]; }
                    u32x4 w; w.x = cvt_pk_bf16(v0[0], v0[1]); w.y = cvt_pk_bf16(v0[2], v0[3]); w.z = cvt_pk_bf16(v1[0], v1[1]); w.w = cvt_pk_bf16(v1[2], v1[3]);
                    *(u32x4*)(O + (size_t)row * 4096 + col0) = w; } }
            if (vhalf) {
#pragma unroll
                for (int m = 0; m < 4; ++m) { float s = ss[m], q = qq[m]; s += __shfl_xor(s, 16); s += __shfl_xor(s, 32); q += __shfl_xor(q, 16); q += __shfl_xor(q, 32);
                    if (fq == 0) { f32x2 o; o.x = s; o.y = q; *(f32x2*)(st + ((size_t)(u.pm * BM + ai * HALF + wr * 64 + fr + m * 16) * 64 + (u.pn - 8) * 4 + wc) * 2) = o; } } }
        }
    }
};
}

typedef float f32x2 __attribute__((ext_vector_type(2)));
typedef short s16x4_t __attribute__((ext_vector_type(4)));
__device__ __forceinline__ void ph_gmlp_spatial(const Ctx& C, const bf16* Z, const float* st, const float* lng, const bf16* Wsb, const float* bs, bf16* G, int lat_only) {
    LAS unsigned char* Vs = C.lds;
    LAS float* stat = (LAS float*)(C.lds + 128 * 264);
    const int tid = C.tid, lane = C.lane, w = C.wave, fr = lane & 15, fq = lane >> 4;
    const int nchunk = lat_only ? (BATCH * SEQ / CHUNK) : (NR / CHUNK), nunits = nchunk * GG;
    LAS unsigned char* Wl = C.lds + 40960;
    LAS unsigned char* Ol = C.lds + 77824;
    int gl = -1;
    for (int un = C.vcu; un < nunits; un += C.G) {
        if (un % GG != gl) { gl = un % GG; __syncthreads();
            const bf16* wsrc = Wsb + (size_t)gl * 128 * 128;
#pragma unroll
            for (int it = 0; it < 4; ++it) { const int idx = it * 512 + tid, p = idx >> 4, c8 = idx & 15;
                *(LAS v4u*)(Wl + p * 272 + c8 * 16) = *(const GAS v4u*)(wsrc + (size_t)p * 128 + c8 * 8); } }
        const int g = un % GG, chl = un / GG; const int ch = lat_only ? chl + 2 * (chl / 64) : chl;
        const int r0 = ch * CHUNK;
        const int c8 = tid & 15; v4u raw[4];
#pragma unroll
        for (int it = 0; it < 4; ++it) raw[it] = *(const GAS v4u*)(Z + (size_t)(r0 + it * 32 + (tid >> 4)) * 4096 + GW + g * GC + c8 * 8);
        const bool cx = (r0 % TB) >= SEQ; f32x4 sp0[4], sp1[4];
#pragma unroll
        for (int it = 0; it < 4; ++it) { const GAS f32x4* p = (const GAS f32x4*)(st + (size_t)(r0 + it * 32 + (tid >> 4)) * 128); sp0[it] = p[c8]; sp1[it] = cx ? p[16 + c8] : (f32x4){0.f, 0.f, 0.f, 0.f}; }
        __syncthreads();
        float mean4[4], rstd4[4];
#pragma unroll
        for (int it = 0; it < 4; ++it) { float s = (sp0[it].x + sp0[it].z) + (sp1[it].x + sp1[it].z), q = (sp0[it].y + sp0[it].w) + (sp1[it].y + sp1[it].w);
#pragma unroll
            for (int o = 1; o < 16; o <<= 1) { s += __shfl_xor(s, o); q += __shfl_xor(q, o); }
            const float mean = s * (1.0f / GW), var = q * (1.0f / GW) - mean * mean; mean4[it] = mean; rstd4[it] = rsqrtf(fmaxf(var, 0.f) + EPS); }
        {   const f32x4 g0 = *(const GAS f32x4*)(lng + g * GC + c8 * 8), g1 = *(const GAS f32x4*)(lng + g * GC + c8 * 8 + 4);
#pragma unroll
            for (int it = 0; it < 4; ++it) { const int q = it * 32 + (tid >> 4);
                const float mean = mean4[it], rstd = rstd4[it];
                float x[8];
#pragma unroll
                for (int j = 0; j < 4; ++j) { x[2 * j] = __builtin_bit_cast(float, raw[it][j] << 16); x[2 * j + 1] = __builtin_bit_cast(float, raw[it][j] & 0xffff0000u); }
                unsigned o0 = pk2((x[0] - mean) * rstd * g0.x, (x[1] - mean) * rstd * g0.y), o1 = pk2((x[2] - mean) * rstd * g0.z, (x[3] - mean) * rstd * g0.w);
                unsigned o2 = pk2((x[4] - mean) * rstd * g1.x, (x[5] - mean) * rstd * g1.y), o3 = pk2((x[6] - mean) * rstd * g1.z, (x[7] - mean) * rstd * g1.w);
                LAS unsigned long long* d = (LAS unsigned long long*)(Vs + q * 264 + c8 * 16);
                d[0] = (unsigned long long)o0 | ((unsigned long long)o1 << 32); d[1] = (unsigned long long)o2 | ((unsigned long long)o3 << 32); } }
        v4u uraw[4];
#pragma unroll
        for (int it = 0; it < 4; ++it) uraw[it] = *(const GAS v4u*)(Z + (size_t)(r0 + it * 32 + (tid >> 4)) * 4096 + g * GC + c8 * 8);
        float bv[4];
#pragma unroll
        for (int it = 0; it < 4; ++it) bv[it] = *(const GAS float*)(bs + g * CHUNK + it * 32 + (tid >> 4));
        __syncthreads();
        bf16x8 af[4];
        {   const int ab = (int)(unsigned)(size_t)Vs + (8 * fq + (fr >> 2)) * 264 + 32 * w + 8 * (fr & 3);
            s16x4_t tl[4], th[4];
#pragma unroll
            for (int ks = 0; ks < 4; ++ks) { asm volatile("ds_read_b64_tr_b16 %0, %1" : "=&v"(tl[ks]) : "v"(ab + ks * 32 * 264) : "memory");
                                             asm volatile("ds_read_b64_tr_b16 %0, %1" : "=&v"(th[ks]) : "v"(ab + ks * 32 * 264 + 4 * 264) : "memory"); }
            asm volatile("s_waitcnt lgkmcnt(0)" ::: "memory");
#pragma unroll
            for (int ks = 0; ks < 4; ++ks) af[ks] = (bf16x8){tl[ks][0], tl[ks][1], tl[ks][2], tl[ks][3], th[ks][0], th[ks][1], th[ks][2], th[ks][3]}; }
#pragma unroll
        for (int pt = 0; pt < 8; ++pt) {
            f32x4 acc = {0.f, 0.f, 0.f, 0.f};
#pragma unroll
            for (int ks = 0; ks < 4; ++ks) { const bf16x8 bfrag = *(const LAS bf16x8*)(Wl + (16 * pt + fr) * 272 + 64 * ks + 16 * fq);
                acc = __builtin_amdgcn_mfma_f32_16x16x32_bf16(af[ks], bfrag, acc, 0, 0, 0); }
            *(LAS f32x4*)(Ol + (16 * pt + fr) * 528 + (16 * w + 4 * fq) * 4) = acc;
        }
        __syncthreads();
#pragma unroll
        for (int it = 0; it < 4; ++it) { const int p = it * 32 + (tid >> 4);
            const f32x4 s0 = *(const LAS f32x4*)(Ol + p * 528 + c8 * 32), s1 = *(const LAS f32x4*)(Ol + p * 528 + c8 * 32 + 16);
            const float b = bv[it];
            float u[8];
#pragma unroll
            for (int j = 0; j < 4; ++j) { u[2 * j] = __builtin_bit_cast(float, uraw[it][j] << 16); u[2 * j + 1] = __builtin_bit_cast(float, uraw[it][j] & 0xffff0000u); }
            v4u o; o.x = pk2(u[0] * (s0.x + b), u[1] * (s0.y + b)); o.y = pk2(u[2] * (s0.z + b), u[3] * (s0.w + b)); o.z = pk2(u[4] * (s1.x + b), u[5] * (s1.y + b)); o.w = pk2(u[6] * (s1.z + b), u[7] * (s1.w + b));
            *(GAS v4u*)(G + (size_t)(r0 + p) * GW + g * GC + c8 * 8) = o; }
    }
    __syncthreads();
}

namespace att {
using bf16x8 = __attribute__((ext_vector_type(8))) short;
using s16x4  = __attribute__((ext_vector_type(4))) short;
using f32x16 = __attribute__((ext_vector_type(16))) float;
using u32x4  = __attribute__((ext_vector_type(4))) unsigned;
typedef unsigned short bf16;
constexpr int KVBLK = 64, QBLK = 32, NW = 8;
constexpr float THR = 8.f;
#define ATT_KSWZ(row, colB) ((row) * 256 + ((colB) ^ (((row) & 7) << 4)))
#define ATT_SBAR() __builtin_amdgcn_sched_barrier(0)
__device__ __forceinline__ int crow(int r, int hi) { return (r & 3) + 8 * (r >> 2) + 4 * hi; }
__device__ __forceinline__ unsigned cvtpk(float lo, float hi) { unsigned r; asm volatile("v_cvt_pk_bf16_f32 %0, %1, %2" : "=v"(r) : "v"(lo), "v"(hi)); return r; }

__device__ __forceinline__ void partialSM(f32x16& p0, f32x16& p1, float& m_reg, float& mn, float& alpha, float Cs, float thr) {
  float pmax = p0[0];
#pragma unroll
  for (int r = 1; r < 16; ++r) pmax = fmaxf(pmax, p0[r]);
#pragma unroll
  for (int r = 0; r < 16; ++r) pmax = fmaxf(pmax, p1[r]);
  { auto rr = __builtin_amdgcn_permlane32_swap(__float_as_uint(pmax), __float_as_uint(pmax), false, false);
    pmax = fmaxf(__uint_as_float(rr[0]), __uint_as_float(rr[1])); }
  if (__builtin_expect(__all(pmax - m_reg <= thr), 1)) { mn = m_reg; alpha = 1.f; }
  else { mn = fmaxf(m_reg, pmax); alpha = __builtin_amdgcn_exp2f((m_reg - mn) * Cs); m_reg = mn; }
  float mnC = -mn * Cs;
#pragma unroll
  for (int r = 0; r < 16; ++r) p0[r] = fmaf(p0[r], Cs, mnC);
#pragma unroll
  for (int r = 0; r < 16; ++r) p1[r] = fmaf(p1[r], Cs, mnC);
#pragma unroll
  for (int r = 0; r < 16; ++r) p0[r] = __builtin_amdgcn_exp2f(p0[r]);
}
__device__ __forceinline__ void finishSM(f32x16& p0, f32x16& p1, float alpha, float& l_reg, bf16x8& pa0, bf16x8& pa1, bf16x8& pa2, bf16x8& pa3) {
#pragma unroll
  for (int r = 0; r < 16; ++r) p1[r] = __builtin_amdgcn_exp2f(p1[r]);
  float ps = 0;
#pragma unroll
  for (int r = 0; r < 16; ++r) ps += p0[r];
#pragma unroll
  for (int r = 0; r < 16; ++r) ps += p1[r];
  { auto rr = __builtin_amdgcn_permlane32_swap(__float_as_uint(ps), __float_as_uint(ps), false, false);
    ps = __uint_as_float(rr[0]) + __uint_as_float(rr[1]); }
  l_reg = l_reg * alpha + ps;
#define ATT_PK4(P, BASE, OUT) do { unsigned a0 = cvtpk(P[BASE + 0], P[BASE + 1]), a1 = cvtpk(P[BASE + 2], P[BASE + 3]);   \
    unsigned b0 = cvtpk(P[BASE + 4], P[BASE + 5]), b1 = cvtpk(P[BASE + 6], P[BASE + 7]);                              \
    auto r0 = __builtin_amdgcn_permlane32_swap(a0, b0, false, false); auto r1 = __builtin_amdgcn_permlane32_swap(a1, b1, false, false); \
    u32x4 w = {r0[0], r1[0], r0[1], r1[1]}; OUT = *reinterpret_cast<bf16x8*>(&w); } while (0)
  ATT_PK4(p0, 0, pa0); ATT_PK4(p0, 8, pa1); ATT_PK4(p1, 0, pa2); ATT_PK4(p1, 8, pa3);
#undef ATT_PK4
}
__device__ __forceinline__ int v_st(int k, int c) { const int kk = (k & ~0xC) | ((k & 4) << 1) | ((k & 8) >> 1); return ((kk >> 3) * 4 + (c >> 5)) * 512 + ((kk & 7) * 32 + (c & 31)) * 2; }
__device__ __forceinline__ int v_rd_base(int lane) { return ((lane & 3) << 3) | (((lane >> 2) & 3) << 6) | (((lane >> 4) & 1) << 5) | (((lane >> 5) & 1) << 8); }
constexpr int v_rd_off(int d0, int ks, int half) { return d0 * 512 + ks * 4096 + half * 2048; }
template <int OFF> __device__ __forceinline__ s16x4 tr_read(int vb) {
  s16x4 r; asm volatile("ds_read_b64_tr_b16 %0, %1 offset:%2" : "=&v"(r) : "v"(vb), "i"(OFF) : "memory"); return r;
}
template <int D0> __device__ __forceinline__ void pv_one(f32x16& od, int vb, bf16x8 pa0, bf16x8 pa1, bf16x8 pa2, bf16x8 pa3) {
  const s16x4 l0 = tr_read<v_rd_off(D0, 0, 0)>(vb), h0 = tr_read<v_rd_off(D0, 0, 1)>(vb), l1 = tr_read<v_rd_off(D0, 1, 0)>(vb), h1 = tr_read<v_rd_off(D0, 1, 1)>(vb);
  const s16x4 l2 = tr_read<v_rd_off(D0, 2, 0)>(vb), h2 = tr_read<v_rd_off(D0, 2, 1)>(vb), l3 = tr_read<v_rd_off(D0, 3, 0)>(vb), h3 = tr_read<v_rd_off(D0, 3, 1)>(vb);
  asm volatile("s_waitcnt lgkmcnt(0)" ::: "memory"); ATT_SBAR();
#define ATT_PK(L, H) (bf16x8){L[0], L[1], L[2], L[3], H[0], H[1], H[2], H[3]}
  od = __builtin_amdgcn_mfma_f32_32x32x16_bf16(pa0, ATT_PK(l0, h0), od, 0, 0, 0);
  od = __builtin_amdgcn_mfma_f32_32x32x16_bf16(pa1, ATT_PK(l1, h1), od, 0, 0, 0);
  od = __builtin_amdgcn_mfma_f32_32x32x16_bf16(pa2, ATT_PK(l2, h2), od, 0, 0, 0);
  od = __builtin_amdgcn_mfma_f32_32x32x16_bf16(pa3, ATT_PK(l3, h3), od, 0, 0, 0);
#undef ATT_PK
}
__device__ __forceinline__ void pv_d0(f32x16* o, int vb, bf16x8 pa0, bf16x8 pa1, bf16x8 pa2, bf16x8 pa3) {
  pv_one<0>(o[0], vb, pa0, pa1, pa2, pa3); pv_one<1>(o[1], vb, pa0, pa1, pa2, pa3); pv_one<2>(o[2], vb, pa0, pa1, pa2, pa3); pv_one<3>(o[3], vb, pa0, pa1, pa2, pa3);
}
constexpr size_t SHM_V = KVBLK * 128 * 2, SHM_K = KVBLK * 128 * 2, SHM_ATTN = 2 * SHM_V + 2 * SHM_K + NW * 64 * 4;

}

namespace pg8 {
struct EpiQkvRope {
    static constexpr bool PERM = true, AFTER_DRAIN = false;
    bf16_t* O; const float* tab; PG8_LAS const _Float16* tl;
    __device__ __forceinline__ void quad(const f32x4 (&a)[4][2], const Unit& u, int ai, int bj, int wr, int wc, int fr, int fq) const {
        const int row0 = u.pm * BM + ai * HALF + wr * 64 + fr, col0 = u.pn * BM + bj * HALF + wc * 32 + 8 * fq;
        const bool rope = (u.pn < 16) && ((u.pm % 33) != 32);
        const int half = wc >> 1, f0 = 16 * (wc & 1) + 4 * fq;
#pragma unroll
        for (int m = 0; m < 4; ++m) { const int row = row0 + m * 16;
            f32x4 cs = {1.f, 1.f, 1.f, 1.f}, sn = {0.f, 0.f, 0.f, 0.f};
            if (rope) { const int t = row % TB, pos = half ? (t % GRID_W) : (t / GRID_W);
                typedef _Float16 h16x4 __attribute__((ext_vector_type(4)));
                const h16x4 ch = *(PG8_LAS const h16x4*)(tl + pos * 32 + f0), sh = *(PG8_LAS const h16x4*)(tl + 4096 + pos * 32 + f0);
                cs = (f32x4){(float)ch[0], (float)ch[1], (float)ch[2], (float)ch[3]}; sn = (f32x4){(float)sh[0], (float)sh[1], (float)sh[2], (float)sh[3]}; }
            const f32x4 v0 = a[m][0], v1 = a[m][1];
            const float a0 = v0[0] * cs[0] - v0[1] * sn[0], b0 = v0[1] * cs[0] + v0[0] * sn[0], a1 = v0[2] * cs[1] - v0[3] * sn[1], b1 = v0[3] * cs[1] + v0[2] * sn[1];
            const float a2 = v1[0] * cs[2] - v1[1] * sn[2], b2 = v1[1] * cs[2] + v1[0] * sn[2], a3 = v1[2] * cs[3] - v1[3] * sn[3], b3 = v1[3] * cs[3] + v1[2] * sn[3];
            u32x4 w; w.x = cvt_pk_bf16(a0, b0); w.y = cvt_pk_bf16(a1, b1); w.z = cvt_pk_bf16(a2, b2); w.w = cvt_pk_bf16(a3, b3);
            *(u32x4*)(O + (size_t)row * 6144 + col0) = w; }
    }
    __device__ __forceinline__ void operator()(const f32x4 (&acc)[2][2][4][2], const Unit& u, int wr, int wc, int fr, int fq) const {
#pragma unroll
        for (int ai = 0; ai < 2; ++ai)
#pragma unroll
            for (int bj = 0; bj < 2; ++bj) quad(acc[ai][bj], u, ai, bj, wr, wc, fr, fq);
    }
};
}

__device__ __forceinline__ void ph_diff_combine(const Ctx& C, const bf16* O, const float* lq1, const float* lk1, const float* lq2, const float* lk2, const float* subg, float lambda_init, bf16* ON) {
    const int gw = C.vcu * 8 + C.wave, NGW = C.G * 8, lane = C.lane, l32 = lane & 31;
    float d1 = lq1[lane] * lk1[lane] + lq1[lane + 64] * lk1[lane + 64], d2 = lq2[lane] * lk2[lane] + lq2[lane + 64] * lk2[lane + 64];
    d1 = wsum(d1); d2 = wsum(d2);
    const float lam = expf(d1) - expf(d2) + lambda_init;
    const f32x4 g0 = *(const GAS f32x4*)(subg + l32 * 8), g1 = *(const GAS f32x4*)(subg + l32 * 8 + 4);
    for (int r = gw; r < NR; r += NGW) {
        v4u raw[DH];
#pragma unroll
        for (int h = 0; h < DH; ++h) raw[h] = *(const GAS v4u*)(O + (size_t)r * 4096 + h * 512 + lane * 8);
#pragma unroll
        for (int h = 0; h < DH; ++h) {
            float v[8]; float ss = 0.f;
#pragma unroll
            for (int j = 0; j < 4; ++j) { const unsigned mine = raw[h][j], other = (unsigned)__shfl((int)mine, l32 + 32);
                const float a0 = __builtin_bit_cast(float, mine << 16), a1 = __builtin_bit_cast(float, mine & 0xffff0000u), b0 = __builtin_bit_cast(float, other << 16), b1 = __builtin_bit_cast(float, other & 0xffff0000u);
                v[2 * j] = a0 - lam * b0; v[2 * j + 1] = a1 - lam * b1; ss += v[2 * j] * v[2 * j] + v[2 * j + 1] * v[2 * j + 1]; }
#pragma unroll
            for (int o = 1; o < 32; o <<= 1) ss += __shfl_xor(ss, o);
            const float k = rsqrtf(ss * (1.0f / 256) + EPS) * (1.0f - lambda_init);
            v4u ow; ow.x = pk2(v[0] * k * g0.x, v[1] * k * g0.y); ow.y = pk2(v[2] * k * g0.z, v[3] * k * g0.w); ow.z = pk2(v[4] * k * g1.x, v[5] * k * g1.y); ow.w = pk2(v[6] * k * g1.z, v[7] * k * g1.w);
            if (lane < 32) *(GAS v4u*)(ON + (size_t)r * 2048 + h * 256 + l32 * 8) = ow;
        }
    }
}

namespace att {
constexpr int NQR2 = 4;
constexpr int D2_K = 0, D2_V = 2 * 16384, D2_Q = D2_V + 2 * 32768, D2_WS = D2_Q + NW * (8 - NQR2) * 1024, SHM_D2 = D2_WS + NW * 64 * 4;
constexpr int v_rd_off2(int d0, int ks, int half) { return d0 * 512 + ks * 8192 + half * 4096; }
template <int D0, int SLOT> __device__ __forceinline__ void pv_one2(f32x16& od, int vb, bf16x8 pa0, bf16x8 pa1, bf16x8 pa2, bf16x8 pa3) {
  constexpr int B = SLOT * 32768;
  const s16x4 l0 = tr_read<B + v_rd_off2(D0, 0, 0)>(vb), h0 = tr_read<B + v_rd_off2(D0, 0, 1)>(vb), l1 = tr_read<B + v_rd_off2(D0, 1, 0)>(vb), h1 = tr_read<B + v_rd_off2(D0, 1, 1)>(vb);
  const s16x4 l2 = tr_read<B + v_rd_off2(D0, 2, 0)>(vb), h2 = tr_read<B + v_rd_off2(D0, 2, 1)>(vb), l3 = tr_read<B + v_rd_off2(D0, 3, 0)>(vb), h3 = tr_read<B + v_rd_off2(D0, 3, 1)>(vb);
  asm volatile("s_waitcnt lgkmcnt(0)" ::: "memory"); ATT_SBAR();
#define ATT_PK(L, H) (bf16x8){L[0], L[1], L[2], L[3], H[0], H[1], H[2], H[3]}
  od = __builtin_amdgcn_mfma_f32_32x32x16_bf16(pa0, ATT_PK(l0, h0), od, 0, 0, 0);
  od = __builtin_amdgcn_mfma_f32_32x32x16_bf16(pa1, ATT_PK(l1, h1), od, 0, 0, 0);
  od = __builtin_amdgcn_mfma_f32_32x32x16_bf16(pa2, ATT_PK(l2, h2), od, 0, 0, 0);
  od = __builtin_amdgcn_mfma_f32_32x32x16_bf16(pa3, ATT_PK(l3, h3), od, 0, 0, 0);
#undef ATT_PK
}
__device__ __forceinline__ void qkt2(f32x16& p0, f32x16& p1, const char* Ks, const int (&kb)[4], const bf16x8* qr, const char* qrl) {
  p0 = f32x16{}; p1 = f32x16{};
#pragma unroll
  for (int d0 = 0; d0 < 8; ++d0) {
    bf16x8 b0 = *reinterpret_cast<const bf16x8*>(Ks + kb[d0 & 3] + (d0 >> 2) * 128);
    bf16x8 b1 = *reinterpret_cast<const bf16x8*>(Ks + kb[d0 & 3] + (d0 >> 2) * 128 + 8192);
    bf16x8 q; if (d0 < NQR2) q = qr[d0]; else q = *reinterpret_cast<const bf16x8*>(qrl + (d0 - NQR2) * 1024);
    p0 = __builtin_amdgcn_mfma_f32_32x32x16_bf16(b0, q, p0, 0, 0, 0);
    p1 = __builtin_amdgcn_mfma_f32_32x32x16_bf16(b1, q, p1, 0, 0, 0); }
}
__device__ unsigned g_ctxa[16 * 64];
template <int LDQ, int LDK, int LDV, int LDO, int MODE>
__device__ __forceinline__ void attn_dv256_body(const bf16* __restrict__ Qb, const bf16* __restrict__ Kh, const bf16* __restrict__ Vh, bf16* __restrict__ Ob, float* __restrict__ S1, float lam, const float* __restrict__ subg, float osc,
                                                int seq, char* lds, LAS unsigned char* ldsL, float scale, bool xwait = false) {
  const float Cs = scale * 1.4426950408889634f, thr = THR / scale;
  const int tid = threadIdx.x, wid = __builtin_amdgcn_readfirstlane(tid >> 6), lane = tid & 63, r32 = lane & 31, hi = lane >> 5;
  float* ws = (float*)(lds + D2_WS) + wid * 64; float* li_l = ws; float* al_l = ws + 32;
  const char* qrl = lds + D2_Q + wid * (8 - NQR2) * 1024 + lane * 16;
  float m_reg = -1e30f, l_reg = 0; f32x16 o[8] = {}; bf16x8 qr[NQR2 > 0 ? NQR2 : 1];
  { int t1 = threadIdx.x; asm volatile("" : "+v"(t1));
    const int w1 = t1 >> 6, l1 = t1 & 63;
    const bf16* Qw = Qb + (long)(w1 * QBLK + (l1 & 31)) * LDQ + (l1 >> 5) * 8;
    char* ql1 = lds + D2_Q + w1 * (8 - NQR2) * 1024 + l1 * 16;
#pragma unroll
    for (int d0 = 0; d0 < NQR2; ++d0) qr[d0] = *reinterpret_cast<const bf16x8*>(Qw + d0 * 16);
#pragma unroll
    for (int d0 = NQR2; d0 < 8; ++d0) *reinterpret_cast<bf16x8*>(ql1 + (d0 - NQR2) * 1024) = *reinterpret_cast<const bf16x8*>(Qw + d0 * 16); }
  unsigned ko[2], vo[4];
#pragma unroll
  for (int i = 0; i < 2; ++i) { const int ch = (wid * 2 + i) * 64 + lane, row = ch >> 4, cpos = ch & 15; ko[i] = (unsigned)(row * LDK + ((cpos ^ (row & 7)) * 8)) * 2u; }
#pragma unroll
  for (int i = 0; i < 4; ++i) { const int ch = (wid * 4 + i) * 64 + lane, st = ch >> 5, w16 = ch & 31, kk = ((st >> 3) << 3) | (w16 >> 2), k = (kk & ~0xC) | ((kk & 4) << 1) | ((kk & 8) >> 1), col = (st & 7) * 32 + (w16 & 3) * 8;
    vo[i] = (unsigned)(k * LDV + col) * 2u; }
  int kb[4];
#pragma unroll
  for (int k = 0; k < 4; ++k) kb[k] = r32 * 256 + (((hi << 4) ^ ((r32 & 7) << 4)) ^ (k << 5));
  const int vb0 = (int)(uintptr_t)(lds + D2_V) + v_rd_base(lane);
#define D2_DMA(slot, k0) do { const char* kt_ = (const char*)Kh + (size_t)(k0) * (LDK * 2); const char* vt_ = (const char*)Vh + (size_t)(k0) * (LDV * 2); \
    _Pragma("unroll") for (int i_ = 0; i_ < 2; ++i_) __builtin_amdgcn_global_load_lds((const unsigned*)(kt_ + ko[i_]), (LAS unsigned*)(ldsL + D2_K + (slot) * 16384 + (wid * 2 + i_) * 1024), 16, 0, 0); \
    _Pragma("unroll") for (int i_ = 0; i_ < 4; ++i_) __builtin_amdgcn_global_load_lds((const unsigned*)(vt_ + vo[i_]), (LAS unsigned*)(ldsL + D2_V + (slot) * 32768 + (wid * 4 + i_) * 1024), 16, 0, 0); } while (0)
#define D2_RESC(a) do { if (__any((a) < 1.f)) { if (hi == 0) al_l[r32] = (a); asm volatile("s_waitcnt lgkmcnt(0)" ::: "memory"); \
    _Pragma("unroll") for (int d = 0; d < 8; ++d) _Pragma("unroll") for (int r = 0; r < 16; ++r) o[d][r] *= al_l[crow(r, hi)]; } } while (0)
#define D2_TILE(slot, jj) do { \
    asm volatile("s_waitcnt vmcnt(0)" ::: "memory"); __builtin_amdgcn_s_barrier(); asm volatile("" ::: "memory");        \
    if ((jj) + 1 < NT) D2_DMA(1 - (slot), ((jj) + 1) * KVBLK); \
    f32x16 p0, p1; float mn, al; bf16x8 pa0, pa1, pa2, pa3; \
    ATT_SBAR(); qkt2(p0, p1, lds + D2_K + (slot) * 16384, kb, qr, qrl); \
    partialSM(p0, p1, m_reg, mn, al, Cs, thr); D2_RESC(al); \
    finishSM(p0, p1, al, l_reg, pa0, pa1, pa2, pa3); ATT_SBAR(); \
    pv_one2<0, slot>(o[0], vb0, pa0, pa1, pa2, pa3); pv_one2<1, slot>(o[1], vb0, pa0, pa1, pa2, pa3); pv_one2<2, slot>(o[2], vb0, pa0, pa1, pa2, pa3); pv_one2<3, slot>(o[3], vb0, pa0, pa1, pa2, pa3); \
    pv_one2<4, slot>(o[4], vb0, pa0, pa1, pa2, pa3); pv_one2<5, slot>(o[5], vb0, pa0, pa1, pa2, pa3); pv_one2<6, slot>(o[6], vb0, pa0, pa1, pa2, pa3); pv_one2<7, slot>(o[7], vb0, pa0, pa1, pa2, pa3); } while (0)
  const int NT = seq / KVBLK;
  D2_DMA(0, 0);
  for (int j = 0; j < NT; j += 2) { D2_TILE(0, j); D2_TILE(1, j + 1); }
  if (hi == 0) li_l[r32] = l_reg; asm volatile("s_waitcnt lgkmcnt(0)" ::: "memory");
  { int t2 = threadIdx.x; asm volatile("" : "+v"(t2));
    const int w2 = t2 >> 6, l2 = t2 & 63, r2 = l2 & 31, h2 = l2 >> 5;
    const float* li2 = (const float*)(lds + D2_WS) + w2 * 64;
    float* Sw = S1 + (w2 * QBLK) * 256 + r2;
    if constexpr (MODE == 0) {
#pragma unroll
      for (int r = 0; r < 16; ++r) { const int orow = crow(r, h2); const float rl = __builtin_amdgcn_rcpf(li2[orow]);
#pragma unroll
        for (int d0 = 0; d0 < 8; ++d0) __hip_atomic_store((unsigned*)(Sw + orow * 256 + d0 * 32), __float_as_uint(o[d0][r] * rl), __ATOMIC_RELAXED, __HIP_MEMORY_SCOPE_AGENT); }
    } else {
      if (xwait) {
        if (w2 == 0) { const int bx = (int)blockIdx.x, G_ = (int)gridDim.x, vc = (bx % 8) * (G_ / 8) + bx / 8; unsigned* xw = g_ctxa + (vc >> 1) * 64; unsigned sp = 0;
          for (;;) { if ((unsigned)__builtin_amdgcn_readfirstlane(__hip_atomic_load(xw, __ATOMIC_RELAXED, __HIP_MEMORY_SCOPE_AGENT)) >= 8u) break; __builtin_amdgcn_s_sleep(2); if (++sp > (1u << 20)) break; }
          __builtin_amdgcn_fence(__ATOMIC_ACQUIRE, "agent"); asm volatile("s_waitcnt vmcnt(0)" ::: "memory"); }
        __builtin_amdgcn_s_barrier(); asm volatile("" ::: "memory"); }
      bf16* Ow = Ob + (long)(w2 * QBLK) * LDO + r2;
      float sg[8];
#pragma unroll
      for (int d0 = 0; d0 < 8; ++d0) sg[d0] = subg[d0 * 32 + r2] * osc;
#pragma unroll
      for (int r = 0; r < 16; ++r) { const int orow = crow(r, h2); const float rl = __builtin_amdgcn_rcpf(li2[orow]) * lam;
        float dv[8]; float ss = 0.f;
#pragma unroll
        for (int d0 = 0; d0 < 8; ++d0) { dv[d0] = Sw[orow * 256 + d0 * 32] - o[d0][r] * rl; ss += dv[d0] * dv[d0]; }
#pragma unroll
        for (int sh = 1; sh < 32; sh <<= 1) ss += __shfl_xor(ss, sh);
        const float kk = rsqrtf(ss * (1.0f / 256) + EPS);
#pragma unroll
        for (int d0 = 0; d0 < 8; ++d0) Ow[(long)orow * LDO + d0 * 32] = (bf16)::f2bf(dv[d0] * kk * sg[d0]); } } }
  asm volatile("s_waitcnt vmcnt(0) lgkmcnt(0)" ::: "memory"); __builtin_amdgcn_s_barrier(); asm volatile("" ::: "memory");
#undef D2_DMA
#undef D2_RESC
#undef D2_TILE
}
}

__device__ __forceinline__ void ph_diff_attn3(const Ctx& C, const bf16* QKV, float* S1g, const float* lq1, const float* lk1, const float* lq2, const float* lk2, const float* subg, float lambda_init, bf16* ON, float* S1c = nullptr) {
    const float scale = 0.08838834764831845f;
    const int lane = C.lane;
    float d1 = lq1[lane] * lk1[lane] + lq1[lane + 64] * lk1[lane + 64], d2 = lq2[lane] * lk2[lane] + lq2[lane + 64] * lk2[lane + 64];
    d1 = wsum(d1); d2 = wsum(d2);
    const float lam = expf(d1) - expf(d2) + lambda_init, osc = 1.0f - lambda_init;
    constexpr int NLAT = BATCH * DH * (SEQ / 256), NUN = NLAT + BATCH * DH;
    const bool split = (S1c != nullptr);
    bool ctxdone = false;
    for (int u = C.vcu; ; u += C.G) {
        const bool isctx = u >= NLAT; int combo, qb, md = 2;
        if (!isctx) { combo = u >> 5; qb = u & 31; }
        else if (split) { if (C.vcu >= 2 * BATCH * DH || ctxdone) break; combo = C.vcu >> 1; md = C.vcu & 1; qb = 32; ctxdone = true; }
        else { if (u >= NUN) break; combo = u - NLAT; qb = 32; }
        const int h = combo & (DH - 1), b = combo / DH;
        const size_t qrow = (size_t)b * TB + (size_t)qb * 256, krow = (size_t)b * TB + (isctx ? SEQ : 0);
        const att::bf16* Qp = (const att::bf16*)QKV + qrow * NQKV + h * 256; const att::bf16* Kp = (const att::bf16*)QKV + krow * NQKV + 2048 + h * 256; const att::bf16* Vp = (const att::bf16*)QKV + krow * NQKV + 4096 + h * 256;
        float* S1 = (isctx && split) ? S1c + (size_t)combo * 256 * 256 : S1g + (size_t)C.vcu * 256 * 256;
        if (md != 1) { att::attn_dv256_body<NQKV, NQKV, NQKV, 2048, 0>(Qp, Kp, Vp, nullptr, S1, lam, subg, osc, isctx ? CTXL : TB, (char*)C.lds, C.lds, scale);
            if (md == 0) { int t9 = threadIdx.x; asm volatile("" : "+v"(t9)); if ((t9 & 63) == 0) __hip_atomic_fetch_add(att::g_ctxa + combo * 64, 1u, __ATOMIC_RELAXED, __HIP_MEMORY_SCOPE_AGENT); } }
        if (md != 0) att::attn_dv256_body<NQKV, NQKV, NQKV, 2048, 1>(Qp + 128, Kp + 128, Vp, (att::bf16*)ON + qrow * 2048 + h * 256, S1, lam, subg, osc, isctx ? CTXL : TB, (char*)C.lds, C.lds, scale, md == 1);
    }
}

namespace att {
constexpr size_t SHM_K2 = KVBLK * 192 * 2;
constexpr size_t MLA_OFF_K = 2 * SHM_V, MLA_OFF_WS = MLA_OFF_K + 2 * SHM_K2, MLA_OFF_QR = MLA_OFF_WS + NW * 64 * 4, SHM_MLA = MLA_OFF_QR + NW * 4 * 1024;
#define ATT_KSWZ2(row, colB) ((row) * 384 + ((colB) ^ (((row) & 7) << 4)))
constexpr int NQREG = 8;
__device__ __forceinline__ void qkt192(f32x16& p0, f32x16& p1, const char* Ks, const int (&kb)[4], const bf16x8* qr, const char* qrl) {
  p0 = f32x16{}; p1 = f32x16{};
#pragma unroll
  for (int d0 = 0; d0 < 12; ++d0) {
    bf16x8 b0 = *reinterpret_cast<const bf16x8*>(Ks + kb[d0 & 3] + (d0 >> 2) * 128);
    bf16x8 b1 = *reinterpret_cast<const bf16x8*>(Ks + kb[d0 & 3] + (d0 >> 2) * 128 + 32 * 384);
    bf16x8 q; if (d0 < NQREG) q = qr[d0]; else q = *reinterpret_cast<const bf16x8*>(qrl + (d0 - NQREG) * 1024);
    p0 = __builtin_amdgcn_mfma_f32_32x32x16_bf16(b0, q, p0, 0, 0, 0);
    p1 = __builtin_amdgcn_mfma_f32_32x32x16_bf16(b1, q, p1, 0, 0, 0); }
}
template <int LDQ, int LDKN, int LDKR, int LDO>
__device__ __forceinline__ void attn_mla_body(const bf16* __restrict__ Qb, const bf16* __restrict__ Kn, const bf16* __restrict__ Kr, bf16* __restrict__ Ob, int seq, char* lds, float scale) {
  const float Cs = scale * 1.4426950408889634f, thr = THR / scale;
  const int tid = threadIdx.x, wid = tid >> 6, lane = tid & 63, r32 = lane & 31, hi = lane >> 5;
  bf16* V_lds = (bf16*)lds; bf16* K_lds = (bf16*)(lds + MLA_OFF_K);
  float* ws = (float*)(lds + MLA_OFF_WS) + wid * 64; float* li_l = ws; float* al_l = ws + 32;
  char* qrl = lds + MLA_OFF_QR + wid * (12 - NQREG) * 1024 + lane * 16;
  float m_reg = -1e30f, l_reg = 0; f32x16 o[4] = {}; bf16x8 qr[NQREG > 0 ? NQREG : 1];
  { int t1 = threadIdx.x; asm volatile("" : "+v"(t1));
    const int w1 = t1 >> 6, l1 = t1 & 63;
    const bf16* Qw = Qb + (long)(w1 * QBLK + (l1 & 31)) * LDQ + (l1 >> 5) * 8;
    char* ql1 = lds + MLA_OFF_QR + w1 * (12 - NQREG) * 1024 + l1 * 16;
#pragma unroll
    for (int d0 = 0; d0 < NQREG; ++d0) qr[d0] = *reinterpret_cast<const bf16x8*>(Qw + d0 * 16);
#pragma unroll
    for (int d0 = NQREG; d0 < 12; ++d0) *reinterpret_cast<bf16x8*>(ql1 + (d0 - NQREG) * 1024) = *reinterpret_cast<const bf16x8*>(Qw + d0 * 16); }
  const int sr = tid >> 4, sc = (tid & 15) * 8, vst0 = v_st(sr, sc), vst1 = v_st(32 + sr, sc);
  const int r3 = tid >> 3, c3 = (tid & 7) * 8;
  const int vb0 = (int)(uintptr_t)V_lds + v_rd_base(lane);
  struct { bf16x8 vs0, vs1, ks0, ks1, kr; } sr_[2];
  const unsigned oK = (unsigned)(sr * LDKN + sc) * 2u, oR = (unsigned)(r3 * LDKR + c3) * 2u;
  int kb[4];
#pragma unroll
  for (int k = 0; k < 4; ++k) kb[k] = r32 * 384 + (((hi << 4) ^ ((r32 & 7) << 4)) ^ (k << 5));
#define SLOAD(i, k0) do { const char* kt_ = (const char*)Kn + (size_t)(k0) * (LDKN * 2); const char* rt_ = (const char*)Kr + (size_t)(k0) * (LDKR * 2); \
    sr_[i].vs0 = *reinterpret_cast<const bf16x8*>(kt_ + oK + 256); sr_[i].vs1 = *reinterpret_cast<const bf16x8*>(kt_ + (size_t)32 * LDKN * 2 + oK + 256); \
    sr_[i].ks0 = *reinterpret_cast<const bf16x8*>(kt_ + oK); sr_[i].ks1 = *reinterpret_cast<const bf16x8*>(kt_ + (size_t)32 * LDKN * 2 + oK); \
    sr_[i].kr = *reinterpret_cast<const bf16x8*>(rt_ + oR); } while (0)
#define SWRITE(b, i) do { *(bf16x8*)((char*)V_lds + (b) * SHM_V + vst0) = sr_[i].vs0;          \
    *(bf16x8*)((char*)V_lds + (b) * SHM_V + vst1) = sr_[i].vs1; int kc = sc * 2;               \
    *(bf16x8*)((char*)K_lds + (b) * SHM_K2 + ATT_KSWZ2(sr, kc)) = sr_[i].ks0;                       \
    *(bf16x8*)((char*)K_lds + (b) * SHM_K2 + ATT_KSWZ2(32 + sr, kc)) = sr_[i].ks1;                  \
    *(bf16x8*)((char*)K_lds + (b) * SHM_K2 + ATT_KSWZ2(r3, 256 + c3 * 2)) = sr_[i].kr; } while (0)
#define SWAIT() asm volatile("s_waitcnt vmcnt(5)" ::: "memory")
#define RESC(a) do { if (__any((a) < 1.f)) { if (hi == 0) al_l[r32] = (a); asm volatile("s_waitcnt lgkmcnt(0)" ::: "memory"); \
    _Pragma("unroll") for (int d = 0; d < 4; ++d) _Pragma("unroll") for (int r = 0; r < 16; ++r) o[d][r] *= al_l[crow(r, hi)]; } } while (0)
  f32x16 pA0, pA1, pB0, pB1; float mnA, mnB, alA, alB; bf16x8 pa0, pa1, pa2, pa3; const int NT = seq / KVBLK;
  constexpr int SE = 0, SO = 1;
  SLOAD(SE, 0); asm volatile("s_waitcnt vmcnt(0)" ::: "memory"); SWRITE(0, SE); __syncthreads();
  qkt192(pA0, pA1, (const char*)K_lds, kb, qr, qrl); partialSM(pA0, pA1, m_reg, mnA, alA, Cs, thr);
  SLOAD(SO, KVBLK); if (2 < NT) SLOAD(SE, 2 * KVBLK);
  SWAIT(); SWRITE(1, SO); __syncthreads();
  for (int j = 1; j + 1 < NT; j += 2) {
    ATT_SBAR(); qkt192(pB0, pB1, (const char*)K_lds + SHM_K2, kb, qr, qrl);
    finishSM(pA0, pA1, alA, l_reg, pa0, pa1, pa2, pa3); ATT_SBAR();
    SLOAD(SO, (j + 2) * KVBLK); ATT_SBAR();
    pv_d0(o, vb0, pa0, pa1, pa2, pa3); partialSM(pB0, pB1, m_reg, mnB, alB, Cs, thr);
    __syncthreads(); SWAIT(); SWRITE(0, SE);
    RESC(alB); __syncthreads();
    ATT_SBAR(); qkt192(pA0, pA1, (const char*)K_lds, kb, qr, qrl);
    finishSM(pB0, pB1, alB, l_reg, pa0, pa1, pa2, pa3); ATT_SBAR();
    if (j + 3 < NT) SLOAD(SE, (j + 3) * KVBLK); ATT_SBAR();
    pv_d0(o, vb0 + (int)SHM_V, pa0, pa1, pa2, pa3); partialSM(pA0, pA1, m_reg, mnA, alA, Cs, thr);
    __syncthreads(); SWAIT(); SWRITE(1, SO);
    RESC(alA); __syncthreads();
  }
  ATT_SBAR(); qkt192(pB0, pB1, (const char*)K_lds + SHM_K2, kb, qr, qrl);
  finishSM(pA0, pA1, alA, l_reg, pa0, pa1, pa2, pa3); ATT_SBAR();
  pv_d0(o, vb0, pa0, pa1, pa2, pa3); partialSM(pB0, pB1, m_reg, mnB, alB, Cs, thr);
  __syncthreads(); RESC(alB);
  finishSM(pB0, pB1, alB, l_reg, pa0, pa1, pa2, pa3); ATT_SBAR();
  pv_d0(o, vb0 + (int)SHM_V, pa0, pa1, pa2, pa3);
  if (hi == 0) li_l[r32] = l_reg; asm volatile("s_waitcnt lgkmcnt(0)" ::: "memory");
  {
    int t2 = threadIdx.x; asm volatile("" : "+v"(t2));
    const int w2 = t2 >> 6, l2 = t2 & 63, r2 = l2 & 31, h2 = l2 >> 5;
    const float* li2 = (const float*)(lds + MLA_OFF_WS) + w2 * 64;
    bf16* Ow = Ob + (long)(w2 * QBLK) * LDO + r2;
#pragma unroll
    for (int r = 0; r < 16; ++r) { const int orow = crow(r, h2); const float rl = __builtin_amdgcn_rcpf(li2[orow]);
#pragma unroll
      for (int d0 = 0; d0 < 4; ++d0) Ow[(long)orow * LDO + d0 * 32] = (bf16)::f2bf(o[d0][r] * rl); } }
  asm volatile("s_waitcnt vmcnt(0) lgkmcnt(0)" ::: "memory"); __syncthreads();
#undef SLOAD
#undef SWRITE
#undef SWAIT
#undef RESC
}
}

namespace pg8 {
struct EpiF32Store {
    static constexpr bool PERM = false, AFTER_DRAIN = false;
    float* Cc; int ldc; float* part;
    __device__ __forceinline__ void quad(const f32x4 (&a)[4][2], const Unit& u, int ai, int bj, int wr, int wc, int fr, int fq) const {
        const int row0 = u.pm * BM + ai * HALF + wr * 64 + fr, col0 = u.pn * BM + bj * HALF + wc * 32 + 4 * fq;
#pragma unroll
        for (int m = 0; m < 4; ++m) { float* rowp = Cc + (size_t)(row0 + m * 16) * ldc + col0; *(f32x4*)rowp = a[m][0]; *(f32x4*)(rowp + 16) = a[m][1]; }
    }
    __device__ __forceinline__ void quad_part(const f32x4 (&a)[4][2], const Unit& u, int ai, int bj, int sp, int pc, int wr, int wc, int fr, int fq) const {
        const int col0 = u.pn * BM + bj * HALF + wc * 32 + 4 * fq, rl0 = pc * BM + ai * HALF + wr * 64 + fr;
#pragma unroll
        for (int m = 0; m < 4; ++m) { float* rowp = part + ((size_t)sp * 512 + rl0 + m * 16) * ldc + col0; *(f32x4*)rowp = a[m][0]; *(f32x4*)(rowp + 16) = a[m][1]; }
    }
    __device__ __forceinline__ void operator()(const f32x4 (&acc)[2][2][4][2], const Unit& u, int wr, int wc, int fr, int fq) const {
#pragma unroll
        for (int ai = 0; ai < 2; ++ai)
#pragma unroll
            for (int bj = 0; bj < 2; ++bj) quad(acc[ai][bj], u, ai, bj, wr, wc, fr, fq);
    }
};
struct EpiMlaDown {
    static constexpr bool PERM = false, AFTER_DRAIN = true;
    float* part; const float* gq; const float* gkv; const float* tab; bf16_t* CQn; bf16_t* CKVn; bf16_t* KR; float* slots; unsigned* cnt; unsigned* tmo;
    __device__ __forceinline__ void fused(f32x4 (&acc)[2][2][4][2], const Unit& u, int wr, int wc, int fr, int fq, PG8_LAS unsigned char* lds, int wid, int lane) const {
        PG8_LAS float* P = (PG8_LAS float*)lds;
        PG8_LAS float* S = (PG8_LAS float*)(lds + 8192);
        PG8_LAS unsigned char* stg = lds + 12288;
#pragma unroll
        for (int ai = 0; ai < 2; ++ai)
#pragma unroll
            for (int m = 0; m < 4; ++m)
#pragma unroll
                for (int bj = 0; bj < 2; ++bj) { const f32x4 a0 = acc[ai][bj][m][0], a1 = acc[ai][bj][m][1];
                    float q = (a0[0] * a0[0] + a0[1] * a0[1]) + (a0[2] * a0[2] + a0[3] * a0[3]) + (a1[0] * a1[0] + a1[1] * a1[1]) + (a1[2] * a1[2] + a1[3] * a1[3]);
                    q += __shfl_xor(q, 16); q += __shfl_xor(q, 32);
                    if (fq == 0) P[(ai * HALF + wr * 64 + m * 16 + fr) * 8 + bj * 4 + wc] = q; }
        asm volatile("s_waitcnt lgkmcnt(0)" ::: "memory"); __builtin_amdgcn_s_barrier(); asm volatile("" ::: "memory");
        const int row = wid * 32 + (lane & 31);
        if (lane < 32) { float tq = 0.f, tkv = 0.f;
#pragma unroll
            for (int s8 = 0; s8 < 8; ++s8) { const int ci = u.pn * 8 + s8; const float v = P[row * 8 + s8]; if (ci < 14) tq += v; else if (ci < 30) tkv += v; }
            unsigned* sl = (unsigned*)slots + ((size_t)(u.pm * BM + row) * 8 + u.pn * 2);
            __hip_atomic_store(sl, __float_as_uint(tq), __ATOMIC_RELAXED, __HIP_MEMORY_SCOPE_AGENT); __hip_atomic_store(sl + 1, __float_as_uint(tkv), __ATOMIC_RELAXED, __HIP_MEMORY_SCOPE_AGENT); }
        asm volatile("s_waitcnt vmcnt(0)" ::: "memory");
        if (lane == 0) __hip_atomic_fetch_add(cnt + 64 * u.pm, 1u, __ATOMIC_RELAXED, __HIP_MEMORY_SCOPE_AGENT);
        if (wid == 0) { unsigned sp = 0;
            for (;;) { if ((unsigned)__builtin_amdgcn_readfirstlane(__hip_atomic_load(cnt + 64 * u.pm, __ATOMIC_RELAXED, __HIP_MEMORY_SCOPE_AGENT)) >= 32u) break;
                __builtin_amdgcn_s_sleep(2);
                if (++sp > (1u << 18)) { if (lane == 0) __hip_atomic_store(tmo, 1u, __ATOMIC_RELAXED, __HIP_MEMORY_SCOPE_AGENT); break; } }
            __builtin_amdgcn_fence(__ATOMIC_ACQUIRE, "agent"); }
        asm volatile("s_waitcnt vmcnt(0) lgkmcnt(0)" ::: "memory"); __builtin_amdgcn_s_barrier(); asm volatile("" ::: "memory");
        if (lane < 32) { const unsigned* sl = (const unsigned*)slots + (size_t)(u.pm * BM + row) * 8; float tq = 0.f, tkv = 0.f;
#pragma unroll
            for (int k = 0; k < 4; ++k) { tq += __uint_as_float(__hip_atomic_load(sl + 2 * k, __ATOMIC_RELAXED, __HIP_MEMORY_SCOPE_AGENT)); tkv += __uint_as_float(__hip_atomic_load(sl + 2 * k + 1, __ATOMIC_RELAXED, __HIP_MEMORY_SCOPE_AGENT)); }
            S[row * 2] = rsqrtf(tq * (1.0f / MQR) + EPS); S[row * 2 + 1] = rsqrtf(tkv * (1.0f / MKVR) + EPS); }
        asm volatile("s_waitcnt vmcnt(0) lgkmcnt(0)" ::: "memory"); __builtin_amdgcn_s_barrier(); asm volatile("" ::: "memory");
#pragma unroll
        for (int bj = 0; bj < 2; ++bj) { const int ci = u.pn * 8 + bj * 4 + wc, cg = ci * 32 + 4 * fq;
            if (ci < 30) { const bool isq = ci < 14; const float* gp = isq ? gq + cg : gkv + (cg - MQR);
                const f32x4 g0 = *(const f32x4*)gp, g1 = *(const f32x4*)(gp + 16);
#pragma unroll
                for (int ai = 0; ai < 2; ++ai)
#pragma unroll
                    for (int m = 0; m < 4; ++m) { const int r = ai * HALF + wr * 64 + m * 16 + fr; const float rs = S[r * 2 + (isq ? 0 : 1)];
                        const f32x4 y0 = acc[ai][bj][m][0] * rs * g0, y1 = acc[ai][bj][m][1] * rs * g1;
                        PG8_LAS unsigned char* d = stg + r * 528 + (bj * HALF + wc * 32 + 4 * fq) * 2;
                        *(PG8_LAS unsigned long long*)d = (unsigned long long)cvt_pk_bf16(y0[0], y0[1]) | ((unsigned long long)cvt_pk_bf16(y0[2], y0[3]) << 32);
                        *(PG8_LAS unsigned long long*)(d + 32) = (unsigned long long)cvt_pk_bf16(y1[0], y1[1]) | ((unsigned long long)cvt_pk_bf16(y1[2], y1[3]) << 32); }
            } else { const int half = ci - 30;
#pragma unroll
                for (int ai = 0; ai < 2; ++ai)
#pragma unroll
                    for (int m = 0; m < 4; ++m) { const int r = ai * HALF + wr * 64 + m * 16 + fr, t = (u.pm * BM + r) % TB, pos = half ? (t % GRID_W) : (t / GRID_W);
                        const f32x4 cs = *(const f32x4*)(tab + 8192 + pos * 16 + 4 * fq), sn = *(const f32x4*)(tab + 8192 + 2048 + pos * 16 + 4 * fq);
                        const f32x4 lo = acc[ai][bj][m][0], hi = acc[ai][bj][m][1]; const f32x4 ylo = lo * cs - hi * sn, yhi = hi * cs + lo * sn;
                        u32x4 w; w.x = cvt_pk_bf16(ylo[0], yhi[0]); w.y = cvt_pk_bf16(ylo[1], yhi[1]); w.z = cvt_pk_bf16(ylo[2], yhi[2]); w.w = cvt_pk_bf16(ylo[3], yhi[3]);
                        *(PG8_LAS u32x4*)(stg + r * 528 + (bj * HALF + wc * 32 + 8 * fq) * 2) = w; }
            } }
        asm volatile("s_waitcnt lgkmcnt(0)" ::: "memory"); __builtin_amdgcn_s_barrier(); asm volatile("" ::: "memory");
        const int tid = wid * 64 + lane;
#pragma unroll
        for (int it = 0; it < 16; ++it) { const int p = it * 512 + tid, r = p >> 5, ch = p & 31, c = u.pn * BM + ch * 8; const size_t grow = (size_t)(u.pm * BM + r);
            const u32x4 v = *(const PG8_LAS u32x4*)(stg + r * 528 + ch * 16);
            if (c < MQR) *(u32x4*)(CQn + grow * 512 + c) = v;
            else if (c < MQR + MKVR) { *(u32x4*)(CKVn + grow * 512 + (c - MQR)) = v; if (c < 512) *(u32x4*)(CQn + grow * 512 + c) = (u32x4){0u, 0u, 0u, 0u}; }
            else *(u32x4*)(KR + grow * 64 + (c - MQR - MKVR)) = v; }
        asm volatile("s_waitcnt lgkmcnt(0)" ::: "memory"); __builtin_amdgcn_s_barrier(); asm volatile("" ::: "memory");
    }
    __device__ __forceinline__ void quad(const f32x4 (&)[4][2], const Unit&, int, int, int, int, int, int) const {}
    __device__ __forceinline__ void quad_part(const f32x4 (&a)[4][2], const Unit& u, int ai, int bj, int sp, int pc, int wr, int wc, int fr, int fq) const {
        const int col0 = u.pn * BM + bj * HALF + wc * 32 + 4 * fq, rl0 = pc * BM + ai * HALF + wr * 64 + fr;
#pragma unroll
        for (int m = 0; m < 4; ++m) { float* rowp = part + ((size_t)sp * 512 + rl0 + m * 16) * 1024 + col0; *(f32x4*)rowp = a[m][0]; *(f32x4*)(rowp + 16) = a[m][1]; }
    }
};
struct EpiMlaQ {
    static constexpr bool PERM = true, AFTER_DRAIN = false;
    bf16_t* O; PG8_LAS const float* tl;
    __device__ __forceinline__ void quad(const f32x4 (&a)[4][2], const Unit& u, int ai, int bj, int wr, int wc, int fr, int fq) const {
        const int row0 = u.pm * BM + ai * HALF + wr * 64 + fr, col0 = u.pn * BM + bj * HALF + wc * 32 + 8 * fq;
        const int hd = col0 % 192, e0 = hd - 128; const bool rope = hd >= 128; const int half = (e0 >> 5) & 1, f0 = (e0 & 31) >> 1;
#pragma unroll
        for (int m = 0; m < 4; ++m) { const int row = row0 + m * 16, t = row % TB; const f32x4 v0 = a[m][0], v1 = a[m][1];
            f32x4 cs = {1.f, 1.f, 1.f, 1.f}, sn = {0.f, 0.f, 0.f, 0.f};
            if (rope) { const int pos = half ? (t % GRID_W) : (t / GRID_W); cs = *(PG8_LAS const f32x4*)(tl + pos * 16 + f0); sn = *(PG8_LAS const f32x4*)(tl + 2048 + pos * 16 + f0); }
            const float a0 = v0[0] * cs[0] - v0[1] * sn[0], b0 = v0[1] * cs[0] + v0[0] * sn[0], a1 = v0[2] * cs[1] - v0[3] * sn[1], b1 = v0[3] * cs[1] + v0[2] * sn[1];
            const float a2 = v1[0] * cs[2] - v1[1] * sn[2], b2 = v1[1] * cs[2] + v1[0] * sn[2], a3 = v1[2] * cs[3] - v1[3] * sn[3], b3 = v1[3] * cs[3] + v1[2] * sn[3];
            u32x4 w; w.x = cvt_pk_bf16(a0, b0); w.y = cvt_pk_bf16(a1, b1); w.z = cvt_pk_bf16(a2, b2); w.w = cvt_pk_bf16(a3, b3);
            *(u32x4*)(O + (size_t)row * 3072 + col0) = w; }
    }
    __device__ __forceinline__ void operator()(const f32x4 (&acc)[2][2][4][2], const Unit& u, int wr, int wc, int fr, int fq) const {
#pragma unroll
        for (int ai = 0; ai < 2; ++ai)
#pragma unroll
            for (int bj = 0; bj < 2; ++bj) quad(acc[ai][bj], u, ai, bj, wr, wc, fr, fq);
    }
};
}

__device__ __forceinline__ void ph_mla_mid(const Ctx& C, const float* Cf, const float* part, const float* qg, const float* kvg, const float* tab, bf16* CQn, bf16* CKVn, bf16* KR, int ctx_only = 0, unsigned* pub = nullptr) {
    const int gw = C.vcu * 8 + C.wave, NGW = C.G * 8, lane = C.lane;
    float qgr[7], kvgr[8];
#pragma unroll
    for (int j = 0; j < 7; ++j) qgr[j] = qg[j * 64 + lane];
#pragma unroll
    for (int j = 0; j < 8; ++j) kvgr[j] = kvg[j * 64 + lane];
    for (int i = gw; i < (ctx_only ? BATCH * CTXL : NR); i += NGW) {
        const int r = ctx_only ? (i / CTXL) * TB + SEQ + i % CTXL : i;
        const int tt = r % TB; const bool isctx = tt >= SEQ;
        const float* cr = isctx ? part + ((size_t)(r / TB) * CTXL + (tt - SEQ)) * 1024 : Cf + (size_t)r * 1024;
        float q[7], kv[8]; float sq = 0.f, sk = 0.f; float x;
        if (isctx) {
#pragma unroll
            for (int j = 0; j < 7; ++j) q[j] = (cr[j * 64 + lane] + cr[512 * 1024 + j * 64 + lane]) + (cr[2 * 512 * 1024 + j * 64 + lane] + cr[3 * 512 * 1024 + j * 64 + lane]);
#pragma unroll
            for (int j = 0; j < 8; ++j) kv[j] = (cr[448 + j * 64 + lane] + cr[512 * 1024 + 448 + j * 64 + lane]) + (cr[2 * 512 * 1024 + 448 + j * 64 + lane] + cr[3 * 512 * 1024 + 448 + j * 64 + lane]);
            x = (cr[960 + lane] + cr[512 * 1024 + 960 + lane]) + (cr[2 * 512 * 1024 + 960 + lane] + cr[3 * 512 * 1024 + 960 + lane]);
        } else {
#pragma unroll
            for (int j = 0; j < 7; ++j) q[j] = cr[j * 64 + lane];
#pragma unroll
            for (int j = 0; j < 8; ++j) kv[j] = cr[448 + j * 64 + lane];
            x = cr[960 + lane];
        }
#pragma unroll
        for (int j = 0; j < 7; ++j) sq += q[j] * q[j];
#pragma unroll
        for (int j = 0; j < 8; ++j) sk += kv[j] * kv[j];
        const float rq = rsqrtf(wsum(sq) * (1.0f / 448) + EPS), rk = rsqrtf(wsum(sk) * (1.0f / 512) + EPS);
#pragma unroll
        for (int j = 0; j < 7; ++j) CQn[(size_t)r * 512 + j * 64 + lane] = (bf16)f2bf(q[j] * rq * qgr[j]);
        CQn[(size_t)r * 512 + 448 + lane] = (bf16)0;
#pragma unroll
        for (int j = 0; j < 8; ++j) { const unsigned me = f2bf(kv[j] * rk * kvgr[j]);
            if (pub) { const unsigned nb = (unsigned)__shfl_xor((int)me, 1); if ((lane & 1) == 0) __hip_atomic_store((unsigned*)(CKVn + (size_t)r * 512 + j * 64 + lane), me | (nb << 16), __ATOMIC_RELAXED, __HIP_MEMORY_SCOPE_AGENT); }
            else CKVn[(size_t)r * 512 + j * 64 + lane] = (bf16)me; }
        const int t = r % TB, half = lane >> 5, dd = lane & 31, f = dd & 15;
        const float xp = __shfl_xor(x, 16);
        float y = x;
        if (t < SEQ) { const int pos = half ? (t % GRID_W) : (t / GRID_W); const float cs = tab[8192 + pos * 16 + f], sn = tab[8192 + 2048 + pos * 16 + f];
            y = (dd < 16) ? (x * cs - xp * sn) : (x * cs + xp * sn); }
        const int np = (dd < 16) ? 2 * dd : 2 * (dd - 16) + 1;
        KR[(size_t)r * 64 + half * 32 + np] = (bf16)f2bf(y);
    }
    if (pub) { asm volatile("s_waitcnt vmcnt(0)" ::: "memory"); if (lane == 0) __hip_atomic_fetch_add(pub, 1u, __ATOMIC_RELAXED, __HIP_MEMORY_SCOPE_AGENT); }
}
__device__ __forceinline__ void ph_mla_attn(const Ctx& C, const bf16* Qm, const bf16* KVm, const bf16* KRm, bf16* OM) {
    const float scale = 0.07216878364870323f;
    constexpr int NUN = BATCH * MH * (SEQ / 256);
    for (int u = C.vcu; u < NUN; u += C.G) {
        const int combo = u >> 5, qb = u & 31, h = combo & 15, b = combo >> 4;
        const size_t qrow = (size_t)b * TB + (size_t)qb * 256, krow = (size_t)b * TB;
        att::attn_mla_body<3072, 4096, 64, 2048>((const att::bf16*)Qm + qrow * 3072 + h * 192, (const att::bf16*)KVm + krow * 4096 + h * 256, (const att::bf16*)KRm + krow * 64,
            (att::bf16*)OM + qrow * 2048 + h * 128, TB, (char*)C.lds, scale);
    }
}
static_assert(att::SHM_D2 <= RING_BYTES && att::SHM_MLA <= (size_t)RING_BYTES && att::SHM_ATTN <= (size_t)RING_BYTES, "attention LDS images fit below the control words");

#define PH(l, s) (1 + 10 * (l) + (s))
#ifndef GEMM_ALIGN
#define GEMM_ALIGN false
#define GEMM_SP2 true
#endif
constexpr int PH_FINAL = 41, PH_END = 42;

__global__ void __launch_bounds__(512, 2) mega(Args args) {
    extern __shared__ __attribute__((aligned(16))) unsigned char lds_raw[];
    Ctx C; C.lds = (LAS unsigned char*)lds_raw; C.tid = threadIdx.x; C.lane = C.tid & 63; C.wave = __builtin_amdgcn_readfirstlane(C.tid >> 6);
    C.G = gridDim.x; { const int bx = blockIdx.x; C.vcu = (C.G % 8 == 0) ? (bx % 8) * (C.G / 8) + bx / 8 : bx; }
    volatile LAS unsigned* MISC = (volatile LAS unsigned*)(C.lds + MISC_OFF);
    for (int u = C.tid; u < (LDS_BYTES - LDSCTL_OFF) / 4; u += 512) ((LAS unsigned*)(C.lds + LDSCTL_OFF))[u] = 0u;
    __syncthreads();
    unsigned char* ws = args.ws;
    XcdBarrier bar = xcd_barrier_post((unsigned*)(ws + WS_CTL) + CW_BAR + args.li * XCD_BAR_WORDS, MISC + 8);
    const int lo = args.ph_lo, hi = args.ph_hi; bool started = false;
#define PHASE_BEGIN(k) if (lo <= (k) && (k) < hi) { if (started) xcd_barrier(bar); started = true;
#define PHASE_END }
    float* X = (float*)(ws + WS_X); const float* mod = (const float*)(ws + WS_MOD);
    const pg8::bf16_t* WB = (const pg8::bf16_t*)(ws + WS_WB);
    bf16* XNb = (bf16*)(ws + FA_XN); bf16* Hb = (bf16*)(ws + FA_H);
    float* PARTf = (float*)(ws + FA_B + 136 * MiB);
    float* SLOTf = (float*)(ws + FA_B + 120 * MiB); unsigned* CNTw = (unsigned*)(ws + WS_CTL) + 131072; unsigned* TMOw = CNTw - 64;
    const bool fuse = (C.G == 256);
    unsigned* CTXC = CNTw + 9 * 66 * 64;
#define FUSED_RES(Aop, Wop, Kdim, gatep, ngp, nmodp, gid, xinp, CTX) { pg8::Gemm g{Aop, Wop, NR, D, Kdim}; \
        pg8::EpiResNorm E{X, gatep, ngp, nmodp, (pg8::bf16_t*)XNb, args.out, SLOTf, CNTw + (gid) * 66 * 64, TMOw, xinp, PARTf}; \
        pg8::SliceOrder S0{(int)blockIdx.x, 0, C.G}; pg8::gemm_phase<pg8::EpiResNorm, pg8::SliceOrder, GEMM_ALIGN, GEMM_SP2>(C.lds, g, S0, E); __syncthreads(); \
        pg8::SliceOrder S1{(int)blockIdx.x, 1, C.G}; pg8::gemm_phase<pg8::EpiResNorm, pg8::SliceOrder, GEMM_ALIGN, GEMM_SP2, (CTX), ((CTX) ? 4 : 1)>(C.lds, g, S1, E); }

    PHASE_BEGIN(0) if (blockIdx.x == 0 && C.tid < 16) __hip_atomic_store(att::g_ctxa + C.tid * 64, 0u, __ATOMIC_RELAXED, __HIP_MEMORY_SCOPE_AGENT);
        ph_prologue(args, C, fuse ? CTXC + 6 * 64 : (unsigned*)nullptr);
        if (fuse) { if (C.wave == 0) { unsigned sp_ = 0; const unsigned want_ = (unsigned)C.G * 8u;
                for (;;) { if ((unsigned)__builtin_amdgcn_readfirstlane(__hip_atomic_load(CTXC + 6 * 64, __ATOMIC_RELAXED, __HIP_MEMORY_SCOPE_AGENT)) >= want_) break; __builtin_amdgcn_s_sleep(2); if (++sp_ > (1u << 20)) break; }
                __builtin_amdgcn_fence(__ATOMIC_ACQUIRE, "agent"); asm volatile("s_waitcnt vmcnt(0)" ::: "memory"); }
            __syncthreads();
            ph_norm(C, X, args.in[I_N1G], mod, 0, XNb, 0, args.in[I_X], args.in[I_CTX]); }
    PHASE_END

#define FFN_PHASES(l) \
    if (!fuse) { PHASE_BEGIN(PH(l, 6)) ph_norm(C, X, args.in[I_N2G] + (size_t)(l) * D, mod + (size_t)(l) * 3 * MODW, 1, XNb, (l) >= 2, nullptr, (l) == 0 ? args.in[I_CTX] : nullptr, (l) < 2 ? PARTf : nullptr, 4, 0); PHASE_END } \
    PHASE_BEGIN(PH(l, 7)) { pg8::Gemm g{XNb, WB + WB_FF1 + (size_t)(l) * D * DFF, NR, DFF, D}; \
        if (fuse && (l) < 2) { ph_norm(C, X, args.in[I_N2G] + (size_t)(l) * D, mod + (size_t)(l) * 3 * MODW, 1, XNb, 0, nullptr, (l) == 0 ? args.in[I_CTX] : nullptr, PARTf, 4, 2, CTXC + (l) * 64); g.ctxcnt = CTXC + (l) * 64; g.ctxwant = (unsigned)C.G * 8u; }     \
        pg8::StaticOrder S; S.init(BATCH * SEQ, DFF, C.G, (int)blockIdx.x, 1); \
        pg8::EpiAct<2> E{Hb, DFF}; pg8::gemm_phase<pg8::EpiAct<2>, pg8::StaticOrder, GEMM_ALIGN, GEMM_SP2, ((l) < 2)>(C.lds, g, S, E); } PHASE_END \
    PHASE_BEGIN(PH(l, 8)) if (fuse) FUSED_RES(Hb, WB + WB_FF2 + (size_t)(l) * D * DFF, DFF, mod + (size_t)(l) * 3 * MODW + 5 * D, (l) == 3 ? args.in[I_FING] : args.in[I_N1G] + (size_t)((l) + 1) * D, (l) == 3 ? (const float*)nullptr : mod + (size_t)((l) + 1) * 3 * MODW, 4 + (l), (const float*)nullptr, ((l) < 2)) \
        else { pg8::Gemm g{Hb, WB + WB_FF2 + (size_t)(l) * D * DFF, NR, D, DFF}; pg8::StaticOrder S; S.init(BATCH * SEQ, D, C.G, (int)blockIdx.x, 1); \
        pg8::EpiRes E{X, mod + (size_t)(l) * 3 * MODW + 5 * D, nullptr, nullptr, PARTf};  pg8::gemm_phase<pg8::EpiRes, pg8::StaticOrder, GEMM_ALIGN, GEMM_SP2, ((l) < 2), 4>(C.lds, g, S, E); } PHASE_END

    bf16* Zb = (bf16*)(ws + FA_H); bf16* Gb = XNb; float* STf = (float*)(ws + FA_B);
#define GMLP_PHASES(l, idx) \
    if (!fuse) { PHASE_BEGIN(PH(l, 0)) ph_norm(C, X, args.in[I_N1G] + (size_t)(l) * D, mod + (size_t)(l) * 3 * MODW, 0, XNb, (l) == 3, (l) == 0 ? args.in[I_X] : nullptr, (l) == 0 ? args.in[I_CTX] : nullptr); PHASE_END } \
    PHASE_BEGIN(PH(l, 1)) { pg8::Gemm g{XNb, WB + WB_AWIN + (size_t)(idx) * D * 4096, NR, 4096, D}; pg8::StaticOrder S; S.init(BATCH * SEQ, 4096, C.G, (int)blockIdx.x, 1); \
        { LAS float* bl_ = (LAS float*)(C.lds + 131072); const float* bs_ = args.in[I_ABIN] + (size_t)(idx) * 4096; for (int i_ = C.tid; i_ < 4096; i_ += 512) bl_[i_] = bs_[i_]; } __syncthreads();     \
        pg8::EpiGeluStats E{Zb, (LAS const float*)(C.lds + 131072), STf}; pg8::gemm_phase<pg8::EpiGeluStats, pg8::StaticOrder, GEMM_ALIGN, GEMM_SP2, ((l) != 3)>(C.lds, g, S, E); } PHASE_END \
    PHASE_BEGIN(PH(l, 2)) ph_gmlp_spatial(C, Zb, STf, args.in[I_ALNG] + (size_t)(idx) * GW, (const bf16*)WB + WB_AWS + (size_t)(idx) * GG * 128 * 128, args.in[I_ABS] + (size_t)(idx) * GG * CHUNK, Gb, (l) == 3); PHASE_END \
    PHASE_BEGIN(PH(l, 3)) if (fuse) FUSED_RES(Gb, WB + WB_AWOUT + (size_t)(idx) * D * D, GW, mod + (size_t)(l) * 3 * MODW + 2 * D, args.in[I_N2G] + (size_t)(l) * D, mod + (size_t)(l) * 3 * MODW + 3 * D, (l), (l) == 0 ? args.in[I_X] : (const float*)nullptr, ((l) != 3)) \
        else { pg8::Gemm g{Gb, WB + WB_AWOUT + (size_t)(idx) * D * D, NR, D, GW}; pg8::StaticOrder S; S.init(BATCH * SEQ, D, C.G, (int)blockIdx.x, 1); \
        pg8::EpiRes E{X, mod + (size_t)(l) * 3 * MODW + 2 * D, (l) == 0 ? args.in[I_X] : nullptr, (l) == 0 ? args.in[I_CTX] : nullptr, PARTf};  pg8::gemm_phase<pg8::EpiRes, pg8::StaticOrder, GEMM_ALIGN, GEMM_SP2, ((l) != 3), 4>(C.lds, g, S, E); } PHASE_END

    bf16* QKVb = (bf16*)(ws + FA_H); bf16* Of = (bf16*)(ws + FA_B); const float* tab = (const float*)(ws + WS_ROPE);
#define DIFF_PHASES(l, idx) \
    if (!fuse) { PHASE_BEGIN(PH(l, 0)) ph_norm(C, X, args.in[I_N1G] + (size_t)(l) * D, mod + (size_t)(l) * 3 * MODW, 0, XNb, 0, nullptr, nullptr, PARTf, 4, 0); PHASE_END } \
    PHASE_BEGIN(PH(l, 1)) { pg8::Gemm g{XNb, WB + WB_BQKV, NR, NQKV, D}; \
        if (fuse) { ph_norm(C, X, args.in[I_N1G] + (size_t)(l) * D, mod + (size_t)(l) * 3 * MODW, 0, XNb, 0, nullptr, nullptr, PARTf, 4, 2, CTXC + (2 + (l)) * 64); g.ctxcnt = CTXC + (2 + (l)) * 64; g.ctxwant = (unsigned)C.G * 8u; } \
        pg8::StaticOrder S; S.init(BATCH * SEQ, NQKV, C.G, (int)blockIdx.x, 1); \
        { LAS _Float16* tl_ = (LAS _Float16*)(C.lds + 131072); for (int i_ = C.tid; i_ < 8192; i_ += 512) tl_[i_] = (_Float16)tab[i_]; } __syncthreads();     \
        pg8::EpiQkvRope E{QKVb, tab, (LAS const _Float16*)(C.lds + 131072)}; pg8::gemm_phase<pg8::EpiQkvRope, pg8::StaticOrder, GEMM_ALIGN, GEMM_SP2, true>(C.lds, g, S, E); } PHASE_END \
    PHASE_BEGIN(PH(l, 2)) ph_diff_attn3(C, QKVb, (float*)Of, args.in[I_BLQ1], args.in[I_BLK1], args.in[I_BLQ2], args.in[I_BLK2], args.in[I_BSUBG], 0.35550906759097f, XNb, fuse ? (float*)(ws + FA_B + 64 * MiB) : (float*)nullptr); PHASE_END \
    PHASE_BEGIN(PH(l, 4)) if (fuse) FUSED_RES(XNb, WB + WB_BWO, 2048, mod + (size_t)(l) * 3 * MODW + 2 * D, args.in[I_N2G] + (size_t)(l) * D, mod + (size_t)(l) * 3 * MODW + 3 * D, (l), (const float*)nullptr, true) \
        else { pg8::Gemm g{XNb, WB + WB_BWO, NR, D, 2048}; pg8::StaticOrder S; S.init(BATCH * SEQ, D, C.G, (int)blockIdx.x, 1); \
        pg8::EpiRes E{X, mod + (size_t)(l) * 3 * MODW + 2 * D, nullptr, nullptr, PARTf};  pg8::gemm_phase<pg8::EpiRes, pg8::StaticOrder, GEMM_ALIGN, GEMM_SP2, true, 4>(C.lds, g, S, E); } PHASE_END

    GMLP_PHASES(0, 0)
    FFN_PHASES(0)
    DIFF_PHASES(1, 0)
    FFN_PHASES(1)
    float* Cf = (float*)(ws + FA_B); bf16* CQn = (bf16*)(ws + FA_B + 66 * MiB); bf16* CKVn = (bf16*)(ws + FA_B + 83 * MiB); bf16* KRb = (bf16*)(ws + FA_B + 100 * MiB);
    bf16* Qmb = (bf16*)(ws + FA_H); bf16* KVmb = (bf16*)(ws + FA_H + 99 * MiB);
#define MLA_PHASES(l) \
    if (!fuse) { PHASE_BEGIN(PH(l, 0)) ph_norm(C, X, args.in[I_N1G] + (size_t)(l) * D, mod + (size_t)(l) * 3 * MODW, 0, XNb, 0, nullptr, nullptr, PARTf, 4, 0); PHASE_END } \
    PHASE_BEGIN(PH(l, 1)) { pg8::Gemm g{XNb, WB + WB_CDQKV, NR, 1024, D}; \
        if (fuse) { ph_norm(C, X, args.in[I_N1G] + (size_t)(l) * D, mod + (size_t)(l) * 3 * MODW, 0, XNb, 0, nullptr, nullptr, PARTf, 4, 2, CTXC + (2 + (l)) * 64); g.ctxcnt = CTXC + (2 + (l)) * 64; g.ctxwant = (unsigned)C.G * 8u; } \
        pg8::StaticOrder S; S.init(BATCH * SEQ, 1024, C.G, (int)blockIdx.x, 1); \
        if (fuse) { pg8::EpiMlaDown E{PARTf, args.in[I_CQNG], args.in[I_CKVNG], tab, (pg8::bf16_t*)CQn, (pg8::bf16_t*)CKVn, (pg8::bf16_t*)KRb, SLOTf, CNTw + 8 * 66 * 64, TMOw}; \
            pg8::gemm_phase<pg8::EpiMlaDown, pg8::StaticOrder, GEMM_ALIGN, GEMM_SP2, true, 4>(C.lds, g, S, E); } \
        else { pg8::EpiF32Store E{Cf, 1024, PARTf}; pg8::gemm_phase<pg8::EpiF32Store, pg8::StaticOrder, GEMM_ALIGN, GEMM_SP2, true, 4>(C.lds, g, S, E); } } PHASE_END \
    if (!fuse) { PHASE_BEGIN(PH(l, 2)) ph_mla_mid(C, Cf, PARTf, args.in[I_CQNG], args.in[I_CKVNG], tab, CQn, CKVn, KRb, 0); PHASE_END } \
    PHASE_BEGIN(PH(l, 3)) { if (fuse) ph_mla_mid(C, Cf, PARTf, args.in[I_CQNG], args.in[I_CKVNG], tab, CQn, CKVn, KRb, 1, CTXC + 5 * 64);     \
        { pg8::Gemm g{CQn, WB + WB_CUQ, NR, 3072, 512}; pg8::StaticOrder S; S.init(BATCH * SEQ, 3072, C.G, (int)blockIdx.x, 1); \
        { LAS float* tl_ = (LAS float*)(C.lds + 131072); for (int i_ = C.tid; i_ < 4096; i_ += 512) tl_[i_] = tab[8192 + i_]; } __syncthreads();     \
        pg8::EpiMlaQ E{Qmb, (LAS const float*)(C.lds + 131072)}; pg8::gemm_phase<pg8::EpiMlaQ, pg8::StaticOrder, GEMM_ALIGN, GEMM_SP2>(C.lds, g, S, E); } \
        { pg8::Gemm g{CKVn, WB + WB_CUKV, NR, 4096, 512}; if (fuse) { g.ctxcnt = CTXC + 5 * 64; g.ctxwant = (unsigned)C.G * 8u; } pg8::StaticOrder S; S.init(BATCH * SEQ, 4096, C.G, (int)blockIdx.x, 1); \
        pg8::EpiAct<0> E{KVmb, 4096}; pg8::gemm_phase<pg8::EpiAct<0>, pg8::StaticOrder, GEMM_ALIGN, GEMM_SP2, true>(C.lds, g, S, E); } } PHASE_END \
    PHASE_BEGIN(PH(l, 4)) ph_mla_attn(C, Qmb, KVmb, KRb, XNb); PHASE_END \
    PHASE_BEGIN(PH(l, 5)) if (fuse) FUSED_RES(XNb, WB + WB_CWO, 2048, mod + (size_t)(l) * 3 * MODW + 2 * D, args.in[I_N2G] + (size_t)(l) * D, mod + (size_t)(l) * 3 * MODW + 3 * D, (l), (const float*)nullptr, false) \
        else { pg8::Gemm g{XNb, WB + WB_CWO, NR, D, 2048}; pg8::StaticOrder S; S.init(BATCH * SEQ, D, C.G, (int)blockIdx.x, 1); \
        pg8::EpiRes E{X, mod + (size_t)(l) * 3 * MODW + 2 * D, nullptr, nullptr, nullptr};  pg8::gemm_phase<pg8::EpiRes, pg8::StaticOrder, GEMM_ALIGN, GEMM_SP2>(C.lds, g, S, E); } PHASE_END
    MLA_PHASES(2)
    FFN_PHASES(2)
    GMLP_PHASES(3, 1)
    FFN_PHASES(3)

    if (!fuse) { PHASE_BEGIN(PH_FINAL) ph_final(C, X, args.in[I_FING], args.out); PHASE_END }
#undef PHASE_BEGIN
#undef PHASE_END
}

extern "C" void kernel_launch(void* const* d_in, const int* in_sizes, int n_in, void* d_out, int out_size, void* d_ws, size_t ws_size, hipStream_t stream) {
    if (n_in != N_IN || in_sizes[I_X] != BATCH * SEQ * D || out_size != BATCH * SEQ * D || ws_size < WS_NEED) {
        fprintf(stderr, "kernel_launch: unexpected shapes (n_in %d, x %d, out %d, ws %zu; need ws %zu); nothing launched\n", n_in, n_in > 0 ? in_sizes[0] : -1, out_size, ws_size, (size_t)WS_NEED);
        return;
    }
    static int grid = 0;
    if (grid == 0) {
        int dev = 0, cus = 0, per_cu = 0;
        if (hipGetDevice(&dev) != hipSuccess || hipDeviceGetAttribute(&cus, hipDeviceAttributeMultiprocessorCount, dev) != hipSuccess) { grid = -1; return; }
        if (hipFuncSetAttribute((const void*)mega, hipFuncAttributeMaxDynamicSharedMemorySize, LDS_BYTES) != hipSuccess) { fprintf(stderr, "kernel_launch: cannot get %d B of LDS\n", LDS_BYTES); grid = -1; return; }
        if (hipOccupancyMaxActiveBlocksPerMultiprocessor(&per_cu, (const void*)mega, 512, LDS_BYTES) != hipSuccess || per_cu < 1) fprintf(stderr, "kernel_launch: occupancy query says %d blocks per CU\n", per_cu);
        (void)hipGetLastError();
        grid = cus;
    }
    if (grid < 0) return;
    unsigned char* ws = (unsigned char*)d_ws;
    (void)hipMemsetAsync(ws + WS_CTL, 0, 1 * MiB, stream);
    Args a{}; for (int i = 0; i < N_IN; ++i) a.in[i] = (const float*)d_in[i]; a.out = (float*)d_out; a.ws = ws;
    a.ph_lo = 0; a.ph_hi = PH_END; a.li = 0; a.pad = 0;
    hipLaunchKernelGGL(mega, dim3(grid), dim3(512), LDS_BYTES, stream, a);
    const hipError_t le = hipPeekAtLastError();
    if (le != hipSuccess) fprintf(stderr, "kernel_launch: launch failed: %s\n", hipGetErrorName(le));
}
```
